# Optimizing an MI355X kernel written in HIP

```python
import math
import jax, jax.numpy as jnp
from jax import lax
import numpy as np

D_MODEL = 2048
BATCH = 2
SEQ = 4096
DEPTH = 2

GRID_W = 64
CTX_LEN = 256

BRANCH_WIDTH = 1024
N_BRANCH = 3

HY_WIDTH = BRANCH_WIDTH
HY_ORDER = 2
HY_CONV = 3
HY_EMB = 33
HY_BANDS = (HY_EMB - 1) // 2
HY_FILTER_HIDDEN = 64
HY_DECAY_TARGET = 1e-2
HY_FAST_DECAY = 0.3
HY_SLOW_DECAY = 1.5

HG_HEADS = 8
HG_DK = 128
HG_DV = BRANCH_WIDTH // HG_HEADS
HG_FWIDTH = HG_HEADS * HG_DK
HG_WIDTH = HG_HEADS * HG_DV
HG_F_MIN = 1e-30

DN_QK_HEADS = 4
DN_V_HEADS = 8
DN_DK = 128
DN_DV = BRANCH_WIDTH // DN_V_HEADS
DN_QK_WIDTH = DN_QK_HEADS * DN_DK
DN_WIDTH = DN_V_HEADS * DN_DV
DN_CONV = 3

CHUNK = 64
D_FF = 4 * D_MODEL
ALPHA = (2 * DEPTH) ** 0.25
BETA_INIT = (8 * DEPTH) ** -0.25
LN_EPS = 1e-5
RMS_EPS = 1e-6

STATE_SIZES = (HG_FWIDTH, HG_FWIDTH, HG_WIDTH, DN_QK_WIDTH, DN_WIDTH, 2 * DN_V_HEADS, 2 * DN_V_HEADS)
READ_SIZES = (HG_FWIDTH, HG_WIDTH, DN_QK_WIDTH, DN_WIDTH)
IN_SIZES = STATE_SIZES + READ_SIZES + ((HY_ORDER + 1) * HY_WIDTH, N_BRANCH * D_MODEL)
STATE_COLS = sum(STATE_SIZES)
IN_COLS = sum(IN_SIZES)

kernel_name = "hybrid_hyena_hgrn2_gdn_dit_block"


def _split(h, sizes):
    idx = [int(i) for i in np.cumsum(sizes)[:-1]]
    return jnp.split(h, idx, axis=-1)


def _flip(t):
    return None if t is None else jnp.flip(t, axis=1)


def _layernorm(x, g, b):
    xf = x.astype(jnp.float32)
    mu = jnp.mean(xf, -1, keepdims=True)
    var = jnp.mean(jnp.square(xf - mu), -1, keepdims=True)
    return ((xf - mu) * lax.rsqrt(var + LN_EPS) * g + b).astype(x.dtype)


def _rmsnorm(o, w):
    of = o.astype(jnp.float32)
    return of * lax.rsqrt(jnp.mean(of * of, -1, keepdims=True) + RMS_EPS) * w


def _l2norm(t):
    t = t.astype(jnp.float32)
    return t * lax.rsqrt(jnp.sum(t * t, -1, keepdims=True) + 1e-6)


def _modulate(x, shift, scale):
    return x * (1.0 + scale) + shift


def _short_conv(x, w, is_grid):
    b, l, ch = x.shape
    xs = x.reshape(b, l // GRID_W, GRID_W, ch) if is_grid else x
    k = w.shape[0]
    n = xs.shape[-2]
    xp = jnp.pad(xs, [(0, 0)] * (xs.ndim - 2) + [(k // 2, k // 2), (0, 0)])
    y = xp[..., 0:n, :] * w[0]
    for j in range(1, k):
        y = y + xp[..., j:j + n, :] * w[j]
    return y.reshape(b, l, ch)


def _hyena_filters(L, w1, b1, w2, b2, w3):
    f32 = jnp.float32
    t = jnp.linspace(0.0, 1.0, L, dtype=f32)[:, None]
    ang = (2.0 * math.pi / L) * jnp.arange(L, dtype=f32)[:, None]
    bands = jnp.linspace(1e-4, HY_BANDS - 1, HY_BANDS, dtype=f32)[None, :]
    feats = jnp.concatenate([t, jnp.cos(bands * ang), -jnp.sin(bands * ang)], axis=-1)
    hid = jnp.sin(feats @ w1.astype(f32) + b1.astype(f32))
    hid = jnp.sin(hid @ w2.astype(f32) + b2.astype(f32))
    h = (hid @ w3.astype(f32)).reshape(L, HY_ORDER, 2, HY_WIDTH)
    deltas = jnp.abs(jnp.linspace(math.log(HY_DECAY_TARGET) / HY_SLOW_DECAY,
                                  math.log(HY_DECAY_TARGET) / HY_FAST_DECAY, HY_WIDTH, dtype=f32))
    window = jnp.exp(-t * deltas)
    return h * window[:, None, None, :]


def _fft_long_conv(u, h_fwd, h_bwd, skip):
    L = u.shape[1]
    kfull = jnp.concatenate([h_fwd, jnp.zeros_like(h_fwd[:1]), h_bwd[:0:-1]], axis=0)
    uf = jnp.fft.rfft(u.astype(jnp.float32), n=2 * L, axis=1)
    kf = jnp.fft.rfft(kfull.astype(jnp.float32), n=2 * L, axis=0)
    y = jnp.fft.irfft(uf * kf[None], n=2 * L, axis=1)[:, :L]
    return (y + u.astype(jnp.float32) * skip).astype(u.dtype)


def _hyena(hh, conv_w, conv_b, filt_params, skip, is_grid):
    L = hh.shape[1]
    filt = _hyena_filters(L, *filt_params)
    z = _short_conv(hh, conv_w, is_grid) + conv_b
    v, *gates = jnp.split(z, HY_ORDER + 1, axis=-1)
    y = v
    for n, gate in enumerate(gates):
        y = gate * _fft_long_conv(y, filt[:, n, 0], filt[:, n, 1], skip[n])
    return y


def _to_chunks(t):
    b, l = t.shape[:2]
    t = t.reshape(b, l // CHUNK, CHUNK, *t.shape[2:])
    return jnp.moveaxis(t, (1, 2), (0, 3))


def _from_chunks(t):
    t = jnp.moveaxis(t, (0, 3), (1, 2))
    return t.reshape(t.shape[0], t.shape[1] * t.shape[2], *t.shape[3:])


def _gla_scan(q, k, v, log_f, s0):
    with_output = q is not None
    tri = jnp.tril(jnp.ones((CHUNK, CHUNK), bool))[:, :, None]
    xs = tuple(_to_chunks(t.astype(jnp.float32)) for t in (k, v, log_f))
    if with_output:
        xs = xs + (_to_chunks(q.astype(jnp.float32)),)

    def step(s, inp):
        kc, vc, gc = inp[:3]
        bc = jnp.cumsum(gc, axis=-2)
        b_last = bc[..., -1:, :]
        s_new = jnp.exp(b_last[..., 0, :])[..., None] * s + jnp.einsum(
            'bhsk,bhsv->bhkv', kc * jnp.exp(b_last - bc), vc)
        if not with_output:
            return s_new, None
        qc = inp[3]
        diff = bc[..., :, None, :] - bc[..., None, :, :]
        w = jnp.where(tri, jnp.exp(jnp.where(tri, diff, 0.0)), 0.0)
        att = jnp.einsum('bhtk,bhsk,bhtsk->bhts', qc, kc, w)
        o = jnp.einsum('bhtk,bhkv->bhtv', qc * jnp.exp(bc), s) + jnp.einsum('bhts,bhsv->bhtv', att, vc)
        return s_new, o

    s_fin, ys = lax.scan(step, s0, xs)
    return (_from_chunks(ys) if with_output else None), s_fin


def _delta_scan(q, k, v, g, beta, s0):
    with_output = q is not None
    tri = jnp.tril(jnp.ones((CHUNK, CHUNK), bool))
    strict = jnp.tril(jnp.ones((CHUNK, CHUNK), bool), -1)
    eye = jnp.eye(CHUNK, dtype=jnp.float32)
    xs = tuple(_to_chunks(t.astype(jnp.float32)) for t in (k, v, g, beta))
    if with_output:
        xs = xs + (_to_chunks(q.astype(jnp.float32)),)

    def step(s, inp):
        kc, vc, gc, bc = inp[:4]
        dv = vc.shape[-1]
        gcum = jnp.cumsum(gc, axis=-1)
        diff = gcum[..., :, None] - gcum[..., None, :]
        decay = jnp.where(tri, jnp.exp(jnp.where(tri, diff, 0.0)), 0.0)
        kb = kc * bc[..., None]
        a = eye + jnp.where(strict, jnp.einsum('bhtk,bhsk->bhts', kb, kc) * decay, 0.0)
        rhs = jnp.concatenate([vc * bc[..., None], kb * jnp.exp(gcum)[..., None]], axis=-1)
        sol = lax.linalg.triangular_solve(a, rhs, left_side=True, lower=True, unit_diagonal=False)
        u, w = sol[..., :dv], sol[..., dv:]
        v_new = u - jnp.einsum('bhtk,bhkv->bhtv', w, s)
        g_last = gcum[..., -1:]
        s_new = jnp.exp(g_last)[..., None] * s + jnp.einsum(
            'bhsk,bhsv->bhkv', kc * jnp.exp(g_last - gcum)[..., None], v_new)
        if not with_output:
            return s_new, None
        qc = inp[4]
        att = jnp.einsum('bhtk,bhsk->bhts', qc, kc) * decay
        o = jnp.einsum('bhtk,bhkv->bhtv', qc * jnp.exp(gcum)[..., None], s) + jnp.einsum(
            'bhts,bhsv->bhtv', att, v_new)
        return s_new, o

    s_fin, ys = lax.scan(step, s0, xs)
    return (_from_chunks(ys) if with_output else None), s_fin


def _hgrn2(q, f_f, f_b, i, g, lb_f, lb_b, norm_w, states):
    bsz, L = i.shape[:2]
    heads = lambda t: t.reshape(bsz, L, HG_HEADS, -1)

    def forget(fz, lb):
        fz = fz.astype(jnp.float32)
        f = lb + (1.0 - lb) * jax.nn.sigmoid(fz)
        return heads(jnp.log(jnp.maximum(f, HG_F_MIN))), heads((1.0 - lb) * jax.nn.sigmoid(-fz))

    lf_f, k_f = forget(f_f, lb_f)
    lf_b, k_b = forget(f_b, lb_b)
    ih = heads(i)
    qh = None if q is None else heads(jax.nn.silu(q))
    o_f, s_f = _gla_scan(qh, k_f, ih, lf_f, states[0])
    o_b, s_b = _gla_scan(_flip(qh), _flip(k_b), _flip(ih), _flip(lf_b), states[1])
    if q is None:
        return None, (s_f, s_b)
    o = _rmsnorm(o_f + _flip(o_b), norm_w) * jax.nn.sigmoid(heads(g).astype(jnp.float32))
    return o.reshape(bsz, L, HG_WIDTH).astype(i.dtype), (s_f, s_b)


def _gated_deltanet(q_raw, k_raw, v_raw, z, a_all, b_all, conv_q, conv_k, conv_v,
                    a_log, dt_bias, norm_w, states, is_grid):
    bsz, L = k_raw.shape[:2]
    rep = DN_V_HEADS // DN_QK_HEADS
    k = _l2norm(jax.nn.silu(_short_conv(k_raw, conv_k, is_grid)).reshape(bsz, L, DN_QK_HEADS, DN_DK))
    k = jnp.repeat(k, rep, axis=2)
    v = jax.nn.silu(_short_conv(v_raw, conv_v, is_grid)).reshape(bsz, L, DN_V_HEADS, DN_DV)
    a_f, a_b = jnp.split(a_all.astype(jnp.float32), 2, axis=-1)
    b_f, b_b = jnp.split(b_all.astype(jnp.float32), 2, axis=-1)
    g_f = -jnp.exp(a_log[0]) * jax.nn.softplus(a_f + dt_bias[0])
    g_b = -jnp.exp(a_log[1]) * jax.nn.softplus(a_b + dt_bias[1])
    q = None
    if q_raw is not None:
        q = _l2norm(jax.nn.silu(_short_conv(q_raw, conv_q, is_grid)).reshape(bsz, L, DN_QK_HEADS, DN_DK))
        q = jnp.repeat(q * DN_DK ** -0.5, rep, axis=2)
    o_f, s_f = _delta_scan(q, k, v, g_f, jax.nn.sigmoid(b_f), states[0])
    o_b, s_b = _delta_scan(_flip(q), _flip(k), _flip(v), _flip(g_b), _flip(jax.nn.sigmoid(b_b)), states[1])
    if q is None:
        return None, (s_f, s_b)
    zh = z.reshape(bsz, L, DN_V_HEADS, DN_DV).astype(jnp.float32)
    o = _rmsnorm(o_f + _flip(o_b), norm_w) * jax.nn.silu(zh)
    return o.reshape(bsz, L, DN_WIDTH).astype(k_raw.dtype), (s_f, s_b)


def _token_mixers(u, lp, init_states, is_grid, with_output):
    bsz, L, _ = u.shape
    if with_output:
        parts = _split(u @ lp["w_in"], IN_SIZES)
    else:
        parts = _split(u @ lp["w_in"][:, :STATE_COLS], STATE_SIZES) + [None] * (len(IN_SIZES) - len(STATE_SIZES))
    hg_ff, hg_fb, hg_i, dn_k, dn_v, dn_a, dn_b, hg_q, hg_g, dn_q, dn_z, hy_in, gate_in = parts
    hg_out, hg_states = _hgrn2(hg_q, hg_ff, hg_fb, hg_i, hg_g, lp["lb_fwd"], lp["lb_bwd"],
                               lp["hg_norm_w"], init_states[0])
    dn_out, dn_states = _gated_deltanet(dn_q, dn_k, dn_v, dn_z, dn_a, dn_b, lp["dn_conv_q"], lp["dn_conv_k"],
                                        lp["dn_conv_v"], lp["dn_a_log"], lp["dn_dt_bias"], lp["dn_norm_w"],
                                        init_states[1], is_grid)
    states = (hg_states, dn_states)
    if not with_output:
        return None, states
    hy_out = _hyena(hy_in, lp["hy_conv_w"], lp["hy_conv_b"], lp["hy_filt"], lp["hy_skip"], is_grid)
    branches = jnp.stack([hy_out, hg_out, dn_out], axis=2)
    proj = jnp.einsum('blgc,gcd->blgd', branches, lp["w_branch"])
    gate = jax.nn.sigmoid(gate_in.reshape(bsz, L, N_BRANCH, D_MODEL))
    y = jnp.sum(gate * proj, axis=2) @ lp["w_out"]
    return y, states


def _sq_relu_mlp(u, w1, w2):
    return jnp.square(jax.nn.relu(u @ w1)) @ w2


def setup_inputs(seed: int = 0) -> dict:
    key = jax.random.key(seed)
    ks = jax.random.split(key, 40)
    f32 = jnp.float32
    nrm = lambda k, shape, s: s * jax.random.normal(k, shape, f32)
    dt = jnp.exp(jax.random.uniform(ks[22], (DEPTH, 2, DN_V_HEADS), f32, math.log(1e-3), math.log(1e-1)))
    return {
        "x": nrm(ks[0], (BATCH, SEQ, D_MODEL), 1.0),
        "c": nrm(ks[1], (BATCH, D_MODEL), 1.0),
        "ctx": nrm(ks[2], (BATCH, CTX_LEN, D_MODEL), 1.0),
        "c_ctx": nrm(ks[3], (D_MODEL,), 1.0),
        "w_ada": nrm(ks[4], (DEPTH, D_MODEL, 6 * D_MODEL), 0.5 * D_MODEL ** -0.5),
        "b_ada": nrm(ks[5], (DEPTH, 6 * D_MODEL), 0.02),
        "w_in": nrm(ks[6], (DEPTH, D_MODEL, IN_COLS), D_MODEL ** -0.5),
        "hy_conv_w": nrm(ks[7], (DEPTH, HY_CONV, (HY_ORDER + 1) * HY_WIDTH), HY_CONV ** -0.5),
        "hy_conv_b": nrm(ks[8], (DEPTH, (HY_ORDER + 1) * HY_WIDTH), 0.02),
        "hy_filt_w1": nrm(ks[9], (DEPTH, HY_EMB, HY_FILTER_HIDDEN), HY_EMB ** -0.5),
        "hy_filt_b1": nrm(ks[10], (DEPTH, HY_FILTER_HIDDEN), 0.02),
        "hy_filt_w2": nrm(ks[11], (DEPTH, HY_FILTER_HIDDEN, HY_FILTER_HIDDEN), HY_FILTER_HIDDEN ** -0.5),
        "hy_filt_b2": nrm(ks[12], (DEPTH, HY_FILTER_HIDDEN), 0.02),
        "hy_filt_w3": nrm(ks[13], (DEPTH, HY_FILTER_HIDDEN, HY_ORDER * 2 * HY_WIDTH), 0.1 * HY_FILTER_HIDDEN ** -0.5),
        "hy_skip": nrm(ks[14], (DEPTH, HY_ORDER, HY_WIDTH), 1.0),
        "hg_lb_logits": nrm(ks[15], (2, DEPTH, HG_FWIDTH), 0.1),
        "hg_norm_w": 1.0 + nrm(ks[16], (DEPTH, HG_DV), 0.02),
        "dn_conv_q": nrm(ks[17], (DEPTH, DN_CONV, DN_QK_WIDTH), DN_CONV ** -0.5),
        "dn_conv_k": nrm(ks[18], (DEPTH, DN_CONV, DN_QK_WIDTH), DN_CONV ** -0.5),
        "dn_conv_v": nrm(ks[19], (DEPTH, DN_CONV, DN_WIDTH), DN_CONV ** -0.5),
        "dn_a_log": jnp.log(jax.random.uniform(ks[20], (DEPTH, 2, DN_V_HEADS), f32, 1.0, 16.0)),
        "dn_dt_bias": dt + jnp.log(-jnp.expm1(-dt)),
        "dn_norm_w": 1.0 + nrm(ks[21], (DEPTH, DN_DV), 0.02),
        "w_branch": nrm(ks[23], (DEPTH, N_BRANCH, BRANCH_WIDTH, D_MODEL), BRANCH_WIDTH ** -0.5),
        "w_out": nrm(ks[24], (DEPTH, D_MODEL, D_MODEL), BETA_INIT * D_MODEL ** -0.5),
        "ln1_g": 1.0 + nrm(ks[25], (DEPTH, D_MODEL), 0.02),
        "ln1_b": nrm(ks[26], (DEPTH, D_MODEL), 0.02),
        "w_ff1": nrm(ks[27], (DEPTH, D_MODEL, D_FF), D_MODEL ** -0.5),
        "w_ff2": nrm(ks[28], (DEPTH, D_FF, D_MODEL), BETA_INIT * D_FF ** -0.5),
        "ln2_g": 1.0 + nrm(ks[29], (DEPTH, D_MODEL), 0.02),
        "ln2_b": nrm(ks[30], (DEPTH, D_MODEL), 0.02),
    }


def reference(x, c, ctx, c_ctx, w_ada, b_ada, w_in, hy_conv_w, hy_conv_b, hy_filt_w1, hy_filt_b1,
              hy_filt_w2, hy_filt_b2, hy_filt_w3, hy_skip, hg_lb_logits, hg_norm_w, dn_conv_q, dn_conv_k,
              dn_conv_v, dn_a_log, dn_dt_bias, dn_norm_w, w_branch, w_out, ln1_g, ln1_b, w_ff1, w_ff2,
              ln2_g, ln2_b):
    f32 = jnp.float32
    bsz = x.shape[0]
    p = jax.nn.softmax(hg_lb_logits.astype(f32), axis=1)
    lower_bounds = jnp.cumsum(p, axis=1) - p[:, :1]
    h_ctx = ctx
    for l in range(DEPTH):
        last = l == DEPTH - 1
        lp = {
            "w_in": w_in[l], "hy_conv_w": hy_conv_w[l], "hy_conv_b": hy_conv_b[l],
            "hy_filt": (hy_filt_w1[l], hy_filt_b1[l], hy_filt_w2[l], hy_filt_b2[l], hy_filt_w3[l]),
            "hy_skip": hy_skip[l], "lb_fwd": lower_bounds[0, l], "lb_bwd": lower_bounds[1, l],
            "hg_norm_w": hg_norm_w[l], "dn_conv_q": dn_conv_q[l], "dn_conv_k": dn_conv_k[l],
            "dn_conv_v": dn_conv_v[l], "dn_a_log": dn_a_log[l], "dn_dt_bias": dn_dt_bias[l],
            "dn_norm_w": dn_norm_w[l], "w_branch": w_branch[l], "w_out": w_out[l],
        }
        zero_hg = jnp.zeros((bsz, HG_HEADS, HG_DK, HG_DV), f32)
        zero_dn = jnp.zeros((bsz, DN_V_HEADS, DN_DK, DN_DV), f32)
        init = ((zero_hg, zero_hg), (zero_dn, zero_dn))
        n_mod = 2 if last else 6
        mod_c = jax.nn.silu(c_ctx) @ w_ada[l][:, :n_mod * D_MODEL] + b_ada[l][:n_mod * D_MODEL]
        mods_c = jnp.split(mod_c, n_mod)
        y_ctx, ctx_states = _token_mixers(_modulate(h_ctx, mods_c[0], mods_c[1]), lp, init, False, not last)
        if not last:
            h_ctx = _layernorm(ALPHA * h_ctx + mods_c[2] * y_ctx, ln1_g[l], ln1_b[l])
            h_ctx = _layernorm(ALPHA * h_ctx + mods_c[5] * _sq_relu_mlp(_modulate(h_ctx, mods_c[3], mods_c[4]),
                                                                          w_ff1[l], w_ff2[l]), ln2_g[l], ln2_b[l])
        mod = jax.nn.silu(c) @ w_ada[l] + b_ada[l]
        sh1, sc1, g1, sh2, sc2, g2 = [m[:, None, :] for m in jnp.split(mod, 6, axis=-1)]
        y, _ = _token_mixers(_modulate(x, sh1, sc1), lp, ctx_states, True, True)
        x = _layernorm(ALPHA * x + g1 * y, ln1_g[l], ln1_b[l])
        x = _layernorm(ALPHA * x + g2 * _sq_relu_mlp(_modulate(x, sh2, sc2), w_ff1[l], w_ff2[l]),
                       ln2_g[l], ln2_b[l])
    return x
```

```cpp
#include <hip/hip_runtime.h>
#include <hip/hip_cooperative_groups.h>
#include <cstdio>
#include <cstdint>
namespace cg = cooperative_groups;

#define LAS __attribute__((address_space(3)))
typedef unsigned short bf16_t;
typedef short bf16x8 __attribute__((ext_vector_type(8)));
typedef float f32x4 __attribute__((ext_vector_type(4)));
typedef float f32x2 __attribute__((ext_vector_type(2)));
typedef unsigned u32x4 __attribute__((ext_vector_type(4)));
typedef unsigned u32x2 __attribute__((ext_vector_type(2)));

constexpr int D = 2048, NB = 2, SEQ = 4096, CTX = 256, TPB = SEQ + CTX, M = NB * TPB, DEPTH = 2;
constexpr int INC = 17440, NPAD = 17664, DFF = 8192;
constexpr int C_HGFF = 0, C_HGFB = 1024, C_HGI = 2048, C_DNK = 3072, C_DNV = 3584, C_DNA = 4608, C_DNB = 4624,
              C_HGQ = 4640, C_HGG = 5664, C_DNQ = 6688, C_DNZ = 7200, C_HY = 8224, C_GATE = 11296;
constexpr int NTHR = 512, NWAVES = 8;
constexpr int LDS_BYTES = 147456;
constexpr float ALPHA = 1.41421356237f;

constexpr size_t al256(size_t x) { return (x + 255) & ~(size_t)255; }
constexpr size_t SZ_WIN = (size_t)NPAD * D * 2, SZ_WBR = (size_t)D * 1024 * 2, SZ_WOUT = (size_t)D * D * 2, SZ_WFF = (size_t)DFF * D * 2;
constexpr size_t WS_WIN = 0;
constexpr size_t WS_WBR = WS_WIN + DEPTH * SZ_WIN;
constexpr size_t WS_WOUT = WS_WBR + DEPTH * 3 * SZ_WBR;
constexpr size_t WS_WFF1 = WS_WOUT + DEPTH * SZ_WOUT;
constexpr size_t WS_WFF2 = WS_WFF1 + DEPTH * SZ_WFF;
constexpr size_t WS_X = WS_WFF2 + DEPTH * SZ_WFF;
constexpr size_t WS_U = WS_X + (size_t)M * D * 4;
constexpr size_t WS_H = WS_U + (size_t)M * D * 2;
constexpr size_t WS_DN = WS_H + (size_t)M * NPAD * 2;
constexpr size_t OFF_DNK = 0, OFF_DNQ = (size_t)M * 512 * 4, OFF_DNV = 2 * OFF_DNQ, OFF_DNS = OFF_DNV + (size_t)M * 1024 * 4;
constexpr size_t SZ_DN = OFF_DNS + (size_t)M * 64 * 4;
constexpr size_t WS_SO = WS_DN + SZ_DN;
constexpr size_t SZ_SO1 = (size_t)M * 1024 * 4;
constexpr size_t SZ_SOB = (size_t)M * 1024 * 2;
constexpr size_t WS_ZT = WS_SO + 4 * SZ_SO1;
constexpr size_t WS_ZY = WS_ZT + (size_t)3072 * 4096 * 8;
constexpr size_t WS_ZC = WS_ZY + (size_t)1024 * 4096 * 8;
constexpr size_t WS_MOD = WS_ZC + (size_t)2 * 256 * 3072 * 4;
constexpr size_t WS_HID = WS_MOD + (size_t)DEPTH * 3 * 6 * D * 4;
constexpr size_t SZ_HID1 = (size_t)64 * (4096 + 256) * 4;
constexpr size_t WS_LB = WS_HID + DEPTH * SZ_HID1;
constexpr size_t WS_BAR = WS_LB + (size_t)DEPTH * 2 * 1024 * 4;
constexpr size_t WS_SCTX = WS_ZT;
constexpr int NCHUNK = TPB / 16, NTASK = NB * 8 * 2 * NCHUNK;
constexpr size_t WS_CP1 = WS_ZT;
constexpr size_t CP1_STRIDE = 8192;
constexpr size_t WS_CPK = WS_U;
constexpr size_t WS_CP2 = WS_BAR + 16384;
constexpr size_t CP2_STRIDE = 512 + 512 + 128;
static_assert((size_t)NTASK * 4096 <= (size_t)M * D * 2, "CPK alias");
constexpr size_t WS_HGQ = WS_DN + OFF_DNK;
constexpr size_t WS_HGA = WS_ZT + (size_t)NTASK * CP1_STRIDE;
constexpr size_t WS_HGK = WS_CP2 + (size_t)NTASK * CP2_STRIDE;
constexpr size_t WS_HYC = WS_HGK + (size_t)NTASK * 4096;
static_assert((size_t)NTASK * 4096 <= 2 * (size_t)M * 512 * 4 && (size_t)NTASK * (CP1_STRIDE + 1024) <= (size_t)3072 * 4096 * 8, "HG fragment aliases");
constexpr size_t WS_END = WS_HYC + (size_t)512 * 1024 * 2;
static_assert((size_t)NTASK * CP1_STRIDE <= (size_t)3072 * 4096 * 8, "CP1 alias");
static_assert((size_t)16 * 512 * D * 4 <= (size_t)3072 * 4096 * 8, "PART alias");
static_assert(WS_END < (size_t)1142900000, "workspace too large");
static_assert((size_t)M * 3072 * 2 <= SZ_DN && (size_t)M * DFF * 2 <= (size_t)M * NPAD * 2 && 2 * (size_t)M * D * 4 <= 4 * SZ_SO1, "aliases");

struct Params { const float* in[31]; float* out; unsigned char* ws; };

#define LDS_WAIT() asm volatile("s_waitcnt lgkmcnt(0)" ::: "memory")
#define XB_CNT(j) (64 * (j))
#define XB_SUB(j) (1024 + 64 * (j))
#define XB_TOP 2048
#define XB_GEN 2112
__device__ __forceinline__ unsigned xcc_id() { return (unsigned)__builtin_amdgcn_s_getreg((3 << 11) | 20) & 0xFu; }
__device__ __forceinline__ int otid() { int t = threadIdx.x; asm volatile("" : "+v"(t)); return t; }
__device__ __forceinline__ int obid() { int t = blockIdx.x; asm volatile("" : "+s"(t)); return t; }
__device__ __forceinline__ unsigned pk2(float lo, float hi) { unsigned r; asm("v_cvt_pk_bf16_f32 %0, %1, %2" : "=v"(r) : "v"(lo), "v"(hi)); return r; }
typedef __bf16 bf16v2 __attribute__((ext_vector_type(2)));
__device__ __forceinline__ unsigned pk2n(float lo, float hi) { return __builtin_bit_cast(unsigned, __builtin_convertvector((f32x2){lo, hi}, bf16v2)); }
__device__ __forceinline__ float bflo(unsigned u) { return __uint_as_float(u << 16); }
__device__ __forceinline__ float bfhi(unsigned u) { return __uint_as_float(u & 0xffff0000u); }
__device__ __forceinline__ float bf1(bf16_t u) { return __uint_as_float(((unsigned)u) << 16); }
__device__ __forceinline__ float sigm(float x) { return __builtin_amdgcn_rcpf(1.f + __expf(-x)); }
__device__ __forceinline__ float silu(float x) { return x * sigm(x); }
__device__ __forceinline__ float sin_rad(float x) { float r = x * 0.15915494309189535f; r = r - floorf(r); return __builtin_amdgcn_sinf(r); }
template <int CTRL> __device__ __forceinline__ float dppf(float x) { return __builtin_bit_cast(float, __builtin_amdgcn_update_dpp(0, __builtin_bit_cast(int, x), CTRL, 0xf, 0xf, true)); }
__device__ __forceinline__ float row_sum16(float x) {
    x += dppf<0x128>(x); x += dppf<0x124>(x); x += dppf<0x122>(x); x += dppf<0x121>(x); return x;
}
__device__ __forceinline__ float wave_sum(float v) {
    v = row_sum16(v);
    const int iv = __builtin_bit_cast(int, v);
    const float a = __builtin_bit_cast(float, __builtin_amdgcn_readlane(iv, 0)), b = __builtin_bit_cast(float, __builtin_amdgcn_readlane(iv, 16));
    const float c = __builtin_bit_cast(float, __builtin_amdgcn_readlane(iv, 32)), d = __builtin_bit_cast(float, __builtin_amdgcn_readlane(iv, 48));
    return (a + b) + (c + d);
}
__device__ __forceinline__ void unpack8(u32x4 u, float* f) {
    f[0] = bflo(u.x); f[1] = bfhi(u.x); f[2] = bflo(u.y); f[3] = bfhi(u.y); f[4] = bflo(u.z); f[5] = bfhi(u.z); f[6] = bflo(u.w); f[7] = bfhi(u.w);
}

namespace pg8 {
constexpr int BM = 256, BK = 64, HALF = 128, HTB = HALF * BK * 2, NXCD = 8, WGM = 8;
__device__ __forceinline__ int lds_byte(int r, int c) { const int st = (r >> 4) * 2 + (c >> 5), rr = r & 15, cc = c & 31, ob = rr * 64 + cc * 2; return st * 1024 + (ob ^ (((ob >> 9) & 1) << 5)); }
__device__ __forceinline__ void stage_rc(int b, int& R, int& C) { const int st = b / 1024, sb = b % 1024, swz = sb ^ (((sb >> 9) & 1) << 5); R = (st >> 1) * 16 + swz / 64; C = (st & 1) * 32 + (swz % 64) / 2; }
__device__ __forceinline__ int perm32(int rho) { const int n = rho >> 4, i = rho & 15; return 8 * (i >> 2) + 4 * n + (i & 3); }

struct Unit { int pm, pn, g, nt, split, slot; const char* A; const char* B; };

__device__ __forceinline__ void tile_of(int L, int nM, int nN, int& pm, int& pn) {
    const int nwg = nM * nN; int wgid = L;
    { const int q = nwg / NXCD, r = nwg % NXCD, xcd = wgid % NXCD, off = wgid / NXCD; wgid = (xcd < r ? xcd * (q + 1) : r * (q + 1) + (xcd - r) * q) + off; }
    const int nig = WGM * nN, gid = wgid / nig, fm = gid * WGM, gsz = (nM - fm) < WGM ? (nM - fm) : WGM;
    pm = fm + ((wgid % nig) % gsz); pn = (wgid % nig) / gsz;
}
struct Order {
    const bf16_t* A; const bf16_t* Bt; int lda, ldb, nM, nN, G, c, nsub; size_t aks, bstride;
    int K;
    int latent_only, ctx_ncols;
    int ksplit;
    __device__ __forceinline__ bool next(int i, Unit& u) const {
        const int nmain = nM * nN;
        const int rounds = (nmain > c) ? (nmain - c + G - 1) / G : 0;
        if (i < rounds * nsub) {
            const int ti = i / nsub, g = i - ti * nsub; const int L = ti * G + c;
            tile_of(L, nM, nN, u.pm, u.pn); if (latent_only) u.pm += 1 + (u.pm >= 16);
            u.g = g; u.nt = K / BK; u.split = 0;
            u.A = (const char*)(A + (size_t)u.pm * BM * lda + (size_t)g * aks);
            u.B = (const char*)(Bt + (size_t)g * bstride + (size_t)u.pn * BM * ldb);
            return true;
        }
        const int e = i - rounds * nsub; const long Lx = (long)e * G + c;
        if (ksplit > 0) {
            if (Lx >= (long)2 * nN * nsub * ksplit) return false;
            const int s = (int)Lx, per = nsub * ksplit, tile = s / per, r = s - tile * per, g = r / ksplit, ks = r - g * ksplit, Ks = K / ksplit;
            const int q = tile / nN; u.pm = q * 17; u.pn = tile - q * nN; u.g = g; u.nt = Ks / BK; u.split = 1; u.slot = r;
            u.A = (const char*)(A + (size_t)u.pm * BM * lda + (size_t)g * aks + (size_t)ks * Ks);
            u.B = (const char*)(Bt + (size_t)g * bstride + (size_t)u.pn * BM * ldb + (size_t)ks * Ks);
            return true;
        }
        if (Lx >= (long)2 * ctx_ncols) return false;
        { const int j = (int)Lx; const int q = j / ctx_ncols; u.pm = q * 17; u.pn = j - q * ctx_ncols; }
        u.g = 0; u.nt = K / BK; u.split = 0;
        u.A = (const char*)(A + (size_t)u.pm * BM * lda);
        u.B = (const char*)(Bt + (size_t)u.pn * BM * ldb);
        return true;
    }
};

template <class Epi, class Sched>
__device__ __forceinline__ void gemm_phase(LAS unsigned char* lds, const int lda, const int ldb, const Sched& S, const Epi& E) {
    const int tid = otid(), wid = __builtin_amdgcn_readfirstlane(tid >> 6), lane = tid & 63, wr = wid >> 2, wc = wid & 3, fr = lane & 15, fq = lane >> 4;
    unsigned voffA[2], voffB[2];
#pragma unroll
    for (int i = 0; i < 2; ++i) { int R, C; stage_rc(tid * 16 + i * 8192, R, C); const int Rb = Epi::PERM ? ((R & ~31) + perm32(R & 31)) : R;
        voffA[i] = (unsigned)(R * lda + C) * 2u; voffB[i] = (unsigned)(Rb * ldb + C) * 2u; }
    const size_t kstep = (size_t)(BK * 2);
    const size_t hstepA = (size_t)HALF * lda * 2, hstepB = (size_t)HALF * ldb * 2;
    const unsigned ldsw = (unsigned)wid * 1024u;
    const int aoff = lds_byte(wr * 64 + fr, fq * 8), boff = lds_byte(wc * 32 + fr, fq * 8);
#define PG8_SA(b, h) (((b) * 2 + (h)) * HTB)
#define PG8_SB(b, h) ((4 + (b) * 2 + (h)) * HTB)
#define PG8_STAGE(bufoff, gbase, voff) do { _Pragma("unroll") for (int _i = 0; _i < 2; ++_i) \
        __builtin_amdgcn_global_load_lds((const unsigned*)((const char*)(gbase) + (voff)[_i]), (LAS unsigned*)(lds + (bufoff) + ldsw + _i * 8192), 16, 0, 0); } while (0)
#define PG8_LDA(dst, b, h) do { _Pragma("unroll") for (int m = 0; m < 4; ++m) _Pragma("unroll") for (int k = 0; k < 2; ++k) dst[m][k] = *(const LAS bf16x8*)(lds + PG8_SA(b, h) + aoff + m * 2048 + k * 1024); } while (0)
#define PG8_LDB(dst, b, h) do { _Pragma("unroll") for (int n = 0; n < 2; ++n) _Pragma("unroll") for (int k = 0; k < 2; ++k) dst[n][k] = *(const LAS bf16x8*)(lds + PG8_SB(b, h) + boff + n * 2048 + k * 1024); } while (0)
#define PG8_MMA(ai, bj, At, Bt) do { __builtin_amdgcn_s_setprio(1); _Pragma("unroll") for (int m = 0; m < 4; ++m) _Pragma("unroll") for (int n = 0; n < 2; ++n) _Pragma("unroll") for (int k = 0; k < 2; ++k) \
        acc[ai][bj][m][n] = __builtin_amdgcn_mfma_f32_16x16x32_bf16(Bt[n][k], At[m][k], acc[ai][bj][m][n], 0, 0, 0); __builtin_amdgcn_s_setprio(0); } while (0)
#define PG8_WAIT_V(n) asm volatile("s_waitcnt vmcnt(" #n ")" ::: "memory")
#define PG8_WAIT_L(n) asm volatile("s_waitcnt lgkmcnt(" #n ")" ::: "memory")
#define PG8_BAR __builtin_amdgcn_s_barrier()
#define PG8_SCHED __builtin_amdgcn_sched_barrier(0)
    Unit cur, nxt; int ui = 0;
    if (!S.next(0, cur)) return;
    f32x4 acc[2][2][4][2];
#pragma unroll
    for (int a = 0; a < 2; ++a)
#pragma unroll
        for (int b = 0; b < 2; ++b)
#pragma unroll
            for (int m = 0; m < 4; ++m)
#pragma unroll
                for (int n = 0; n < 2; ++n) acc[a][b][m][n] = (f32x4){0.f, 0.f, 0.f, 0.f};
    bf16x8 At[4][2], B0[2][2], B1[2][2];
    const char* cA = cur.A; const char* cB = cur.B;
    PG8_STAGE(PG8_SB(0, 0), cB, voffB); PG8_STAGE(PG8_SA(0, 0), cA, voffA); PG8_STAGE(PG8_SB(0, 1), cB + hstepB, voffB); PG8_STAGE(PG8_SA(0, 1), cA + hstepA, voffA);
    if (wr == 1) PG8_BAR;
    PG8_WAIT_V(4); PG8_BAR;
    PG8_STAGE(PG8_SB(1, 0), cB + kstep, voffB); PG8_STAGE(PG8_SA(1, 0), cA + kstep, voffA); PG8_STAGE(PG8_SB(1, 1), cB + hstepB + kstep, voffB);
    PG8_WAIT_V(6); PG8_BAR;
    for (;;) {
        const bool has_next = S.next(ui + 1, nxt);
        const char* nA = has_next ? nxt.A : cA; const char* nB = has_next ? nxt.B : cB;
        const int nt = cur.nt;
        for (int t = 0; t < nt; t += 2) {
            const bool last = (t == nt - 2);
            const char* a1 = cA + (size_t)(t + 1) * kstep;
            const char* a2 = last ? nA : cA + (size_t)(t + 2) * kstep; const char* b2 = last ? nB : cB + (size_t)(t + 2) * kstep;
            const char* a3 = a2 + kstep; const char* b3 = b2 + kstep;
            PG8_LDB(B0, 0, 0); PG8_SCHED; PG8_LDA(At, 0, 0); PG8_STAGE(PG8_SA(1, 1), a1 + hstepA, voffA);
            PG8_WAIT_L(8); PG8_BAR; PG8_WAIT_L(0); PG8_MMA(0, 0, At, B0); PG8_BAR; PG8_SCHED;
            PG8_LDB(B1, 0, 1); PG8_STAGE(PG8_SB(0, 0), b2, voffB);
            PG8_BAR; PG8_WAIT_L(0); PG8_MMA(0, 1, At, B1); PG8_BAR;
            PG8_LDA(At, 0, 1); PG8_STAGE(PG8_SA(0, 0), a2, voffA);
            PG8_BAR; PG8_WAIT_L(0); PG8_MMA(1, 0, At, B0); PG8_BAR; PG8_SCHED;
            PG8_STAGE(PG8_SB(0, 1), b2 + hstepB, voffB);
            PG8_WAIT_V(6); PG8_BAR; PG8_MMA(1, 1, At, B1); PG8_BAR;
            PG8_LDB(B0, 1, 0); PG8_SCHED; PG8_LDA(At, 1, 0); PG8_STAGE(PG8_SA(0, 1), a2 + hstepA, voffA);
            PG8_WAIT_L(8); PG8_BAR; PG8_WAIT_L(0); PG8_MMA(0, 0, At, B0); PG8_BAR; PG8_SCHED;
            PG8_LDB(B1, 1, 1); PG8_STAGE(PG8_SB(1, 0), b3, voffB);
            PG8_BAR; PG8_WAIT_L(0); PG8_MMA(0, 1, At, B1); PG8_BAR;
            PG8_LDA(At, 1, 1); PG8_STAGE(PG8_SA(1, 0), a3, voffA);
            PG8_BAR; PG8_WAIT_L(0); PG8_MMA(1, 0, At, B0); PG8_BAR; PG8_SCHED;
            PG8_STAGE(PG8_SB(1, 1), b3 + hstepB, voffB);
            PG8_WAIT_V(6); PG8_BAR; PG8_MMA(1, 1, At, B1); PG8_BAR;
        }
        E(acc, cur, wr, wc, fr, fq);
        if (!has_next) break;
#pragma unroll
        for (int a = 0; a < 2; ++a)
#pragma unroll
            for (int b = 0; b < 2; ++b)
#pragma unroll
                for (int m = 0; m < 4; ++m)
#pragma unroll
                    for (int n = 0; n < 2; ++n) acc[a][b][m][n] = (f32x4){0.f, 0.f, 0.f, 0.f};
        cur = nxt; cA = nA; cB = nB; ++ui;
    }
    PG8_WAIT_V(0);
    if (wr == 0) PG8_BAR;
    PG8_BAR;
#undef PG8_SA
#undef PG8_SB
#undef PG8_STAGE
#undef PG8_LDA
#undef PG8_LDB
#undef PG8_MMA
#undef PG8_WAIT_V
#undef PG8_WAIT_L
#undef PG8_BAR
#undef PG8_SCHED
}

template <int ACT> struct EpiBf16 {
    static constexpr bool PERM = true;
    bf16_t* O; int ldc;
    __device__ __forceinline__ void operator()(const f32x4 (&acc)[2][2][4][2], const Unit& u, int wr, int wc, int fr, int fq) const {
        const int row0 = u.pm * BM + wr * 64 + fr, col0 = u.pn * BM + wc * 32 + 8 * fq;
#pragma unroll
        for (int ai = 0; ai < 2; ++ai)
#pragma unroll
            for (int m = 0; m < 4; ++m) { bf16_t* rowp = O + (size_t)(row0 + ai * HALF + m * 16) * ldc + col0;
#pragma unroll
                for (int bj = 0; bj < 2; ++bj) { f32x4 v0 = acc[ai][bj][m][0], v1 = acc[ai][bj][m][1];
                    if (ACT == 1) {
#pragma unroll
                        for (int e = 0; e < 4; ++e) { float a = fmaxf(v0[e], 0.f), b = fmaxf(v1[e], 0.f); v0[e] = a * a; v1[e] = b * b; } }
                    u32x4 o; o.x = pk2(v0[0], v0[1]); o.y = pk2(v0[2], v0[3]); o.z = pk2(v1[0], v1[1]); o.w = pk2(v1[2], v1[3]);
                    *(u32x4*)(rowp + bj * HALF) = o; } }
    }
};
struct EpiRes {
    static constexpr bool PERM = true;
    bf16_t* T; const float* X; const float* mod; int gidx; float* PART;
    __device__ __forceinline__ void operator()(const f32x4 (&acc)[2][2][4][2], const Unit& u, int wr, int wc, int fr, int fq) const {
        const int row0 = u.pm * BM + wr * 64 + fr, col0 = u.pn * BM + wc * 32 + 8 * fq;
        const int b = u.pm / 17, isctx = (u.pm - b * 17) == 0;
        const float* gv = mod + (size_t)(isctx ? 2 : b) * (6 * D) + (size_t)gidx * D;
#pragma unroll
        for (int bj = 0; bj < 2; ++bj) { const int col = col0 + bj * HALF; const f32x4 g0 = *(const f32x4*)(gv + col), g1 = *(const f32x4*)(gv + col + 4);
#pragma unroll
            for (int ai = 0; ai < 2; ++ai)
#pragma unroll
                for (int m = 0; m < 4; ++m) { const int row = row0 + ai * HALF + m * 16; const size_t o = (size_t)row * D + col;
                    const f32x4 t0 = g0 * acc[ai][bj][m][0], t1 = g1 * acc[ai][bj][m][1];
                    if (u.split) { float* pp = PART + ((size_t)u.slot * 512 + (row - u.pm * BM + (u.pm ? 256 : 0))) * D + col; *(f32x4*)pp = t0; *(f32x4*)(pp + 4) = t1; }
                    else { u32x4 ov; ov.x = pk2(t0[0], t0[1]); ov.y = pk2(t0[2], t0[3]); ov.z = pk2(t1[0], t1[1]); ov.w = pk2(t1[2], t1[3]); *(u32x4*)(T + o) = ov; } } }
    }
};
struct EpiBranch {
    static constexpr bool PERM = true;
    float* S; bf16_t* SB; const bf16_t* H; float* SCTX;
    __device__ __forceinline__ void operator()(const f32x4 (&acc)[2][2][4][2], const Unit& u, int wr, int wc, int fr, int fq) const {
        const int row0 = u.pm * BM + wr * 64 + fr, col0 = u.pn * BM + wc * 32 + 8 * fq; const int g = u.g;
#pragma unroll
        for (int ai = 0; ai < 2; ++ai)
#pragma unroll
            for (int m = 0; m < 4; ++m) { const int row = row0 + ai * HALF + m * 16;
#pragma unroll
                for (int bj = 0; bj < 2; ++bj) { const int col = col0 + bj * HALF;
                    float gt[8]; unpack8(*(const u32x4*)(H + (size_t)row * NPAD + C_GATE + g * D + col), gt);
                    float v[8];
#pragma unroll
                    for (int e = 0; e < 4; ++e) { v[e] = sigm(gt[e]) * acc[ai][bj][m][0][e]; v[4 + e] = sigm(gt[4 + e]) * acc[ai][bj][m][1][e]; }
                    if (u.split) { float* cp = SCTX + ((size_t)u.slot * 512 + (row - u.pm * BM + (u.pm ? 256 : 0))) * D + col;
                        *(f32x4*)cp = (f32x4){v[0], v[1], v[2], v[3]}; *(f32x4*)(cp + 4) = (f32x4){v[4], v[5], v[6], v[7]}; }
                    else {
                        bf16_t* sp = SB + (size_t)row * D + col;
                        if (g > 0) { float pv[8]; unpack8(*(const u32x4*)sp, pv);
#pragma unroll
                            for (int e = 0; e < 8; ++e) v[e] += pv[e]; }
                        u32x4 o; o.x = pk2(v[0], v[1]); o.y = pk2(v[2], v[3]); o.z = pk2(v[4], v[5]); o.w = pk2(v[6], v[7]); *(u32x4*)sp = o; } } }
    }
};
}

__device__ __forceinline__ void transpose_item(const float* __restrict__ W, int K, int N, bf16_t* __restrict__ WT, LAS float* scr, int item, int lane) {
    const int nblk = N / 32, kb = item / nblk, nb = item - kb * nblk, k0 = 64 * kb, n0 = 32 * nb;
#pragma unroll 8
    for (int i = 0; i < 32; ++i) { const int kk = 2 * i + (lane >> 5); scr[kk * 33 + (lane & 31)] = W[(size_t)(k0 + kk) * N + n0 + (lane & 31)]; }
    LDS_WAIT();
    const int c = lane & 7;
#pragma unroll
    for (int j = 0; j < 4; ++j) { const int n = (lane >> 3) + 8 * j; const LAS float* s = scr + (8 * c) * 33 + n;
        u32x4 o; o.x = pk2(s[0 * 33], s[1 * 33]); o.y = pk2(s[2 * 33], s[3 * 33]); o.z = pk2(s[4 * 33], s[5 * 33]); o.w = pk2(s[6 * 33], s[7 * 33]);
        *(u32x4*)(WT + (size_t)(n0 + n) * K + k0 + 8 * c) = o; }
    LDS_WAIT();
}

__device__ __forceinline__ void transpose_item64(const float* __restrict__ W, int K, int N, bf16_t* __restrict__ WT, LAS float* scr, int item, int lane) {
    const int nblk = (N + 63) >> 6, kb = item / nblk, nb = item - kb * nblk, k0 = 64 * kb, n0 = 64 * nb;
    const bool valid = (n0 + lane) < N;
    float wv[64];
    const float* wp = W + (size_t)k0 * N + n0 + (valid ? lane : 0);
#pragma unroll
    for (int i = 0; i < 64; ++i) wv[i] = __builtin_nontemporal_load(wp + (size_t)i * N);
#pragma unroll
    for (int i = 0; i < 64; ++i) scr[i * 65 + lane] = wv[i];
    LDS_WAIT();
#pragma unroll
    for (int j = 0; j < 8; ++j) { const int task = lane + 64 * j, n = task >> 3, c = task & 7; const LAS float* s = scr + (8 * c) * 65 + n;
        u32x4 o; o.x = pk2(s[0 * 65], s[1 * 65]); o.y = pk2(s[2 * 65], s[3 * 65]); o.z = pk2(s[4 * 65], s[5 * 65]); o.w = pk2(s[6 * 65], s[7 * 65]);
        if (n0 + n < N) *(u32x4*)(WT + (size_t)(n0 + n) * K + k0 + 8 * c) = o; }
    LDS_WAIT();
}

__device__ __forceinline__ void phase0(const Params& P, LAS unsigned char* lds) {
    const int tid = otid(), lane = tid & 63, wave = tid >> 6, G = gridDim.x;
    unsigned char* ws = P.ws;
    {
        LAS float* sil = (LAS float*)lds;
        LAS float* red = sil + 3 * 2048;
        for (int i = tid; i < 3 * 2048; i += NTHR) { const int v = i >> 11, k = i & 2047; const float x = (v < 2) ? P.in[1][v * 2048 + k] : P.in[3][k]; sil[i] = silu(x); }
        __syncthreads();
        for (int vb = blockIdx.x; vb < 256; vb += G) {
            const int colg = vb * 96, l = colg / 12288, cl = colg - l * 12288;
            if (tid < 504) {
                const int c4 = tid % 24, kg = tid / 24;
                f32x4 a0 = {0.f, 0.f, 0.f, 0.f}, a1 = a0, a2 = a0;
                const float* wp = P.in[4] + (size_t)l * 2048 * 12288 + cl + c4 * 4;
                int k = kg;
#pragma unroll 1
                for (; k + 21 * 15 < 2048; k += 21 * 16) {
                    f32x4 w[16];
#pragma unroll
                    for (int u = 0; u < 16; ++u) w[u] = __builtin_nontemporal_load((const f32x4*)(wp + (size_t)(k + 21 * u) * 12288));
#pragma unroll
                    for (int u = 0; u < 16; ++u) { a0 += sil[k + 21 * u] * w[u]; a1 += sil[2048 + k + 21 * u] * w[u]; a2 += sil[4096 + k + 21 * u] * w[u]; } }
                for (; k < 2048; k += 21) { const f32x4 w = *(const f32x4*)(wp + (size_t)k * 12288); a0 += sil[k] * w; a1 += sil[2048 + k] * w; a2 += sil[4096 + k] * w; }
                LAS float* rp = red + (kg * 24 + c4) * 12;
#pragma unroll
                for (int e = 0; e < 4; ++e) { rp[e] = a0[e]; rp[4 + e] = a1[e]; rp[8 + e] = a2[e]; }
            }
            __syncthreads();
            if (tid < 288) { const int c4 = tid / 12, ve = tid - c4 * 12, v = ve >> 2, e = ve & 3; float s = 0.f;
                for (int kg = 0; kg < 21; ++kg) s += red[(kg * 24 + c4) * 12 + ve];
                const int col = cl + c4 * 4 + e;
                ((float*)(ws + WS_MOD))[(size_t)(l * 3 + v) * 12288 + col] = s + P.in[5][l * 12288 + col]; }
            __syncthreads();
        }
    }
    {
        LAS float* feats = (LAS float*)lds;
        LAS float* hid1 = feats + 8 * 36;
        for (int item = blockIdx.x; item < 2 * 544; item += G) {
            const int l = item / 544, it = item - l * 544, lsel = it >= 512, L = lsel ? 256 : 4096, t0 = (lsel ? it - 512 : it) * 8;
            const int tt = tid >> 6, j = tid & 63, t = t0 + tt;
            if (j < 33) { float f;
                if (j == 0) f = (float)t / (float)(L - 1);
                else { const int bi = (j - 1) & 15; const float band = 1e-4f + (float)bi * ((15.f - 1e-4f) / 15.f); float rev = band * ((float)t / (float)L); rev = rev - floorf(rev);
                    f = (j <= 16) ? __builtin_amdgcn_cosf(rev) : -__builtin_amdgcn_sinf(rev); }
                feats[tt * 36 + j] = f; }
            __syncthreads();
            { const float* w1 = P.in[9] + (size_t)l * 33 * 64; float a = P.in[10][l * 64 + j];
              for (int f = 0; f < 33; ++f) a += feats[tt * 36 + f] * w1[f * 64 + j];
              hid1[tt * 64 + j] = sin_rad(a); }
            __syncthreads();
            { const float* w2 = P.in[11] + (size_t)l * 64 * 64; float a = P.in[12][l * 64 + j];
              for (int i = 0; i < 64; ++i) a += hid1[tt * 64 + i] * w2[i * 64 + j];
              float* hid = (float*)(ws + WS_HID + (size_t)l * SZ_HID1) + (lsel ? 64 * 4096 : 0);
              hid[(size_t)j * L + t] = sin_rad(a); }
            __syncthreads();
        }
    }
    if (tid == 0) (void)__hip_atomic_fetch_add((unsigned*)(ws + WS_BAR) + XB_CNT(xcc_id()), 1u, __ATOMIC_RELAXED, __HIP_MEMORY_SCOPE_AGENT);
    for (int i = blockIdx.x * NTHR + tid; i < DEPTH * 2 * 1024; i += G * NTHR) {
        const int l = i >> 11, dir = (i >> 10) & 1, ch = i & 1023;
        float x[DEPTH], mx = -1e30f;
#pragma unroll
        for (int q = 0; q < DEPTH; ++q) { x[q] = P.in[15][((size_t)dir * DEPTH + q) * 1024 + ch]; mx = fmaxf(mx, x[q]); }
        float den = 0.f, num = 0.f;
#pragma unroll
        for (int q = 0; q < DEPTH; ++q) { const float e = __expf(x[q] - mx); den += e; if (q >= 1 && q <= l) num += e; }
        ((float*)(ws + WS_LB))[i] = num / den;
    }
    for (int i = blockIdx.x * NTHR + tid; i < DEPTH * (NPAD - INC) * D / 8; i += G * NTHR) {
        const int per = (NPAD - INC) * D / 8, l = i / per, r = i - l * per;
        ((u32x4*)(ws + WS_WIN + (size_t)l * SZ_WIN + (size_t)INC * D * 2))[r] = (u32x4){0u, 0u, 0u, 0u};
    }
    {
        LAS float* scr = (LAS float*)(lds + wave * 16896);
        const int gw = blockIdx.x * NWAVES + wave, NGW = G * NWAVES;
        constexpr int I_IN = 32 * 273, I_BR = 16 * 32, I_OUT = 32 * 32, I_F1 = 32 * 128, I_F2 = 128 * 32;
        constexpr int PER = I_IN + 3 * I_BR + I_OUT + I_F1 + I_F2;
        for (int it = gw; it < (DEPTH - 1) * PER; it += NGW) {
            const int l = it / PER; int r = it - l * PER;
            if (r < I_IN) { transpose_item64(P.in[6] + (size_t)l * D * INC, D, INC, (bf16_t*)(ws + WS_WIN + (size_t)l * SZ_WIN), scr, r, lane); continue; } r -= I_IN;
            if (r < 3 * I_BR) { const int g = r / I_BR; transpose_item64(P.in[23] + (size_t)(l * 3 + g) * 1024 * D, 1024, D, (bf16_t*)(ws + WS_WBR + (size_t)(l * 3 + g) * SZ_WBR), scr, r - g * I_BR, lane); continue; } r -= 3 * I_BR;
            if (r < I_OUT) { transpose_item64(P.in[24] + (size_t)l * D * D, D, D, (bf16_t*)(ws + WS_WOUT + (size_t)l * SZ_WOUT), scr, r, lane); continue; } r -= I_OUT;
            if (r < I_F1) { transpose_item64(P.in[27] + (size_t)l * D * DFF, D, DFF, (bf16_t*)(ws + WS_WFF1 + (size_t)l * SZ_WFF), scr, r, lane); continue; } r -= I_F1;
            transpose_item64(P.in[28] + (size_t)l * DFF * D, DFF, D, (bf16_t*)(ws + WS_WFF2 + (size_t)l * SZ_WFF), scr, r, lane);
        }
    }
}

__device__ __forceinline__ void init_rows(const Params& P) {
    const int tid = otid(); const int lane = tid & 63, gw = blockIdx.x * NWAVES + (tid >> 6), NGW = gridDim.x * NWAVES;
    float* X = (float*)(P.ws + WS_X); bf16_t* U = (bf16_t*)(P.ws + WS_U); const float* mod = (const float*)(P.ws + WS_MOD);
#define INIT_SRC(r_) (((r_) % TPB) < CTX ? P.in[2] + ((size_t)((r_) / TPB) * CTX + ((r_) % TPB)) * D : P.in[0] + ((size_t)((r_) / TPB) * SEQ + (((r_) % TPB) - CTX)) * D)
    f32x4 cv[8];
#pragma unroll
    for (int j = 0; j < 8; ++j) cv[j] = (f32x4){0.f, 0.f, 0.f, 0.f};
    if (gw < M) { const float* s0 = INIT_SRC(gw);
#pragma unroll
        for (int j = 0; j < 8; ++j) cv[j] = __builtin_nontemporal_load((const f32x4*)(s0 + (j * 64 + lane) * 4)); }
#pragma unroll 1
    for (int r = gw; r < M; r += NGW) {
        const int b = r / TPB, p = r - b * TPB; const bool isctx = p < CTX;
        f32x4 nv[8];
#pragma unroll
        for (int j = 0; j < 8; ++j) nv[j] = (f32x4){0.f, 0.f, 0.f, 0.f};
        if (r + NGW < M) { const float* s1 = INIT_SRC(r + NGW);
#pragma unroll
            for (int j = 0; j < 8; ++j) nv[j] = __builtin_nontemporal_load((const f32x4*)(s1 + (j * 64 + lane) * 4)); }
        const float* mv = mod + (size_t)(isctx ? 2 : b) * (6 * D);
#pragma unroll
        for (int j = 0; j < 8; ++j) { const int c = (j * 64 + lane) * 4; const f32x4 v = cv[j];
            *(f32x4*)(X + (size_t)r * D + c) = v;
            const f32x4 sh = *(const f32x4*)(mv + c), sc = *(const f32x4*)(mv + D + c); const f32x4 y = v * (1.f + sc) + sh;
            u32x2 o; o.x = pk2(y[0], y[1]); o.y = pk2(y[2], y[3]); *(u32x2*)(U + (size_t)r * D + c) = o; }
#pragma unroll
        for (int j = 0; j < 8; ++j) cv[j] = nv[j];
    }
#undef INIT_SRC
}
__device__ __forceinline__ void ln_rows(const Params& P, const float* gam, const float* bet, const float* modU, int shidx, bool writeU, bool writeOut, int nsplit, bool skipctx) {
    const int tid = otid(); const int lane = tid & 63, gw = blockIdx.x * NWAVES + (tid >> 6), NGW = gridDim.x * NWAVES;
    float* X = (float*)(P.ws + WS_X); bf16_t* U = (bf16_t*)(P.ws + WS_U); const bf16_t* T = (const bf16_t*)(P.ws + WS_SO + (size_t)M * D * 4);
    f32x4 gv[8], bv[8];
#pragma unroll
    for (int j = 0; j < 8; ++j) { gv[j] = *(const f32x4*)(gam + (j * 64 + lane) * 4); bv[j] = *(const f32x4*)(bet + (j * 64 + lane) * 4); }
    int r = gw;
    while (r < M && skipctx && (r % TPB) < CTX) r += NGW;
    f32x4 cx[8]; u32x2 ct[8]; bool pf = false;
#pragma unroll
    for (int j = 0; j < 8; ++j) { cx[j] = (f32x4){0.f, 0.f, 0.f, 0.f}; ct[j] = (u32x2){0u, 0u}; }
    if (r < M && !((r % TPB) < CTX && nsplit > 0)) { pf = true;
#pragma unroll
        for (int j = 0; j < 8; ++j) { const int c = (j * 64 + lane) * 4; cx[j] = *(const f32x4*)(X + (size_t)r * D + c); ct[j] = *(const u32x2*)(T + (size_t)r * D + c); } }
#pragma unroll 1
    while (r < M) {
        int rn = r + NGW;
        while (rn < M && skipctx && (rn % TPB) < CTX) rn += NGW;
        f32x4 nx[8]; u32x2 nt[8]; bool npf = false;
#pragma unroll
        for (int j = 0; j < 8; ++j) { nx[j] = (f32x4){0.f, 0.f, 0.f, 0.f}; nt[j] = (u32x2){0u, 0u}; }
        if (rn < M && !((rn % TPB) < CTX && nsplit > 0)) { npf = true;
#pragma unroll
            for (int j = 0; j < 8; ++j) { const int c = (j * 64 + lane) * 4; nx[j] = *(const f32x4*)(X + (size_t)rn * D + c); nt[j] = *(const u32x2*)(T + (size_t)rn * D + c); } }
        const int b = r / TPB, p = r - b * TPB; const bool isctx = p < CTX;
        f32x4 v[8]; float s = 0.f;
#pragma unroll
        for (int j = 0; j < 8; ++j) { const int c = (j * 64 + lane) * 4;
            if (!pf) {
                f32x4 a = *(const f32x4*)(X + (size_t)r * D + c) * ALPHA; const float* pp = (const float*)(P.ws + WS_SCTX) + ((size_t)b * 256 + p) * D + c;
                for (int q = 0; q < nsplit; ++q) a += *(const f32x4*)(pp + (size_t)q * 512 * D);
                v[j] = a; }
            else v[j] = cx[j] * ALPHA + (f32x4){bflo(ct[j].x), bfhi(ct[j].x), bflo(ct[j].y), bfhi(ct[j].y)};
            s += (v[j][0] + v[j][1]) + (v[j][2] + v[j][3]); }
        const float mean = wave_sum(s) * (1.f / D); float s2 = 0.f;
#pragma unroll
        for (int j = 0; j < 8; ++j) { v[j] = v[j] - mean; s2 += (v[j][0] * v[j][0] + v[j][1] * v[j][1]) + (v[j][2] * v[j][2] + v[j][3] * v[j][3]); }
        const float rstd = __builtin_amdgcn_rsqf(wave_sum(s2) * (1.f / D) + 1e-5f);
        const float* mv = modU + (size_t)(isctx ? 2 : b) * (6 * D) + (size_t)shidx * D;
#pragma unroll
        for (int j = 0; j < 8; ++j) { const int c = (j * 64 + lane) * 4;
            const f32x4 y = v[j] * rstd * gv[j] + bv[j];
            if (!writeOut) *(f32x4*)(X + (size_t)r * D + c) = y;
            if (writeU) { const f32x4 sh = *(const f32x4*)(mv + c), sc = *(const f32x4*)(mv + D + c); const f32x4 z = y * (1.f + sc) + sh;
                u32x2 o; o.x = pk2(z[0], z[1]); o.y = pk2(z[2], z[3]); *(u32x2*)(U + (size_t)r * D + c) = o; }
            if (writeOut && !isctx) *(f32x4*)(P.out + ((size_t)b * SEQ + (p - CTX)) * D + c) = y; }
#pragma unroll
        for (int j = 0; j < 8; ++j) { cx[j] = nx[j]; ct[j] = nt[j]; }
        pf = npf; r = rn;
    }
}

__device__ __forceinline__ void prep_phase(const Params& P, int l, LAS unsigned char* lds) {
    const int tid = otid(), lane = tid & 63, wave = tid >> 6, G = gridDim.x;
    const int gw = blockIdx.x * NWAVES + wave, NGW = G * NWAVES;
    unsigned char* ws = P.ws;
    const bf16_t* H = (const bf16_t*)(ws + WS_H);
    float* DNK = (float*)(ws + WS_DN + OFF_DNK); float* DNQ = (float*)(ws + WS_DN + OFF_DNQ); float* DNV = (float*)(ws + WS_DN + OFF_DNV); float* DNS = (float*)(ws + WS_DN + OFF_DNS);
    {
        const u32x4 z4 = {0u, 0u, 0u, 0u};
#define DNP_LOAD(hu, ga, gb, row) do { const int p_ = (row) % TPB; \
            const bool hasL_ = (p_ < CTX) ? (p_ > 0) : ((p_ & 63) != 0), hasR_ = (p_ < CTX) ? (p_ < CTX - 1) : ((p_ & 63) != 63); \
            const bf16_t* h_ = H + (size_t)(row) * NPAD; \
            _Pragma("unroll") for (int w_ = 0; w_ < 4; ++w_) { const int col_ = (w_ == 0 ? C_DNK : w_ == 1 ? C_DNQ : C_DNV + (w_ - 2) * 512) + lane * 8; \
                hu[3 * w_ + 0] = hasL_ ? *(const u32x4*)(h_ - NPAD + col_) : z4; hu[3 * w_ + 1] = *(const u32x4*)(h_ + col_); hu[3 * w_ + 2] = hasR_ ? *(const u32x4*)(h_ + NPAD + col_) : z4; } \
            ga = h_[C_DNA + (lane & 15)]; gb = h_[C_DNB + (lane & 15)]; } while (0)
        float cwk[3][8], cwq[3][8], cwv[2][3][8];
#pragma unroll
        for (int j = 0; j < 3; ++j)
#pragma unroll
            for (int e = 0; e < 8; ++e) { cwk[j][e] = P.in[18][(size_t)l * 3 * 512 + j * 512 + lane * 8 + e]; cwq[j][e] = P.in[17][(size_t)l * 3 * 512 + j * 512 + lane * 8 + e];
                cwv[0][j][e] = P.in[19][(size_t)l * 3 * 1024 + j * 1024 + lane * 8 + e]; cwv[1][j][e] = P.in[19][(size_t)l * 3 * 1024 + j * 1024 + 512 + lane * 8 + e]; }
        int r = gw;
        u32x4 ch_[12]; bf16_t cga = 0, cgb = 0;
#pragma unroll
        for (int i = 0; i < 12; ++i) ch_[i] = z4;
        if (r < M) DNP_LOAD(ch_, cga, cgb, r);
#pragma unroll 1
        while (r < M) {
            const int rn_ = r + NGW;
            u32x4 nh_[12]; bf16_t nga = 0, ngb = 0;
#pragma unroll
            for (int i = 0; i < 12; ++i) nh_[i] = z4;
            if (rn_ < M) DNP_LOAD(nh_, nga, ngb, rn_);
            float kn[8], qn[8];
#pragma unroll
            for (int which = 0; which < 2; ++which) {
                float xm[8], x0[8], xp[8]; unpack8(ch_[3 * which], xm); unpack8(ch_[3 * which + 1], x0); unpack8(ch_[3 * which + 2], xp);
                float y[8], ss = 0.f;
#pragma unroll
                for (int e = 0; e < 8; ++e) { y[e] = silu(xm[e] * (which ? cwq[0][e] : cwk[0][e]) + x0[e] * (which ? cwq[1][e] : cwk[1][e]) + xp[e] * (which ? cwq[2][e] : cwk[2][e])); ss += y[e] * y[e]; }
                ss = row_sum16(ss);
                const float rn = __builtin_amdgcn_rsqf(ss + 1e-6f) * (which ? 0.08838834764831845f : 1.f);
#pragma unroll
                for (int e = 0; e < 8; ++e) { if (which) qn[e] = y[e] * rn; else kn[e] = y[e] * rn; }
            }
            float qk = 0.f;
#pragma unroll
            for (int e = 0; e < 8; ++e) qk += qn[e] * kn[e];
            qk = row_sum16(qk);
            *(f32x4*)(DNK + (size_t)r * 512 + lane * 8) = (f32x4){kn[0], kn[1], kn[2], kn[3]}; *(f32x4*)(DNK + (size_t)r * 512 + lane * 8 + 4) = (f32x4){kn[4], kn[5], kn[6], kn[7]};
            *(f32x4*)(DNQ + (size_t)r * 512 + lane * 8) = (f32x4){qn[0], qn[1], qn[2], qn[3]}; *(f32x4*)(DNQ + (size_t)r * 512 + lane * 8 + 4) = (f32x4){qn[4], qn[5], qn[6], qn[7]};
#pragma unroll
            for (int half = 0; half < 2; ++half) {
                const int cc = half * 512 + lane * 8;
                float xm[8], x0[8], xp[8]; unpack8(ch_[6 + 3 * half], xm); unpack8(ch_[6 + 3 * half + 1], x0); unpack8(ch_[6 + 3 * half + 2], xp);
                float y[8];
#pragma unroll
                for (int e = 0; e < 8; ++e) y[e] = silu(xm[e] * cwv[half][0][e] + x0[e] * cwv[half][1][e] + xp[e] * cwv[half][2][e]);
                *(f32x4*)(DNV + (size_t)r * 1024 + cc) = (f32x4){y[0], y[1], y[2], y[3]}; *(f32x4*)(DNV + (size_t)r * 1024 + cc + 4) = (f32x4){y[4], y[5], y[6], y[7]};
            }
            {
                const int hd = lane & 7, dir = (lane >> 3) & 1;
                const float qkh = __shfl(qk, 16 * (hd >> 1));
                if (lane < 16) {
                    const float araw = bf1(cga), braw = bf1(cgb);
                    const float xx = araw + P.in[21][(l * 2 + dir) * 8 + hd];
                    float sp; if (xx > 15.f) sp = xx; else { const float e = __expf(xx); sp = (e < 1e-3f) ? e * (1.f - e * (0.5f - e * (1.f / 3.f))) : __logf(1.f + e); }
                    const float gg = -__expf(P.in[20][(l * 2 + dir) * 8 + hd]) * sp;
                    *(f32x4*)(DNS + ((size_t)r * 16 + dir * 8 + hd) * 4) = (f32x4){__expf(gg), sigm(braw), qkh, gg};
                }
            }
#pragma unroll
            for (int i = 0; i < 12; ++i) ch_[i] = nh_[i];
            cga = nga; cgb = ngb; r = rn_;
        }
#undef DNP_LOAD
    }
    {
        LAS float* L = (LAS float*)lds;
        unsigned* ZT = (unsigned*)(ws + WS_ZT);
#define HYP_LOAD(hv_, item_) do { const int ti_ = (item_) / 48, ct_ = (item_) - ti_ * 48; \
            _Pragma("unroll") for (int u = 0; u < 2; ++u) { const int rowi = (tid >> 3) + 64 * u, bb = rowi >> 6, tt = rowi & 63, ch8 = tid & 7; \
                hv_[u] = *(const u32x4*)(H + ((size_t)bb * TPB + CTX + ti_ * 64 + tt) * NPAD + C_HY + ct_ * 64 + ch8 * 8); } } while (0)
        u32x4 chv[2] = {(u32x4){0u, 0u, 0u, 0u}, (u32x4){0u, 0u, 0u, 0u}};
        if ((int)blockIdx.x < 64 * 48) HYP_LOAD(chv, blockIdx.x);
#pragma unroll 1
        for (int item = blockIdx.x; item < 64 * 48; item += G) {
            const int ti = item / 48, ct = item - ti * 48;
            u32x4 nhv[2] = {(u32x4){0u, 0u, 0u, 0u}, (u32x4){0u, 0u, 0u, 0u}};
            if (item + G < 64 * 48) HYP_LOAD(nhv, item + G);
#pragma unroll
            for (int u = 0; u < 2; ++u) { const int rowi = (tid >> 3) + 64 * u, bb = rowi >> 6, tt = rowi & 63, ch8 = tid & 7;
                float f[8]; unpack8(chv[u], f);
#pragma unroll
                for (int e = 0; e < 8; ++e) L[(bb * 64 + tt) * 65 + ch8 * 8 + e] = f[e]; }
            asm volatile("s_waitcnt lgkmcnt(0)" ::: "memory"); __builtin_amdgcn_s_barrier(); asm volatile("" ::: "memory");
            { const int tt = tid & 63;
#pragma unroll
              for (int u = 0; u < 8; ++u) { const int cc = (tid >> 6) + 8 * u, ch = ct * 64 + cc;
                const float* cw = P.in[7] + (size_t)l * 3 * 3072 + ch; const float w0 = cw[0], w1 = cw[3072], w2 = cw[6144], bias = P.in[8][l * 3072 + ch];
                f32x2 o;
#pragma unroll
                for (int bb = 0; bb < 2; ++bb) { const LAS float* lp = L + (bb * 64 + tt) * 65 + cc;
                    const float xm = tt > 0 ? lp[-65] : 0.f, xp = tt < 63 ? lp[65] : 0.f; o[bb] = xm * w0 + lp[0] * w1 + xp * w2 + bias; }
                ZT[(size_t)ch * 4096 + ti * 64 + tt] = pk2(o[0], o[1]); } }
            asm volatile("s_waitcnt lgkmcnt(0)" ::: "memory"); __builtin_amdgcn_s_barrier(); asm volatile("" ::: "memory");
            chv[0] = nhv[0]; chv[1] = nhv[1];
        }
#undef HYP_LOAD
    }
    if (l == 0) {
        float* ZC = (float*)(ws + WS_ZC);
        for (int i = blockIdx.x * NTHR + tid; i < 2 * 256 * 3072; i += G * NTHR) {
            const int ch = i % 3072, bt = i / 3072, t = bt & 255, bb = bt >> 8;
            const bf16_t* hp = H + ((size_t)bb * TPB + t) * NPAD + C_HY + ch;
            const float* cw = P.in[7] + ch;
            const float xm = t > 0 ? bf1(hp[-NPAD]) : 0.f, xp = t < 255 ? bf1(hp[NPAD]) : 0.f;
            ZC[i] = xm * cw[0] + bf1(hp[0]) * cw[3072] + xp * cw[6144] + P.in[8][ch];
        }
    }
}

__device__ __forceinline__ void chunkprep_phase(const Params& P, LAS unsigned char* lds) {
    const int tid = otid(), lane = tid & 63, wave = tid >> 6, t = lane & 15, kq = lane >> 4;
    const int gw = blockIdx.x * NWAVES + wave, NGW = gridDim.x * NWAVES;
    unsigned char* ws = P.ws;
    const float* DNK = (const float*)(ws + WS_DN + OFF_DNK); const float* DNQ = (const float*)(ws + WS_DN + OFF_DNQ); const float* DNS = (const float*)(ws + WS_DN + OFF_DNS);
    LAS float* Kf = (LAS float*)(lds + wave * 16384);
    LAS bf16_t* Wb = (LAS bf16_t*)(Kf + 16 * 132);
    LAS float* Am = (LAS float*)(Wb + 16 * 136);
    LAS float* St = Am + 256;
    LAS float* Tt = St + 272;
    LAS float* be = Tt + 272;
#pragma unroll 1
    for (int task = gw; task < NTASK; task += NGW) {
        const int c = task % NCHUNK, grp = task / NCHUNK, dir = grp & 1, h = (grp >> 1) & 7, b = grp >> 4;
        const int n0 = c * 16, plo = dir ? (n0 < 256 ? 240 - n0 : TPB + 240 - n0) : n0;
        const size_t prow = (size_t)b * TPB + (dir ? plo + 15 - t : plo + t);
        const float* kp = DNK + prow * 512 + (h >> 1) * 128 + 4 * kq; const float* qp = DNQ + prow * 512 + (h >> 1) * 128 + 4 * kq;
        f32x4 ka[4], kb[4], qa[4], qb[4];
#pragma unroll
        for (int j = 0; j < 4; ++j) { ka[j] = *(const f32x4*)(kp + 32 * j); kb[j] = *(const f32x4*)(kp + 32 * j + 16); qa[j] = *(const f32x4*)(qp + 32 * j); qb[j] = *(const f32x4*)(qp + 32 * j + 16); }
        const f32x4 sc = *(const f32x4*)(DNS + (prow * 16 + dir * 8 + h) * 4);
        const float beta = sc[1];
        float gc = sc[3];
        gc += dppf<0x111>(gc); gc += dppf<0x112>(gc); gc += dppf<0x114>(gc); gc += dppf<0x118>(gc);
        const float gC = __shfl(gc, 15);
        const float egc = __expf(gc);
#pragma unroll
        for (int j = 0; j < 4; ++j) { *(LAS f32x4*)(Kf + t * 132 + 32 * j + 4 * kq) = ka[j]; *(LAS f32x4*)(Kf + t * 132 + 32 * j + 16 + 4 * kq) = kb[j]; }
        if (kq == 0) be[t] = beta * egc;
        f32x4 KK = {0.f, 0.f, 0.f, 0.f}, QK = KK;
#pragma unroll
        for (int j = 0; j < 4; ++j) {
            float kv[8] = {ka[j][0], ka[j][1], ka[j][2], ka[j][3], kb[j][0], kb[j][1], kb[j][2], kb[j][3]};
            float qv[8] = {qa[j][0], qa[j][1], qa[j][2], qa[j][3], qb[j][0], qb[j][1], qb[j][2], qb[j][3]};
            u32x4 kh, kl, qh, ql;
#pragma unroll
            for (int e = 0; e < 4; ++e) { const unsigned hh = pk2n(kv[2 * e], kv[2 * e + 1]); kh[e] = hh; kl[e] = pk2n(kv[2 * e] - bflo(hh), kv[2 * e + 1] - bfhi(hh));
                const unsigned gh = pk2n(qv[2 * e], qv[2 * e + 1]); qh[e] = gh; ql[e] = pk2n(qv[2 * e] - bflo(gh), qv[2 * e + 1] - bfhi(gh)); }
            const bf16x8 Kh = __builtin_bit_cast(bf16x8, kh), Kl = __builtin_bit_cast(bf16x8, kl), Qh = __builtin_bit_cast(bf16x8, qh), Ql = __builtin_bit_cast(bf16x8, ql);
            KK = __builtin_amdgcn_mfma_f32_16x16x32_bf16(Kh, Kh, KK, 0, 0, 0); KK = __builtin_amdgcn_mfma_f32_16x16x32_bf16(Kh, Kl, KK, 0, 0, 0); KK = __builtin_amdgcn_mfma_f32_16x16x32_bf16(Kl, Kh, KK, 0, 0, 0);
            QK = __builtin_amdgcn_mfma_f32_16x16x32_bf16(Qh, Kh, QK, 0, 0, 0); QK = __builtin_amdgcn_mfma_f32_16x16x32_bf16(Qh, Kl, QK, 0, 0, 0); QK = __builtin_amdgcn_mfma_f32_16x16x32_bf16(Ql, Kh, QK, 0, 0, 0);
            u32x4 fq; fq[0] = pk2n(qv[0] * egc, qv[1] * egc); fq[1] = pk2n(qv[2] * egc, qv[3] * egc); fq[2] = pk2n(qv[4] * egc, qv[5] * egc); fq[3] = pk2n(qv[6] * egc, qv[7] * egc);
            *(u32x4*)(ws + WS_CP1 + (size_t)task * CP1_STRIDE + 4096 + (size_t)(j * 64 + lane) * 16) = fq;
        }
#pragma unroll
        for (int e = 0; e < 4; ++e) { const int tp = 4 * kq + e; const float gct = __shfl(gc, tp), bt = __shfl(beta, tp);
            const float dec = __expf(fminf(gct - gc, 0.f));
            Am[tp * 16 + t] = (t < tp) ? bt * KK[e] * dec : 0.f;
            St[tp * 17 + t] = (t <= tp) ? QK[e] * dec : 0.f; }
        LDS_WAIT();
        {
            u32x2 fa; fa[0] = pk2n(St[t * 17 + 4 * kq], St[t * 17 + 4 * kq + 1]); fa[1] = pk2n(St[t * 17 + 4 * kq + 2], St[t * 17 + 4 * kq + 3]);
            *(u32x2*)(ws + WS_CP2 + (size_t)task * CP2_STRIDE + (size_t)lane * 8) = fa;
            float ds[4];
#pragma unroll
            for (int e = 0; e < 4; ++e) ds[e] = __expf(gC - __shfl(gc, 4 * kq + e));
#pragma unroll
            for (int m = 0; m < 8; ++m) { u32x2 fk;
                fk[0] = pk2n(Kf[(4 * kq + 0) * 132 + 16 * m + t] * ds[0], Kf[(4 * kq + 1) * 132 + 16 * m + t] * ds[1]);
                fk[1] = pk2n(Kf[(4 * kq + 2) * 132 + 16 * m + t] * ds[2], Kf[(4 * kq + 3) * 132 + 16 * m + t] * ds[3]);
                *(u32x2*)(ws + WS_CPK + (size_t)task * 4096 + (size_t)(m * 64 + lane) * 8) = fk; }
        }
#pragma unroll 1
        for (int pass = 0; pass < 3; ++pass) {
            if (pass < 2 || lane < 16) {
                const int col = (pass & 1) * 64 + lane;
                float x[16];
#pragma unroll
                for (int tt = 0; tt < 16; ++tt) {
                    float acc = (pass < 2) ? be[tt] * Kf[tt * 132 + col] : ((tt == lane) ? 1.f : 0.f);
#pragma unroll
                    for (int s = 0; s < tt; ++s) acc -= Am[tt * 16 + s] * x[s];
                    x[tt] = acc;
                    if (pass < 2) Wb[tt * 136 + col] = (bf16_t)(pk2n(acc, 0.f) & 0xffffu); else Tt[tt * 17 + lane] = acc; }
            }
        }
        LDS_WAIT();
        {
#pragma unroll
            for (int j = 0; j < 4; ++j) { const u32x2 lo = *(const LAS u32x2*)(Wb + t * 136 + 32 * j + 4 * kq), hi = *(const LAS u32x2*)(Wb + t * 136 + 32 * j + 16 + 4 * kq);
                *(u32x4*)(ws + WS_CP1 + (size_t)task * CP1_STRIDE + (size_t)(j * 64 + lane) * 16) = (u32x4){lo[0], lo[1], hi[0], hi[1]}; }
            u32x2 ft; ft[0] = pk2n(Tt[t * 17 + 4 * kq], Tt[t * 17 + 4 * kq + 1]); ft[1] = pk2n(Tt[t * 17 + 4 * kq + 2], Tt[t * 17 + 4 * kq + 3]);
            *(u32x2*)(ws + WS_CP2 + (size_t)task * CP2_STRIDE + 512 + (size_t)lane * 8) = ft;
            float* misc = (float*)(ws + WS_CP2 + (size_t)task * CP2_STRIDE + 1024);
            if (lane < 16) misc[lane] = beta; else if (lane == 16) misc[16] = __expf(gC);
        }
        LDS_WAIT();
    }
}

__device__ __forceinline__ void hgprep_phase(const Params& P, int l, LAS unsigned char* lds) {
    const int tid = otid(), lane = tid & 63, wave = tid >> 6, t = lane & 15, kq = lane >> 4;
    const int gw = blockIdx.x * NWAVES + wave, NGW = gridDim.x * NWAVES;
    unsigned char* ws = P.ws;
    const bf16_t* H = (const bf16_t*)(ws + WS_H);
    LAS float* Kf = (LAS float*)(lds + wave * 16384);
    LAS float* St = Kf + 16 * 132;
#pragma unroll 1
    for (int task = gw; task < NTASK; task += NGW) {
        const int c = task % NCHUNK, grp = task / NCHUNK, dir = grp & 1, h = (grp >> 1) & 7, b = grp >> 4;
        const int n0 = c * 16, plo = dir ? (n0 < 256 ? 240 - n0 : TPB + 240 - n0) : n0;
        const size_t prow = (size_t)b * TPB + (dir ? plo + 15 - t : plo + t);
        const bf16_t* hp = H + prow * NPAD + h * 128 + 4 * kq;
        const float* lbp = (const float*)(ws + WS_LB) + ((size_t)l * 2 + dir) * 1024 + h * 128 + 4 * kq;
        float L[32], kk[32], q[32];
#pragma unroll
        for (int j = 0; j < 4; ++j)
#pragma unroll
            for (int hh = 0; hh < 2; ++hh) { const int ko = 32 * j + 16 * hh;
                const u32x2 fr = *(const u32x2*)(hp + (dir ? C_HGFB : C_HGFF) + ko), qr = *(const u32x2*)(hp + C_HGQ + ko); const f32x4 lb = *(const f32x4*)(lbp + ko);
                const float fx[4] = {bflo(fr[0]), bfhi(fr[0]), bflo(fr[1]), bfhi(fr[1])}, qx[4] = {bflo(qr[0]), bfhi(qr[0]), bflo(qr[1]), bfhi(qr[1])};
#pragma unroll
                for (int e = 0; e < 4; ++e) { const int ix = 8 * j + 4 * hh + e; const float f = lb[e] + (1.f - lb[e]) * sigm(fx[e]);
                    L[ix] = __logf(fmaxf(f, 1e-30f)); kk[ix] = 1.f - f; q[ix] = silu(qx[e]); } }
        float Lt15[32];
#pragma unroll
        for (int ix = 0; ix < 32; ++ix) { float x = L[ix]; Lt15[ix] = row_sum16(x); x += dppf<0x111>(x); x += dppf<0x112>(x); x += dppf<0x114>(x); x += dppf<0x118>(x); L[ix] = x; }
        f32x4 Att = {0.f, 0.f, 0.f, 0.f};
#pragma unroll
        for (int j = 0; j < 4; ++j) {
            u32x4 fqv, qp, kp; float khat[8];
#pragma unroll
            for (int e2 = 0; e2 < 4; ++e2) {
                float qt[2], qq[2], kx[2];
#pragma unroll
                for (int z = 0; z < 2; ++z) { const int ix = 8 * j + 2 * e2 + z; const float Lt = L[ix];
                    const float L15 = Lt15[ix];
                    qt[z] = q[ix] * __expf(Lt);
                    const float d = fminf(Lt - L15, 80.f);
                    qq[z] = q[ix] * __expf(d); kx[z] = kk[ix] * __expf(-d);
                    khat[2 * e2 + z] = kx[z];
                    if (t == 15) ((float*)(ws + WS_HGA + (size_t)task * 1024 + 512))[32 * j + 16 * ((2 * e2 + z) >> 2) + 4 * kq + ((2 * e2 + z) & 3)] = __expf(Lt); }
                fqv[e2] = pk2n(qt[0], qt[1]); qp[e2] = pk2n(qq[0], qq[1]); kp[e2] = pk2n(kx[0], kx[1]); }
            *(u32x4*)(ws + WS_HGQ + (size_t)task * 4096 + (size_t)(j * 64 + lane) * 16) = fqv;
            Att = __builtin_amdgcn_mfma_f32_16x16x32_bf16(__builtin_bit_cast(bf16x8, qp), __builtin_bit_cast(bf16x8, kp), Att, 0, 0, 0);
            *(LAS f32x4*)(Kf + t * 132 + 32 * j + 4 * kq) = (f32x4){khat[0], khat[1], khat[2], khat[3]};
            *(LAS f32x4*)(Kf + t * 132 + 32 * j + 16 + 4 * kq) = (f32x4){khat[4], khat[5], khat[6], khat[7]};
        }
#pragma unroll
        for (int e = 0; e < 4; ++e) { const int tp = 4 * kq + e; St[tp * 17 + t] = (t <= tp) ? Att[e] : 0.f; }
        LDS_WAIT();
        { u32x2 fa; fa[0] = pk2n(St[t * 17 + 4 * kq], St[t * 17 + 4 * kq + 1]); fa[1] = pk2n(St[t * 17 + 4 * kq + 2], St[t * 17 + 4 * kq + 3]);
          *(u32x2*)(ws + WS_HGA + (size_t)task * 1024 + (size_t)lane * 8) = fa;
#pragma unroll
          for (int m = 0; m < 8; ++m) { u32x2 fk;
              fk[0] = pk2n(Kf[(4 * kq + 0) * 132 + 16 * m + t], Kf[(4 * kq + 1) * 132 + 16 * m + t]);
              fk[1] = pk2n(Kf[(4 * kq + 2) * 132 + 16 * m + t], Kf[(4 * kq + 3) * 132 + 16 * m + t]);
              *(u32x2*)(ws + WS_HGK + (size_t)task * 4096 + (size_t)(m * 64 + lane) * 8) = fk; } }
        LDS_WAIT();
    }
}

constexpr int T32_IN = 32 * 545, T32_BR = 16 * 64, T32_OUT = 32 * 64, T32_F1 = 32 * 256, T32_F2 = 128 * 64, T32_PER = T32_IN + 3 * T32_BR + T32_OUT + T32_F1 + T32_F2;
struct TItem { const float* W; bf16_t* WT; int K, N, k0, n0; };
__device__ __forceinline__ TItem titem_decode(const Params& P, int l, int r) {
    unsigned char* ws = P.ws; TItem t; int item;
    if (r < T32_IN) { t.W = P.in[6] + (size_t)l * D * INC; t.K = D; t.N = INC; t.WT = (bf16_t*)(ws + WS_WIN + (size_t)l * SZ_WIN); item = r; }
    else if ((r -= T32_IN) < 3 * T32_BR) { const int g = r / T32_BR; t.W = P.in[23] + (size_t)(l * 3 + g) * 1024 * D; t.K = 1024; t.N = D; t.WT = (bf16_t*)(ws + WS_WBR + (size_t)(l * 3 + g) * SZ_WBR); item = r - g * T32_BR; }
    else if ((r -= 3 * T32_BR) < T32_OUT) { t.W = P.in[24] + (size_t)l * D * D; t.K = D; t.N = D; t.WT = (bf16_t*)(ws + WS_WOUT + (size_t)l * SZ_WOUT); item = r; }
    else if ((r -= T32_OUT) < T32_F1) { t.W = P.in[27] + (size_t)l * D * DFF; t.K = D; t.N = DFF; t.WT = (bf16_t*)(ws + WS_WFF1 + (size_t)l * SZ_WFF); item = r; }
    else { r -= T32_F1; t.W = P.in[28] + (size_t)l * DFF * D; t.K = DFF; t.N = D; t.WT = (bf16_t*)(ws + WS_WFF2 + (size_t)l * SZ_WFF); item = r; }
    const int nblk = t.N / 32, kb = item / nblk, nb = item - kb * nblk; t.k0 = 64 * kb; t.n0 = 32 * nb;
    return t;
}
#define TSTAGE1(wv, ti) do { const TItem t_ = titem_decode(P, DEPTH - 1, (ti)); const float* wp_ = t_.W + (size_t)(t_.k0 + (lane >> 5)) * t_.N + t_.n0 + (lane & 31); \
    _Pragma("unroll") for (int i_ = 0; i_ < 32; ++i_) wv[i_] = __builtin_nontemporal_load(wp_ + (size_t)(2 * i_) * t_.N); } while (0)
#define TSTAGE2(wv, ti, scr) do { const TItem t_ = titem_decode(P, DEPTH - 1, (ti)); \
    _Pragma("unroll") for (int i_ = 0; i_ < 32; ++i_) (scr)[(2 * i_ + (lane >> 5)) * 33 + (lane & 31)] = wv[i_]; \
    LDS_WAIT(); \
    { const int c_ = lane & 7; _Pragma("unroll") for (int j_ = 0; j_ < 4; ++j_) { const int n_ = (lane >> 3) + 8 * j_; const LAS float* s_ = (scr) + (8 * c_) * 33 + n_; \
        u32x4 o_; o_.x = pk2(s_[0 * 33], s_[1 * 33]); o_.y = pk2(s_[2 * 33], s_[3 * 33]); o_.z = pk2(s_[4 * 33], s_[5 * 33]); o_.w = pk2(s_[6 * 33], s_[7 * 33]); \
        *(u32x4*)(t_.WT + (size_t)(t_.n0 + n_) * t_.K + t_.k0 + 8 * c_) = o_; } } \
    LDS_WAIT(); } while (0)

#define SCAN_BAR() do { asm volatile("s_waitcnt lgkmcnt(0)" ::: "memory"); __builtin_amdgcn_s_barrier(); asm volatile("" ::: "memory"); } while (0)
__device__ __forceinline__ void scan_phase(const Params& P, int l, LAS unsigned char* lds) {
    const int tid = otid(), wid = __builtin_amdgcn_readfirstlane(tid >> 6), lane = tid & 63, col = lane & 15, quad = lane >> 4;
    unsigned char* ws = P.ws;
    const bf16_t* H = (const bf16_t*)(ws + WS_H);
    const float* DNV = (const float*)(ws + WS_DN + OFF_DNV);
    constexpr int TS = 16, NT = NCHUNK;
    constexpr int SLOT = 25856, HGO = 15616;
    const f32x4 zero4 = {0.f, 0.f, 0.f, 0.f};
    for (int vb = blockIdx.x; vb < 256; vb += gridDim.x) {
        const int xcd = vb & 7, idx = vb >> 3, grp = xcd * 4 + (idx >> 3), sub = idx & 7;
        const int b = grp >> 4, h = (grp >> 1) & 7, dir = grp & 1, col0 = sub * 16;
        const size_t rowbase = (size_t)b * TPB;
        if (wid == 0) {
            bf16_t* Odn = (bf16_t*)(ws + WS_SO + (size_t)(2 + dir) * SZ_SOB);
            f32x4 St[8];
#pragma unroll
            for (int m = 0; m < 8; ++m) St[m] = zero4;
#pragma unroll 1
            for (int it = -4; it < NT; ++it) {
                if (it >= 0) {
                    const LAS unsigned char* sl = lds + (it & 1) * SLOT;
                    const int n0 = it * TS; const int plo = dir ? (n0 < 256 ? 256 - TS - n0 : TPB + 256 - TS - n0) : n0;
                    u32x4 fw[4], fq[4]; u32x2 fk[8];
#pragma unroll
                    for (int j = 0; j < 4; ++j) { fw[j] = *(const LAS u32x4*)(sl + (j * 64 + lane) * 16); fq[j] = *(const LAS u32x4*)(sl + 4096 + (j * 64 + lane) * 16); }
#pragma unroll
                    for (int m = 0; m < 8; ++m) fk[m] = *(const LAS u32x2*)(sl + 8192 + (m * 64 + lane) * 8);
                    const u32x2 fa = *(const LAS u32x2*)(sl + 12288 + lane * 8), ft = *(const LAS u32x2*)(sl + 12800 + lane * 8);
                    const f32x4 b4 = *(const LAS f32x4*)(sl + 13312 + lane * 16), v4 = *(const LAS f32x4*)(sl + 14336 + lane * 16);
                    const float egC = *(const LAS float*)(sl + 15360);
                    bf16x8 sf[4];
#pragma unroll
                    for (int j = 0; j < 4; ++j) sf[j] = __builtin_bit_cast(bf16x8, (u32x4){pk2n(St[2 * j][0], St[2 * j][1]), pk2n(St[2 * j][2], St[2 * j][3]), pk2n(St[2 * j + 1][0], St[2 * j + 1][1]), pk2n(St[2 * j + 1][2], St[2 * j + 1][3])});
                    const bf16x8 bv = __builtin_bit_cast(bf16x8, (u32x4){pk2n(b4[0] * v4[0], b4[1] * v4[1]), pk2n(b4[2] * v4[2], b4[3] * v4[3]), 0u, 0u});
                    const bf16x8 FT8 = __builtin_bit_cast(bf16x8, (u32x4){ft[0], ft[1], 0u, 0u}), FA8 = __builtin_bit_cast(bf16x8, (u32x4){fa[0], fa[1], 0u, 0u});
                    const f32x4 U = __builtin_amdgcn_mfma_f32_16x16x32_bf16(FT8, bv, zero4, 0, 0, 0);
                    f32x4 Pw = zero4, O = zero4;
#pragma unroll
                    for (int j = 0; j < 4; ++j) { Pw = __builtin_amdgcn_mfma_f32_16x16x32_bf16(__builtin_bit_cast(bf16x8, fw[j]), sf[j], Pw, 0, 0, 0);
                        O = __builtin_amdgcn_mfma_f32_16x16x32_bf16(__builtin_bit_cast(bf16x8, fq[j]), sf[j], O, 0, 0, 0); }
                    const f32x4 Vn = U - Pw;
                    const bf16x8 vn8 = __builtin_bit_cast(bf16x8, (u32x4){pk2n(Vn[0], Vn[1]), pk2n(Vn[2], Vn[3]), 0u, 0u});
                    O = __builtin_amdgcn_mfma_f32_16x16x32_bf16(FA8, vn8, O, 0, 0, 0);
#pragma unroll
                    for (int m = 0; m < 8; ++m) St[m] = __builtin_amdgcn_mfma_f32_16x16x32_bf16(__builtin_bit_cast(bf16x8, (u32x4){fk[m][0], fk[m][1], 0u, 0u}), vn8, St[m] * egC, 0, 0, 0);
#pragma unroll
                    for (int e = 0; e < 4; ++e) { const int t = 4 * quad + e; const int p = dir ? plo + TS - 1 - t : plo + t;
                        Odn[(rowbase + p) * 1024 + h * 128 + col0 + col] = (bf16_t)(pk2n(O[e], 0.f) & 0xffffu); }
                }
                SCAN_BAR();
            }
        } else if (wid == 1) {
            bf16_t* Ohg = (bf16_t*)(ws + WS_SO + (size_t)dir * SZ_SOB);
            f32x4 St[8];
#pragma unroll
            for (int m = 0; m < 8; ++m) St[m] = zero4;
#pragma unroll 1
            for (int it = -4; it < NT; ++it) {
                if (it >= 0) {
                    const LAS unsigned char* sl = lds + (it & 1) * SLOT + HGO;
                    const int n0 = it * TS; const int plo = dir ? (n0 < 256 ? 256 - TS - n0 : TPB + 256 - TS - n0) : n0;
                    u32x4 fq[4]; u32x2 fk[8]; f32x4 p15[8];
#pragma unroll
                    for (int j = 0; j < 4; ++j) fq[j] = *(const LAS u32x4*)(sl + (j * 64 + lane) * 16);
#pragma unroll
                    for (int m = 0; m < 8; ++m) { fk[m] = *(const LAS u32x2*)(sl + 4096 + (m * 64 + lane) * 8); p15[m] = *(const LAS f32x4*)(sl + 8704 + (16 * m + 4 * quad) * 4); }
                    const u32x2 fa = *(const LAS u32x2*)(sl + 8192 + lane * 8); const f32x4 v4 = *(const LAS f32x4*)(sl + 9216 + lane * 16);
                    bf16x8 sf[4];
#pragma unroll
                    for (int j = 0; j < 4; ++j) sf[j] = __builtin_bit_cast(bf16x8, (u32x4){pk2n(St[2 * j][0], St[2 * j][1]), pk2n(St[2 * j][2], St[2 * j][3]), pk2n(St[2 * j + 1][0], St[2 * j + 1][1]), pk2n(St[2 * j + 1][2], St[2 * j + 1][3])});
                    const bf16x8 bv = __builtin_bit_cast(bf16x8, (u32x4){pk2n(v4[0], v4[1]), pk2n(v4[2], v4[3]), 0u, 0u});
                    const bf16x8 FA8 = __builtin_bit_cast(bf16x8, (u32x4){fa[0], fa[1], 0u, 0u});
                    f32x4 O = __builtin_amdgcn_mfma_f32_16x16x32_bf16(FA8, bv, zero4, 0, 0, 0);
#pragma unroll
                    for (int j = 0; j < 4; ++j) O = __builtin_amdgcn_mfma_f32_16x16x32_bf16(__builtin_bit_cast(bf16x8, fq[j]), sf[j], O, 0, 0, 0);
#pragma unroll
                    for (int m = 0; m < 8; ++m) St[m] = __builtin_amdgcn_mfma_f32_16x16x32_bf16(__builtin_bit_cast(bf16x8, (u32x4){fk[m][0], fk[m][1], 0u, 0u}), bv, St[m] * p15[m], 0, 0, 0);
#pragma unroll
                    for (int e = 0; e < 4; ++e) { const int t = 4 * quad + e; const int p = dir ? plo + TS - 1 - t : plo + t;
                        Ohg[(rowbase + p) * 1024 + h * 128 + col0 + col] = (bf16_t)(pk2n(O[e], 0.f) & 0xffffu); }
                }
                SCAN_BAR();
            }
        } else if (wid < 5) {
            const int k = wid - 2;
            u32x4 fw[4], fq[4]; u32x2 fk[8], fa, ft; f32x4 b4, v4; float egC = 0.f;
#pragma unroll
            for (int j = 0; j < 4; ++j) { fw[j] = (u32x4){0u, 0u, 0u, 0u}; fq[j] = fw[j]; }
#pragma unroll
            for (int m = 0; m < 8; ++m) fk[m] = (u32x2){0u, 0u};
            fa = (u32x2){0u, 0u}; ft = fa; b4 = zero4; v4 = zero4;
            float twv[32]; int tn = 0; bool thave = false; const int tlw = blockIdx.x * 6 + (wid - 2), TNLW = gridDim.x * 6; LAS float* tscr = (LAS float*)(lds + 2 * SLOT + (wid - 2) * 8448);
#pragma unroll
            for (int i_ = 0; i_ < 32; ++i_) twv[i_] = 0.f;
#pragma unroll 1
            for (int it = -4; it < NT; ++it) {
                if ((it + 4) % 3 == k) {
                    const int jw = it + 1, jl = it + 4;
                    if (jw >= 0 && jw < NT) {
                        LAS unsigned char* sl = lds + (jw & 1) * SLOT;
#pragma unroll
                        for (int j = 0; j < 4; ++j) { *(LAS u32x4*)(sl + (j * 64 + lane) * 16) = fw[j]; *(LAS u32x4*)(sl + 4096 + (j * 64 + lane) * 16) = fq[j]; }
#pragma unroll
                        for (int m = 0; m < 8; ++m) *(LAS u32x2*)(sl + 8192 + (m * 64 + lane) * 8) = fk[m];
                        *(LAS u32x2*)(sl + 12288 + lane * 8) = fa; *(LAS u32x2*)(sl + 12800 + lane * 8) = ft;
                        *(LAS f32x4*)(sl + 13312 + lane * 16) = b4; *(LAS f32x4*)(sl + 14336 + lane * 16) = v4;
                        if (lane == 0) *(LAS float*)(sl + 15360) = egC;
                    }
                    if (jl < NT) {
                        const int n0 = jl * TS; const int plo = dir ? (n0 < 256 ? 256 - TS - n0 : TPB + 256 - TS - n0) : n0;
                        const size_t task = (size_t)grp * NCHUNK + jl;
                        const unsigned char* c1 = ws + WS_CP1 + task * CP1_STRIDE; const unsigned char* ck = ws + WS_CPK + task * 4096; const unsigned char* c2 = ws + WS_CP2 + task * CP2_STRIDE;
#pragma unroll
                        for (int j = 0; j < 4; ++j) { fw[j] = *(const u32x4*)(c1 + (size_t)(j * 64 + lane) * 16); fq[j] = *(const u32x4*)(c1 + 4096 + (size_t)(j * 64 + lane) * 16); }
#pragma unroll
                        for (int m = 0; m < 8; ++m) fk[m] = *(const u32x2*)(ck + (size_t)(m * 64 + lane) * 8);
                        fa = *(const u32x2*)(c2 + (size_t)lane * 8); ft = *(const u32x2*)(c2 + 512 + (size_t)lane * 8);
                        b4 = *(const f32x4*)(c2 + 1024 + quad * 16); egC = *(const float*)(c2 + 1024 + 64);
#pragma unroll
                        for (int e = 0; e < 4; ++e) { const int s = 4 * quad + e; const int p = dir ? plo + TS - 1 - s : plo + s;
                            v4[e] = DNV[(rowbase + p) * 1024 + h * 128 + col0 + col]; }
                    }
                }
                if (l == 0) {
                    const int ti = tlw + TNLW * tn;
                    if (ti < T32_PER) {
                        if ((it + 4) % 3 == (k + 1) % 3) { TSTAGE1(twv, ti); thave = true; }
                        else if ((it + 4) % 3 == (k + 2) % 3 && thave) { TSTAGE2(twv, ti, tscr); ++tn; thave = false; }
                    }
                }
                SCAN_BAR();
            }
        } else {
            const int k = wid - 5;
            u32x4 fq[4]; u32x2 fk[8], fa; f32x4 p15 = zero4; bf16_t vr[4] = {0, 0, 0, 0};
#pragma unroll
            for (int j = 0; j < 4; ++j) fq[j] = (u32x4){0u, 0u, 0u, 0u};
#pragma unroll
            for (int m = 0; m < 8; ++m) fk[m] = (u32x2){0u, 0u};
            fa = (u32x2){0u, 0u};
            float twv[32]; int tn = 0; bool thave = false; const int tlw = blockIdx.x * 6 + (wid - 2), TNLW = gridDim.x * 6; LAS float* tscr = (LAS float*)(lds + 2 * SLOT + (wid - 2) * 8448);
#pragma unroll
            for (int i_ = 0; i_ < 32; ++i_) twv[i_] = 0.f;
#pragma unroll 1
            for (int it = -4; it < NT; ++it) {
                if ((it + 4) % 3 == k) {
                    const int jw = it + 1, jl = it + 4;
                    if (jw >= 0 && jw < NT) {
                        LAS unsigned char* sl = lds + (jw & 1) * SLOT + HGO;
#pragma unroll
                        for (int j = 0; j < 4; ++j) *(LAS u32x4*)(sl + (j * 64 + lane) * 16) = fq[j];
#pragma unroll
                        for (int m = 0; m < 8; ++m) *(LAS u32x2*)(sl + 4096 + (m * 64 + lane) * 8) = fk[m];
                        *(LAS u32x2*)(sl + 8192 + lane * 8) = fa;
                        if (lane < 32) *(LAS f32x4*)(sl + 8704 + lane * 16) = p15;
                        *(LAS f32x4*)(sl + 9216 + lane * 16) = (f32x4){bf1(vr[0]), bf1(vr[1]), bf1(vr[2]), bf1(vr[3])};
                    }
                    if (jl < NT) {
                        const int n0 = jl * TS; const int plo = dir ? (n0 < 256 ? 256 - TS - n0 : TPB + 256 - TS - n0) : n0;
                        const size_t task = (size_t)grp * NCHUNK + jl;
                        const unsigned char* cq = ws + WS_HGQ + task * 4096; const unsigned char* ck = ws + WS_HGK + task * 4096; const unsigned char* ca = ws + WS_HGA + task * 1024;
#pragma unroll
                        for (int j = 0; j < 4; ++j) fq[j] = *(const u32x4*)(cq + (size_t)(j * 64 + lane) * 16);
#pragma unroll
                        for (int m = 0; m < 8; ++m) fk[m] = *(const u32x2*)(ck + (size_t)(m * 64 + lane) * 8);
                        fa = *(const u32x2*)(ca + (size_t)lane * 8);
                        if (lane < 32) p15 = *(const f32x4*)(ca + 512 + (size_t)lane * 16);
#pragma unroll
                        for (int e = 0; e < 4; ++e) { const int s = 4 * quad + e; const int p = dir ? plo + TS - 1 - s : plo + s;
                            vr[e] = H[(rowbase + p) * NPAD + C_HGI + h * 128 + col0 + col]; }
                    }
                }
                if (l == 0) {
                    const int ti = tlw + TNLW * tn;
                    if (ti < T32_PER) {
                        if ((it + 4) % 3 == (k + 1) % 3) { TSTAGE1(twv, ti); thave = true; }
                        else if ((it + 4) % 3 == (k + 2) % 3 && thave) { TSTAGE2(twv, ti, tscr); ++tn; thave = false; }
                    }
                }
                SCAN_BAR();
            }
        }
    }
}

__device__ __forceinline__ f32x2 cmul(f32x2 a, f32x2 b) { return (f32x2){a.x * b.x - a.y * b.y, a.x * b.y + a.y * b.x}; }
__device__ __forceinline__ f32x2 cmulc(f32x2 a, f32x2 b) { return (f32x2){a.x * b.x + a.y * b.y, a.y * b.x - a.x * b.y}; }
#define PADI(i) ((i) + (((i) >> 5) << 1))
constexpr int FFT_PADN = 8192 + 512;
template <bool INV, int ST> __device__ __forceinline__ void fft_pass16(LAS f32x2* buf, int base, int bl) {
    constexpr float C16[8] = {1.f, 0.92387953251f, 0.70710678119f, 0.38268343237f, 0.f, -0.38268343237f, -0.70710678119f, -0.92387953251f};
    constexpr float S16[8] = {0.f, 0.38268343237f, 0.70710678119f, 0.92387953251f, 1.f, 0.92387953251f, 0.70710678119f, 0.38268343237f};
    f32x2 x[16];
    constexpr int STEP = (1 << ST) + ((1 << ST) >> 4);
    LAS f32x2* pb = buf + PADI(base);
#pragma unroll
    for (int d = 0; d < 16; ++d) x[d] = pb[d * STEP];
    const float th = (float)bl * (1.f / (float)(16 << ST));
    const f32x2 W1 = {__builtin_amdgcn_cosf(th), -__builtin_amdgcn_sinf(th)};
    const f32x2 W2 = cmul(W1, W1), W4 = cmul(W2, W2), W8 = cmul(W4, W4);
    if (!INV) {
#pragma unroll
        for (int d = 0; d < 8; ++d) { const f32x2 w = cmul(W1, (f32x2){C16[d], -S16[d]}); const f32x2 a = x[d], b = x[d + 8]; x[d] = a + b; x[d + 8] = cmul(a - b, w); }
#pragma unroll
        for (int g = 0; g < 16; g += 8)
#pragma unroll
            for (int dd = 0; dd < 4; ++dd) { const int d = g + dd; const f32x2 w = cmul(W2, (f32x2){C16[2 * dd], -S16[2 * dd]}); const f32x2 a = x[d], b = x[d + 4]; x[d] = a + b; x[d + 4] = cmul(a - b, w); }
#pragma unroll
        for (int g = 0; g < 16; g += 4)
#pragma unroll
            for (int dd = 0; dd < 2; ++dd) { const int d = g + dd; const f32x2 w = dd ? (f32x2){W4.y, -W4.x} : W4; const f32x2 a = x[d], b = x[d + 2]; x[d] = a + b; x[d + 2] = cmul(a - b, w); }
#pragma unroll
        for (int g = 0; g < 16; g += 2) { const f32x2 a = x[g], b = x[g + 1]; x[g] = a + b; x[g + 1] = cmul(a - b, W8); }
    } else {
#pragma unroll
        for (int g = 0; g < 16; g += 2) { const f32x2 a = x[g], b = cmulc(x[g + 1], W8); x[g] = a + b; x[g + 1] = a - b; }
#pragma unroll
        for (int g = 0; g < 16; g += 4)
#pragma unroll
            for (int dd = 0; dd < 2; ++dd) { const int d = g + dd; const f32x2 w = dd ? (f32x2){W4.y, -W4.x} : W4; const f32x2 a = x[d], b = cmulc(x[d + 2], w); x[d] = a + b; x[d + 2] = a - b; }
#pragma unroll
        for (int g = 0; g < 16; g += 8)
#pragma unroll
            for (int dd = 0; dd < 4; ++dd) { const int d = g + dd; const f32x2 w = cmul(W2, (f32x2){C16[2 * dd], -S16[2 * dd]}); const f32x2 a = x[d], b = cmulc(x[d + 4], w); x[d] = a + b; x[d + 4] = a - b; }
#pragma unroll
        for (int d = 0; d < 8; ++d) { const f32x2 w = cmul(W1, (f32x2){C16[d], -S16[d]}); const f32x2 a = x[d], b = cmulc(x[d + 8], w); x[d] = a + b; x[d + 8] = a - b; }
    }
#pragma unroll
    for (int d = 0; d < 16; ++d) pb[d * STEP] = x[d];
}
__device__ __forceinline__ void fft_fwd_abc(LAS f32x2* buf, int tid) {
    asm volatile("" : "+v"(tid));
    fft_pass16<false, 9>(buf, tid, tid); __syncthreads();
    fft_pass16<false, 5>(buf, ((tid >> 5) << 9) + (tid & 31), tid & 31); __syncthreads();
    fft_pass16<false, 1>(buf, ((tid >> 1) << 5) + (tid & 1), tid & 1); __syncthreads();
}
__device__ __forceinline__ void fft_inv_cba(LAS f32x2* buf, int tid) {
    asm volatile("" : "+v"(tid));
    fft_pass16<true, 1>(buf, ((tid >> 1) << 5) + (tid & 1), tid & 1); __syncthreads();
    fft_pass16<true, 5>(buf, ((tid >> 5) << 9) + (tid & 31), tid & 31); __syncthreads();
    fft_pass16<true, 9>(buf, tid, tid); __syncthreads();
}
__device__ __forceinline__ float hy_delta(int c) {
    const float a = -3.0701134573253944f, bq = -15.350567286626972f;
    return fabsf(a + (float)c * ((bq - a) / 1023.f));
}
__device__ __forceinline__ void hyena_phase(const Params& P, int l, LAS unsigned char* lds) {
    const int G = gridDim.x;
    unsigned char* ws = P.ws;
    const unsigned* ZT = (const unsigned*)(ws + WS_ZT);
    const float* HID = (const float*)(ws + WS_HID + (size_t)l * SZ_HID1);
    const float* w3 = P.in[13] + (size_t)l * 64 * 4096;
    const int nitems = 1024 + (l == 0 ? 128 : 0);
#pragma unroll 1
    for (int item = blockIdx.x; item < nitems; item += G) {
        const int tid = otid();
        if (item < 1024) {
            const int c = item;
            LAS f32x2* bufA = (LAS f32x2*)lds; LAS f32x2* bufB = bufA + FFT_PADN; LAS f32x4* w3s = (LAS f32x4*)(lds + 2 * FFT_PADN * 8);
            if (tid < 256) ((LAS float*)w3s)[tid] = w3[(size_t)(tid >> 2) * 4096 + ((tid >> 1) & 1) * 2048 + (tid & 1) * 1024 + c];
            __syncthreads();
            const float dl = hy_delta(c);
            {
                f32x4 hacc[8];
#pragma unroll
                for (int e = 0; e < 8; ++e) hacc[e] = (f32x4){0.f, 0.f, 0.f, 0.f};
#pragma unroll 16
                for (int j = 0; j < 64; ++j) { const f32x4 w = w3s[j]; const f32x4 h0 = *(const f32x4*)(HID + (size_t)j * 4096 + 4 * tid), h1 = *(const f32x4*)(HID + (size_t)j * 4096 + 2048 + 4 * tid);
#pragma unroll
                    for (int e = 0; e < 4; ++e) { hacc[e] += h0[e] * w; hacc[4 + e] += h1[e] * w; } }
#pragma unroll
                for (int e = 0; e < 8; ++e) { const int t = 4 * tid + (e & 3) + (e >> 2) * 2048; const float win = __expf(-((float)t * (1.f / 4095.f)) * dl);
                    bufB[PADI(4 * tid) + (e & 3) + (e >> 2) * 2176] = (f32x2){win * hacc[e][0], win * hacc[e][2]};
                    if (t >= 1) bufB[PADI(8192 - t)] = (f32x2){win * hacc[e][1], win * hacc[e][3]}; else bufB[PADI(4096)] = (f32x2){0.f, 0.f}; }
            }
            __syncthreads();
            fft_fwd_abc(bufB, tid);
#pragma unroll
            for (int u = 0; u < 8; ++u) { LAS f32x4* pp = (LAS f32x4*)(bufB + PADI(2 * tid) + 1088 * u); const f32x4 v = *pp;
                *pp = (f32x4){v[0] + v[2], v[1] + v[3], v[0] - v[2], v[1] - v[3]}; }
            f32x2 vv[8], y1[8];
#pragma unroll
            for (int u = 0; u < 8; ++u) { const int t = tid + 512 * u; { const unsigned w_ = ZT[(size_t)c * 4096 + t]; vv[u] = (f32x2){bflo(w_), bfhi(w_)}; } bufA[PADI(tid) + 544 * u] = vv[u]; bufA[PADI(tid) + 544 * u + 4352] = (f32x2){0.f, 0.f}; }
            __syncthreads();
#pragma unroll
            for (int ord = 0; ord < 2; ++ord) {
                fft_fwd_abc(bufA, tid);
#pragma unroll 2
                for (int u = 0; u < 8; ++u) { const int i0 = 2 * (tid + 512 * u); LAS f32x4* pp = (LAS f32x4*)(bufA + PADI(2 * tid) + 1088 * u); const f32x4 v = *pp;
                    f32x2 xs[2] = {(f32x2){v[0] + v[2], v[1] + v[3]}, (f32x2){v[0] - v[2], v[1] - v[3]}};
                    const f32x4 zz = *(const LAS f32x4*)(bufB + PADI(2 * tid) + 1088 * u);
#pragma unroll
                    for (int q = 0; q < 2; ++q) { const unsigned f = __brev((unsigned)(i0 + q)) >> 19, fp = (8192u - f) & 8191u, ip = __brev(fp) >> 19;
                        const f32x2 Z = q ? (f32x2){zz[2], zz[3]} : (f32x2){zz[0], zz[1]}; const f32x2 Zp = bufB[PADI((int)ip)]; f32x2 Kf;
                        if (ord == 0) Kf = (f32x2){Z.x + Zp.x, Z.y - Zp.y}; else Kf = (f32x2){Z.y + Zp.y, Zp.x - Z.x};
                        Kf *= (0.5f / 8192.f);
                        xs[q] = cmul(xs[q], Kf); }
                    *pp = (f32x4){xs[0].x + xs[1].x, xs[0].y + xs[1].y, xs[0].x - xs[1].x, xs[0].y - xs[1].y}; }
                __syncthreads();
                fft_inv_cba(bufA, tid);
                const float skip = P.in[14][(size_t)(l * 2 + ord) * 1024 + c];
#pragma unroll
                for (int u = 0; u < 8; ++u) { const int t = tid + 512 * u; const f32x2 cv = bufA[PADI(tid) + 544 * u]; const unsigned gw_ = ZT[(size_t)((ord + 1) * 1024 + c) * 4096 + t]; const f32x2 gt = {bflo(gw_), bfhi(gw_)};
                    if (ord == 0) { y1[u] = gt * (cv + skip * vv[u]); bufA[PADI(tid) + 544 * u] = y1[u]; bufA[PADI(tid) + 544 * u + 4352] = (f32x2){0.f, 0.f}; }
                    else { const f32x2 yo = gt * (cv + skip * y1[u]); ((unsigned*)(ws + WS_ZY))[(size_t)c * 4096 + t] = pk2(yo.x, yo.y); } }
                __syncthreads();
            }
        } else {
            const int it = item - 1024, bb = it >> 6, cg = it & 63, ch = tid & 15, tg = tid >> 4, c = cg * 16 + ch;
            LAS float* filt = (LAS float*)lds;
            LAS float* vbuf = filt + 511 * 16;
            LAS float* ybuf = vbuf + 256 * 16;
            const float* ZC = (const float*)(ws + WS_ZC) + (size_t)bb * 256 * 3072;
            const float* HC = HID + 64 * 4096;
            bf16_t* HYC = (bf16_t*)(ws + WS_HYC);
            const float dl = hy_delta(c);
            for (int i = tid; i < 256 * 16; i += NTHR) vbuf[i] = ZC[(size_t)(i >> 4) * 3072 + cg * 16 + (i & 15)];
#pragma unroll 1
            for (int ord = 0; ord < 2; ++ord) {
                {
                    const float* wpf = w3 + ord * 2048 + c; const float* wpb = wpf + 1024;
                    f32x4 af0 = {0.f, 0.f, 0.f, 0.f}, af1 = af0, ab0 = af0, ab1 = af0;
#pragma unroll 4
                    for (int j = 0; j < 64; ++j) { const float wf = wpf[(size_t)j * 4096], wb = wpb[(size_t)j * 4096];
                        const f32x4 h0 = *(const f32x4*)(HC + j * 256 + tg * 8), h1 = *(const f32x4*)(HC + j * 256 + tg * 8 + 4);
                        af0 += h0 * wf; af1 += h1 * wf; ab0 += h0 * wb; ab1 += h1 * wb; }
#pragma unroll
                    for (int e = 0; e < 8; ++e) { const int tau = tg * 8 + e; const float win = __expf(-((float)tau * (1.f / 255.f)) * dl);
                        filt[(255 + tau) * 16 + ch] = win * (e < 4 ? af0[e & 3] : af1[e & 3]);
                        if (tau >= 1) filt[(255 - tau) * 16 + ch] = win * (e < 4 ? ab0[e & 3] : ab1[e & 3]); }
                }
                __syncthreads();
                const int tq = tg >> 1;
                (void)tq;
                float acc[8];
#pragma unroll
                for (int i = 0; i < 8; ++i) acc[i] = 0.f;
                const LAS float* src = ord ? ybuf : vbuf;
                for (int s = 0; s < 256; ++s) { const float vs = src[s * 16 + ch];
#pragma unroll
                    for (int i = 0; i < 8; ++i) acc[i] += filt[(tg * 8 + i - s + 255) * 16 + ch] * vs; }
                const float skip = P.in[14][(size_t)ord * 1024 + c];
                float res[8];
#pragma unroll
                for (int i = 0; i < 8; ++i) { const int t = tg * 8 + i; res[i] = ZC[(size_t)t * 3072 + (ord + 1) * 1024 + c] * (acc[i] + skip * src[t * 16 + ch]); }
                __syncthreads();
#pragma unroll
                for (int i = 0; i < 8; ++i) { const int t = tg * 8 + i;
                    if (ord == 0) ybuf[t * 16 + ch] = res[i];
                    else HYC[((size_t)bb * 256 + t) * 1024 + c] = (bf16_t)(pk2(res[i], 0.f) & 0xffffu); }
                __syncthreads();
            }
        }
    }
}

__device__ __forceinline__ void assemble_phase(const Params& P, int l, LAS unsigned char* lds) {
    const int tid = otid(), lane = tid & 63, wave = tid >> 6, G = gridDim.x;
    const int gw = blockIdx.x * NWAVES + wave, NGW = G * NWAVES;
    unsigned char* ws = P.ws;
    const bf16_t* H = (const bf16_t*)(ws + WS_H); bf16_t* BR = (bf16_t*)(ws + WS_DN);
    {
        LAS float* L = (LAS float*)lds;
        const unsigned* ZT = (const unsigned*)(ws + WS_ZY);
#define ASY_LOAD(rv_, item_) do { const int ti_ = (item_) >> 4, ct_ = (item_) & 15, tt_ = tid & 63; \
            _Pragma("unroll") for (int u = 0; u < 8; ++u) { const int cc = (tid >> 6) + 8 * u; rv_[u] = ZT[(size_t)(ct_ * 64 + cc) * 4096 + ti_ * 64 + tt_]; } } while (0)
        unsigned crv[8];
#pragma unroll
        for (int u = 0; u < 8; ++u) crv[u] = 0u;
        if ((int)blockIdx.x < 64 * 16) ASY_LOAD(crv, blockIdx.x);
#pragma unroll 1
        for (int item = blockIdx.x; item < 64 * 16; item += G) {
            const int ti = item >> 4, ct = item & 15;
            unsigned nrv[8];
#pragma unroll
            for (int u = 0; u < 8; ++u) nrv[u] = 0u;
            if (item + G < 64 * 16) ASY_LOAD(nrv, item + G);
            { const int tt = tid & 63;
#pragma unroll
              for (int u = 0; u < 8; ++u) { const int cc = (tid >> 6) + 8 * u; const unsigned v = crv[u];
                L[(0 * 64 + tt) * 65 + cc] = bflo(v); L[(1 * 64 + tt) * 65 + cc] = bfhi(v); } }
            asm volatile("s_waitcnt lgkmcnt(0)" ::: "memory"); __builtin_amdgcn_s_barrier(); asm volatile("" ::: "memory");
#pragma unroll
            for (int u = 0; u < 2; ++u) { const int task = tid + 512 * u, rowi = task >> 3, bb = rowi >> 6, tt = rowi & 63, ch8 = task & 7;
                const LAS float* lp = L + (bb * 64 + tt) * 65 + ch8 * 8;
                u32x4 o; o.x = pk2(lp[0], lp[1]); o.y = pk2(lp[2], lp[3]); o.z = pk2(lp[4], lp[5]); o.w = pk2(lp[6], lp[7]);
                *(u32x4*)(BR + ((size_t)bb * TPB + CTX + ti * 64 + tt) * 3072 + ct * 64 + ch8 * 8) = o; }
            asm volatile("s_waitcnt lgkmcnt(0)" ::: "memory"); __builtin_amdgcn_s_barrier(); asm volatile("" ::: "memory");
#pragma unroll
            for (int u = 0; u < 8; ++u) crv[u] = nrv[u];
        }
#undef ASY_LOAD
    }
    if (l == 0) {
        const u32x4* HYC = (const u32x4*)(ws + WS_HYC);
        for (int i = blockIdx.x * NTHR + tid; i < 512 * 128; i += G * NTHR) { const int r = i >> 7, c8 = i & 127;
            *(u32x4*)(BR + ((size_t)(r >> 8) * TPB + (r & 255)) * 3072 + c8 * 8) = HYC[i]; }
    }
    {
        const bf16_t* SOb = (const bf16_t*)(ws + WS_SO);
        const bool skipc = (l == DEPTH - 1);
        int r = gw;
        while (r < M && skipc && (r % TPB) < CTX) r += NGW;
        float nwr[2][8];
#pragma unroll
        for (int mix = 0; mix < 2; ++mix)
#pragma unroll
            for (int e = 0; e < 8; ++e) nwr[mix][e] = P.in[mix ? 22 : 16][l * 128 + (lane & 15) * 8 + e];
        u32x4 cs[2][2][2], cg[2][2];
#define ASM_LOAD(so, gg, row) do { _Pragma("unroll") for (int mix = 0; mix < 2; ++mix) _Pragma("unroll") for (int half = 0; half < 2; ++half) { const int ch = half * 512 + lane * 8; \
            so[mix][half][0] = *(const u32x4*)(SOb + (size_t)(mix * 2) * (SZ_SOB / 2) + (size_t)(row) * 1024 + ch); \
            so[mix][half][1] = *(const u32x4*)(SOb + (size_t)(mix * 2 + 1) * (SZ_SOB / 2) + (size_t)(row) * 1024 + ch); \
            gg[mix][half] = *(const u32x4*)(H + (size_t)(row) * NPAD + (mix ? C_DNZ : C_HGG) + ch); } } while (0)
#pragma unroll
        for (int mix = 0; mix < 2; ++mix)
#pragma unroll
            for (int half = 0; half < 2; ++half) { cs[mix][half][0] = (u32x4){0u, 0u, 0u, 0u}; cs[mix][half][1] = cs[mix][half][0]; cg[mix][half] = cs[mix][half][0]; }
        if (r < M) ASM_LOAD(cs, cg, r);
#pragma unroll 1
        while (r < M) {
            int rn = r + NGW;
            while (rn < M && skipc && (rn % TPB) < CTX) rn += NGW;
            u32x4 ns[2][2][2], ng[2][2];
#pragma unroll
            for (int mix = 0; mix < 2; ++mix)
#pragma unroll
                for (int half = 0; half < 2; ++half) { ns[mix][half][0] = (u32x4){0u, 0u, 0u, 0u}; ns[mix][half][1] = ns[mix][half][0]; ng[mix][half] = ns[mix][half][0]; }
            if (rn < M) ASM_LOAD(ns, ng, rn);
#pragma unroll
            for (int mix = 0; mix < 2; ++mix) {
#pragma unroll
                for (int half = 0; half < 2; ++half) {
                    const int ch = half * 512 + lane * 8;
                    float o[8], o2[8]; unpack8(cs[mix][half][0], o); unpack8(cs[mix][half][1], o2);
#pragma unroll
                    for (int e = 0; e < 8; ++e) o[e] += o2[e];
                    float ss = 0.f;
#pragma unroll
                    for (int e = 0; e < 8; ++e) ss += o[e] * o[e];
                    ss = row_sum16(ss);
                    const float rs = __builtin_amdgcn_rsqf(ss * (1.f / 128.f) + 1e-6f);
                    float gt[8]; unpack8(cg[mix][half], gt);
                    float res[8];
#pragma unroll
                    for (int e = 0; e < 8; ++e) res[e] = o[e] * rs * nwr[mix][e] * (mix ? silu(gt[e]) : sigm(gt[e]));
                    u32x4 ov; ov.x = pk2(res[0], res[1]); ov.y = pk2(res[2], res[3]); ov.z = pk2(res[4], res[5]); ov.w = pk2(res[6], res[7]);
                    *(u32x4*)(BR + (size_t)r * 3072 + (mix ? 2048 : 1024) + ch) = ov;
                }
            }
#pragma unroll
            for (int mix = 0; mix < 2; ++mix)
#pragma unroll
                for (int half = 0; half < 2; ++half) { cs[mix][half][0] = ns[mix][half][0]; cs[mix][half][1] = ns[mix][half][1]; cg[mix][half] = ng[mix][half]; }
            r = rn;
        }
#undef ASM_LOAD
    }
}

__device__ __forceinline__ void ctx_sb_from_sctx(const Params& P) {
    const float* SC = (const float*)(P.ws + WS_SCTX); bf16_t* SB = (bf16_t*)(P.ws + WS_U);
    for (int i = blockIdx.x * NTHR + threadIdx.x; i < 512 * D / 4; i += gridDim.x * NTHR) {
        const int r = i / (D / 4), c4 = i - r * (D / 4); f32x4 v = *(const f32x4*)(SC + (size_t)i * 4);
#pragma unroll
        for (int s = 1; s < 12; ++s) v += *(const f32x4*)(SC + (size_t)s * 512 * D + (size_t)i * 4);
        u32x2 o; o.x = pk2(v[0], v[1]); o.y = pk2(v[2], v[3]);
        *(u32x2*)(SB + ((size_t)(r >> 8) * TPB + (r & 255)) * D + c4 * 4) = o; }
}
#define XB_XGEN(j) (3072 + 64 * (j))
__device__ __forceinline__ void gbar_impl(unsigned* bar, unsigned& gen, unsigned nloc, unsigned nx) {
    asm volatile("s_waitcnt vmcnt(0)" ::: "memory");
    __syncthreads();
    gen += 1u;
    if (threadIdx.x == 0) {
        __builtin_amdgcn_s_waitcnt(0);
        const unsigned x = xcc_id();
        const unsigned old = __hip_atomic_fetch_add(bar + XB_SUB(x), 1u, __ATOMIC_RELAXED, __HIP_MEMORY_SCOPE_AGENT);
        unsigned sp = 0u;
        if (old + 1u == gen * nloc) {
            __builtin_amdgcn_fence(__ATOMIC_RELEASE, "agent");
            asm volatile("s_waitcnt vmcnt(0)" ::: "memory");
            const unsigned og = __hip_atomic_fetch_add(bar + XB_TOP, 1u, __ATOMIC_RELAXED, __HIP_MEMORY_SCOPE_AGENT);
            if (og + 1u == gen * nx) (void)__hip_atomic_fetch_add(bar + XB_GEN, 1u, __ATOMIC_RELAXED, __HIP_MEMORY_SCOPE_AGENT);
            else while (__hip_atomic_load(bar + XB_GEN, __ATOMIC_RELAXED, __HIP_MEMORY_SCOPE_AGENT) < gen) { __builtin_amdgcn_s_sleep(1); if (++sp > (1u << 22)) break; }
            __builtin_amdgcn_fence(__ATOMIC_ACQUIRE, "agent");
            (void)__hip_atomic_fetch_add(bar + XB_XGEN(x), 1u, __ATOMIC_RELAXED, __HIP_MEMORY_SCOPE_AGENT);
            asm volatile("s_waitcnt vmcnt(0)" ::: "memory");
        } else {
            while (__hip_atomic_load(bar + XB_XGEN(x), __ATOMIC_RELAXED, __HIP_MEMORY_SCOPE_AGENT) < gen) { __builtin_amdgcn_s_sleep(1); if (++sp > (1u << 22)) break; }
            __builtin_amdgcn_fence(__ATOMIC_ACQUIRE, "agent");
            asm volatile("s_waitcnt vmcnt(0)" ::: "memory");
        }
    }
    __syncthreads();
}
#define gbar(bar, gen, G) gbar_impl(bar, gen, bar_nloc, bar_nx)
#ifndef REPM
#define REPM 0
#endif
#define REP(bit) for (int _rp = 0; _rp < (((REPM) >> (bit)) & 1) + 1; ++_rp)
__global__ void __launch_bounds__(NTHR, 2) mega(Params P) {
    extern __shared__ __attribute__((aligned(16))) unsigned char smem[];
    LAS unsigned char* lds = (LAS unsigned char*)smem;
    cg::grid_group grid = cg::this_grid();
    unsigned char* ws = P.ws;
    const int G = gridDim.x, cidx = blockIdx.x;
    unsigned* bar = (unsigned*)(ws + WS_BAR); unsigned bgen = 0u;

    REP(0) { phase0(P, lds);
    grid.sync(); }
    unsigned bar_nloc, bar_nx;
    { unsigned nl = __hip_atomic_load(bar + XB_CNT(xcc_id()), __ATOMIC_RELAXED, __HIP_MEMORY_SCOPE_AGENT), nxx = 0u;
#pragma unroll
      for (int j = 0; j < 16; ++j) nxx += (__hip_atomic_load(bar + XB_CNT(j), __ATOMIC_RELAXED, __HIP_MEMORY_SCOPE_AGENT) != 0u) ? 1u : 0u;
      bar_nloc = (unsigned)__builtin_amdgcn_readfirstlane((int)(nl ? nl : 1u)); bar_nx = (unsigned)__builtin_amdgcn_readfirstlane((int)(nxx ? nxx : 1u)); }
    init_rows(P);
    gbar(bar, bgen, (unsigned)G);

#pragma unroll 1
    for (int l = 0; l < DEPTH; ++l) {
        const float* modl = (const float*)(ws + WS_MOD) + (size_t)l * 3 * 6 * D;
        { pg8::Order S{(const bf16_t*)(ws + WS_U), (const bf16_t*)(ws + WS_WIN + (size_t)l * SZ_WIN), D, D, l ? 32 : M / 256, NPAD / 256, G, cidx, 1, 0, 0, D, l ? 1 : 0, l ? 19 : 0, 0};
          pg8::EpiBf16<0> E{(bf16_t*)(ws + WS_H), NPAD};
          REP(1) pg8::gemm_phase(lds, D, D, S, E); }
        gbar(bar, bgen, (unsigned)G);
        REP(2) { prep_phase(P, l, lds);
        gbar(bar, bgen, (unsigned)G); }
        REP(4) { hyena_phase(P, l, lds);
        gbar(bar, bgen, (unsigned)G); }
        chunkprep_phase(P, lds);
        gbar(bar, bgen, (unsigned)G);
        hgprep_phase(P, l, lds);
        gbar(bar, bgen, (unsigned)G);
        REP(3) { scan_phase(P, l, lds);
        gbar(bar, bgen, (unsigned)G); }
        REP(5) { assemble_phase(P, l, lds);
        gbar(bar, bgen, (unsigned)G); }
        { pg8::Order S{(const bf16_t*)(ws + WS_DN), (const bf16_t*)(ws + WS_WBR + (size_t)l * 3 * SZ_WBR), 3072, 1024, 32, D / 256, G, cidx, 3, 1024, (size_t)D * 1024, 1024, 1, 0, l ? 0 : 4};
          pg8::EpiBranch E{(float*)(ws + WS_SO), (bf16_t*)(ws + WS_U), (const bf16_t*)(ws + WS_H), (float*)(ws + WS_SCTX)};
          pg8::gemm_phase(lds, 3072, 1024, S, E); }
        gbar(bar, bgen, (unsigned)G);
        if (l == 0) { ctx_sb_from_sctx(P); gbar(bar, bgen, (unsigned)G); }
        { pg8::Order S{(const bf16_t*)(ws + WS_U), (const bf16_t*)(ws + WS_WOUT + (size_t)l * SZ_WOUT), D, D, 32, D / 256, G, cidx, 1, 0, 0, D, 1, 0, l ? 0 : 8};
          pg8::EpiRes E{(bf16_t*)(ws + WS_SO + (size_t)M * D * 4), (const float*)(ws + WS_X), modl, 2, (float*)(ws + WS_SCTX)};
          pg8::gemm_phase(lds, D, D, S, E); }
        gbar(bar, bgen, (unsigned)G);
        REP(8) { ln_rows(P, P.in[25] + l * D, P.in[26] + l * D, modl, 3, true, false, l ? 0 : 8, l == DEPTH - 1);
        gbar(bar, bgen, (unsigned)G); }
        { pg8::Order S{(const bf16_t*)(ws + WS_U), (const bf16_t*)(ws + WS_WFF1 + (size_t)l * SZ_WFF), D, D, l ? 32 : M / 256, DFF / 256, G, cidx, 1, 0, 0, D, l ? 1 : 0, 0, 0};
          pg8::EpiBf16<1> E{(bf16_t*)(ws + WS_H), DFF};
          REP(9) pg8::gemm_phase(lds, D, D, S, E); }
        gbar(bar, bgen, (unsigned)G);
        { pg8::Order S{(const bf16_t*)(ws + WS_H), (const bf16_t*)(ws + WS_WFF2 + (size_t)l * SZ_WFF), DFF, DFF, 32, D / 256, G, cidx, 1, 0, 0, DFF, 1, 0, l ? 0 : 16};
          pg8::EpiRes E{(bf16_t*)(ws + WS_SO + (size_t)M * D * 4), (const float*)(ws + WS_X), modl, 5, (float*)(ws + WS_SCTX)};
          pg8::gemm_phase(lds, DFF, DFF, S, E); }
        gbar(bar, bgen, (unsigned)G);
        const bool lastl = (l == DEPTH - 1);
        ln_rows(P, P.in[29] + l * D, P.in[30] + l * D, modl + (lastl ? 0 : 3 * 6 * D), 0, !lastl, lastl, l ? 0 : 16, lastl);
        if (!lastl) gbar(bar, bgen, (unsigned)G);
    }
}

extern "C" void kernel_launch(void* const* d_in, const int* in_sizes, int n_in, void* d_out, int out_size, void* d_ws, size_t ws_size, hipStream_t stream) {
    static int grid_blocks = 0;
    if (grid_blocks == 0) {
        if (n_in != 31 || ws_size < WS_END) { fprintf(stderr, "kernel_launch: unexpected n_in %d or ws_size %zu (need %zu)\n", n_in, ws_size, (size_t)WS_END); grid_blocks = -1; return; }
        int dev = 0, cus = 0, per_cu = 0;
        hipGetDevice(&dev);
        hipDeviceGetAttribute(&cus, hipDeviceAttributeMultiprocessorCount, dev);
        if (hipFuncSetAttribute((const void*)mega, hipFuncAttributeMaxDynamicSharedMemorySize, LDS_BYTES) != hipSuccess) fprintf(stderr, "kernel_launch: hipFuncSetAttribute failed\n");
        hipOccupancyMaxActiveBlocksPerMultiprocessor(&per_cu, (const void*)mega, NTHR, LDS_BYTES);
        if (per_cu < 1) { fprintf(stderr, "kernel_launch: occupancy query says %d blocks per CU\n", per_cu); per_cu = 1; }
        (void)hipGetLastError();
        grid_blocks = cus;
    }
    if (grid_blocks < 0) return;
    Params p{};
    for (int i = 0; i < 31; ++i) p.in[i] = (const float*)d_in[i];
    p.out = (float*)d_out; p.ws = (unsigned char*)d_ws;
    (void)hipMemsetAsync((unsigned char*)d_ws + WS_BAR, 0, 16384, stream);
    void* args[] = {&p};
    hipError_t e = hipLaunchCooperativeKernel((const void*)mega, dim3(grid_blocks), dim3(NTHR), args, LDS_BYTES, stream);
    if (e != hipSuccess) fprintf(stderr, "cooperative launch failed: %s (grid %d)\n", hipGetErrorString(e), grid_blocks);
}
```

```cpp
#include <hip/hip_runtime.h>
#include <hip/hip_cooperative_groups.h>
#include <cstdio>
#include <cstdint>
namespace cg = cooperative_groups;

#define LAS __attribute__((address_space(3)))
typedef unsigned short bf16_t;
typedef short bf16x8 __attribute__((ext_vector_type(8)));
typedef float f32x4 __attribute__((ext_vector_type(4)));
typedef float f32x2 __attribute__((ext_vector_type(2)));
typedef unsigned u32x4 __attribute__((ext_vector_type(4)));
typedef unsigned u32x2 __attribute__((ext_vector_type(2)));

constexpr int D = 2048, NB = 2, SEQ = 4096, CTX = 256, TPB = SEQ + CTX, M = NB * TPB, DEPTH = 2;
constexpr int INC = 17440, NPAD = 17664, DFF = 8192;
constexpr int C_HGFF = 0, C_HGFB = 1024, C_HGI = 2048, C_DNK = 3072, C_DNV = 3584, C_DNA = 4608, C_DNB = 4624,
              C_HGQ = 4640, C_HGG = 5664, C_DNQ = 6688, C_DNZ = 7200, C_HY = 8224, C_GATE = 11296;
constexpr int NTHR = 512, NWAVES = 8;
constexpr int LDS_BYTES = 147456;
constexpr float ALPHA = 1.41421356237f;

constexpr size_t al256(size_t x) { return (x + 255) & ~(size_t)255; }
constexpr size_t SZ_WIN = (size_t)NPAD * D * 2, SZ_WBR = (size_t)D * 1024 * 2, SZ_WOUT = (size_t)D * D * 2, SZ_WFF = (size_t)DFF * D * 2;
constexpr size_t WS_WIN = 0;
constexpr size_t WS_WBR = WS_WIN + DEPTH * SZ_WIN;
constexpr size_t WS_WOUT = WS_WBR + DEPTH * 3 * SZ_WBR;
constexpr size_t WS_WFF1 = WS_WOUT + DEPTH * SZ_WOUT;
constexpr size_t WS_WFF2 = WS_WFF1 + DEPTH * SZ_WFF;
constexpr size_t WS_X = WS_WFF2 + DEPTH * SZ_WFF;
constexpr size_t WS_U = WS_X + (size_t)M * D * 4;
constexpr size_t WS_H = WS_U + (size_t)M * D * 2;
constexpr size_t WS_DN = WS_H + (size_t)M * NPAD * 2;
constexpr size_t OFF_DNK = 0, OFF_DNQ = (size_t)M * 512 * 4, OFF_DNV = 2 * OFF_DNQ, OFF_DNS = OFF_DNV + (size_t)M * 1024 * 4;
constexpr size_t SZ_DN = OFF_DNS + (size_t)M * 64 * 4;
constexpr size_t WS_SO = WS_DN + SZ_DN;
constexpr size_t SZ_SO1 = (size_t)M * 1024 * 4;
constexpr size_t SZ_SOB = (size_t)M * 1024 * 2;
constexpr size_t WS_ZT = WS_SO + 4 * SZ_SO1;
constexpr size_t WS_ZY = WS_ZT + (size_t)3072 * 4096 * 8;
constexpr size_t WS_ZC = WS_ZY + (size_t)1024 * 4096 * 8;
constexpr size_t WS_MOD = WS_ZC + (size_t)2 * 256 * 3072 * 4;
constexpr size_t WS_HID = WS_MOD + (size_t)DEPTH * 3 * 6 * D * 4;
constexpr size_t SZ_HID1 = (size_t)64 * (4096 + 256) * 4;
constexpr size_t WS_LB = WS_HID + DEPTH * SZ_HID1;
constexpr size_t WS_BAR = WS_LB + (size_t)DEPTH * 2 * 1024 * 4;
constexpr size_t WS_SCTX = WS_ZT;
constexpr int NCHUNK = TPB / 16, NTASK = NB * 8 * 2 * NCHUNK;
constexpr size_t WS_CP1 = WS_ZT;
constexpr size_t CP1_STRIDE = 8192;
constexpr size_t WS_CPK = WS_U;
constexpr size_t WS_CP2 = WS_BAR + 16384;
constexpr size_t CP2_STRIDE = 512 + 512 + 128;
static_assert((size_t)NTASK * 4096 <= (size_t)M * D * 2, "CPK alias");
constexpr size_t WS_HGQ = WS_DN + OFF_DNK;
constexpr size_t WS_HGA = WS_ZT + (size_t)NTASK * CP1_STRIDE;
constexpr size_t WS_HGK = WS_CP2 + (size_t)NTASK * CP2_STRIDE;
constexpr size_t WS_HYC = WS_HGK + (size_t)NTASK * 4096;
static_assert((size_t)NTASK * 4096 <= 2 * (size_t)M * 512 * 4 && (size_t)NTASK * (CP1_STRIDE + 1024) <= (size_t)3072 * 4096 * 8, "HG fragment aliases");
constexpr size_t WS_END = WS_HYC + (size_t)512 * 1024 * 2;
static_assert((size_t)NTASK * CP1_STRIDE <= (size_t)3072 * 4096 * 8, "CP1 alias");
static_assert((size_t)16 * 512 * D * 4 <= (size_t)3072 * 4096 * 8, "PART alias");
static_assert(WS_END < (size_t)1142900000, "workspace too large");
static_assert((size_t)M * 3072 * 2 <= SZ_DN && (size_t)M * DFF * 2 <= (size_t)M * NPAD * 2 && 2 * (size_t)M * D * 4 <= 4 * SZ_SO1, "aliases");

struct Params { const float* in[31]; float* out; unsigned char* ws; };

#define LDS_WAIT() asm volatile("s_waitcnt lgkmcnt(0)" ::: "memory")
#define XB_CNT(j) (64 * (j))
#define XB_SUB(j) (1024 + 64 * (j))
#define XB_TOP 2048
#define XB_GEN 2112
__device__ __forceinline__ unsigned xcc_id() { return (unsigned)__builtin_amdgcn_s_getreg((3 << 11) | 20) & 0xFu; }
__device__ __forceinline__ int otid() { int t = threadIdx.x; asm volatile("" : "+v"(t)); return t; }
__device__ __forceinline__ int obid() { int t = blockIdx.x; asm volatile("" : "+s"(t)); return t; }
__device__ __forceinline__ unsigned pk2(float lo, float hi) { unsigned r; asm("v_cvt_pk_bf16_f32 %0, %1, %2" : "=v"(r) : "v"(lo), "v"(hi)); return r; }
typedef __bf16 bf16v2 __attribute__((ext_vector_type(2)));
__device__ __forceinline__ unsigned pk2n(float lo, float hi) { return __builtin_bit_cast(unsigned, __builtin_convertvector((f32x2){lo, hi}, bf16v2)); }
__device__ __forceinline__ float bflo(unsigned u) { return __uint_as_float(u << 16); }
__device__ __forceinline__ float bfhi(unsigned u) { return __uint_as_float(u & 0xffff0000u); }
__device__ __forceinline__ float bf1(bf16_t u) { return __uint_as_float(((unsigned)u) << 16); }
__device__ __forceinline__ float sigm(float x) { return __builtin_amdgcn_rcpf(1.f + __expf(-x)); }
__device__ __forceinline__ float silu(float x) { return x * sigm(x); }
__device__ __forceinline__ float sin_rad(float x) { float r = x * 0.15915494309189535f; r = r - floorf(r); return __builtin_amdgcn_sinf(r); }
template <int CTRL> __device__ __forceinline__ float dppf(float x) { return __builtin_bit_cast(float, __builtin_amdgcn_update_dpp(0, __builtin_bit_cast(int, x), CTRL, 0xf, 0xf, true)); }
__device__ __forceinline__ float row_sum16(float x) {
    x += dppf<0x128>(x); x += dppf<0x124>(x); x += dppf<0x122>(x); x += dppf<0x121>(x); return x;
}
__device__ __forceinline__ float wave_sum(float v) {
    v = row_sum16(v);
    const int iv = __builtin_bit_cast(int, v);
    const float a = __builtin_bit_cast(float, __builtin_amdgcn_readlane(iv, 0)), b = __builtin_bit_cast(float, __builtin_amdgcn_readlane(iv, 16));
    const float c = __builtin_bit_cast(float, __builtin_amdgcn_readlane(iv, 32)), d = __builtin_bit_cast(float, __builtin_amdgcn_readlane(iv, 48));
    return (a + b) + (c + d);
}
__device__ __forceinline__ void unpack8(u32x4 u, float* f) {
    f[0] = bflo(u.x); f[1] = bfhi(u.x); f[2] = bflo(u.y); f[3] = bfhi(u.y); f[4] = bflo(u.z); f[5] = bfhi(u.z); f[6] = bflo(u.w); f[7] = bfhi(u.w);
}

namespace pg8 {
constexpr int BM = 256, BK = 64, HALF = 128, HTB = HALF * BK * 2, NXCD = 8, WGM = 8;
__device__ __forceinline__ int lds_byte(int r, int c) { const int st = (r >> 4) * 2 + (c >> 5), rr = r & 15, cc = c & 31, ob = rr * 64 + cc * 2; return st * 1024 + (ob ^ (((ob >> 9) & 1) << 5)); }
__device__ __forceinline__ void stage_rc(int b, int& R, int& C) { const int st = b / 1024, sb = b % 1024, swz = sb ^ (((sb >> 9) & 1) << 5); R = (st >> 1) * 16 + swz / 64; C = (st & 1) * 32 + (swz % 64) / 2; }
__device__ __forceinline__ int perm32(int rho) { const int n = rho >> 4, i = rho & 15; return 8 * (i >> 2) + 4 * n + (i & 3); }

struct Unit { int pm, pn, g, nt, split, slot; const char* A; const char* B; };

__device__ __forceinline__ void tile_of(int L, int nM, int nN, int& pm, int& pn) {
    const int nwg = nM * nN; int wgid = L;
    { const int q = nwg / NXCD, r = nwg % NXCD, xcd = wgid % NXCD, off = wgid / NXCD; wgid = (xcd < r ? xcd * (q + 1) : r * (q + 1) + (xcd - r) * q) + off; }
    const int nig = WGM * nN, gid = wgid / nig, fm = gid * WGM, gsz = (nM - fm) < WGM ? (nM - fm) : WGM;
    pm = fm + ((wgid % nig) % gsz); pn = (wgid % nig) / gsz;
}
struct Order {
    const bf16_t* A; const bf16_t* Bt; int lda, ldb, nM, nN, G, c, nsub; size_t aks, bstride;
    int K;
    int latent_only, ctx_ncols;
    int ksplit;
    __device__ __forceinline__ bool next(int i, Unit& u) const {
        const int nmain = nM * nN;
        const int rounds = (nmain > c) ? (nmain - c + G - 1) / G : 0;
        if (i < rounds * nsub) {
            const int ti = i / nsub, g = i - ti * nsub; const int L = ti * G + c;
            tile_of(L, nM, nN, u.pm, u.pn); if (latent_only) u.pm += 1 + (u.pm >= 16);
            u.g = g; u.nt = K / BK; u.split = 0;
            u.A = (const char*)(A + (size_t)u.pm * BM * lda + (size_t)g * aks);
            u.B = (const char*)(Bt + (size_t)g * bstride + (size_t)u.pn * BM * ldb);
            return true;
        }
        const int e = i - rounds * nsub; const long Lx = (long)e * G + c;
        if (ksplit > 0) {
            if (Lx >= (long)2 * nN * nsub * ksplit) return false;
            const int s = (int)Lx, per = nsub * ksplit, tile = s / per, r = s - tile * per, g = r / ksplit, ks = r - g * ksplit, Ks = K / ksplit;
            const int q = tile / nN; u.pm = q * 17; u.pn = tile - q * nN; u.g = g; u.nt = Ks / BK; u.split = 1; u.slot = r;
            u.A = (const char*)(A + (size_t)u.pm * BM * lda + (size_t)g * aks + (size_t)ks * Ks);
            u.B = (const char*)(Bt + (size_t)g * bstride + (size_t)u.pn * BM * ldb + (size_t)ks * Ks);
            return true;
        }
        if (Lx >= (long)2 * ctx_ncols) return false;
        { const int j = (int)Lx; const int q = j / ctx_ncols; u.pm = q * 17; u.pn = j - q * ctx_ncols; }
        u.g = 0; u.nt = K / BK; u.split = 0;
        u.A = (const char*)(A + (size_t)u.pm * BM * lda);
        u.B = (const char*)(Bt + (size_t)u.pn * BM * ldb);
        return true;
    }
};

template <class Epi, class Sched>
__device__ __forceinline__ void gemm_phase(LAS unsigned char* lds, const int lda, const int ldb, const Sched& S, const Epi& E) {
    const int tid = otid(), wid = __builtin_amdgcn_readfirstlane(tid >> 6), lane = tid & 63, wr = wid >> 2, wc = wid & 3, fr = lane & 15, fq = lane >> 4;
    unsigned voffA[2], voffB[2];
#pragma unroll
    for (int i = 0; i < 2; ++i) { int R, C; stage_rc(tid * 16 + i * 8192, R, C); const int Rb = Epi::PERM ? ((R & ~31) + perm32(R & 31)) : R;
        voffA[i] = (unsigned)(R * lda + C) * 2u; voffB[i] = (unsigned)(Rb * ldb + C) * 2u; }
    const size_t kstep = (size_t)(BK * 2);
    const size_t hstepA = (size_t)HALF * lda * 2, hstepB = (size_t)HALF * ldb * 2;
    const unsigned ldsw = (unsigned)wid * 1024u;
    const int aoff = lds_byte(wr * 64 + fr, fq * 8), boff = lds_byte(wc * 32 + fr, fq * 8);
#define PG8_SA(b, h) (((b) * 2 + (h)) * HTB)
#define PG8_SB(b, h) ((4 + (b) * 2 + (h)) * HTB)
#define PG8_STAGE(bufoff, gbase, voff) do { _Pragma("unroll") for (int _i = 0; _i < 2; ++_i) \
        __builtin_amdgcn_global_load_lds((const unsigned*)((const char*)(gbase) + (voff)[_i]), (LAS unsigned*)(lds + (bufoff) + ldsw + _i * 8192), 16, 0, 0); } while (0)
#define PG8_LDA(dst, b, h) do { _Pragma("unroll") for (int m = 0; m < 4; ++m) _Pragma("unroll") for (int k = 0; k < 2; ++k) dst[m][k] = *(const LAS bf16x8*)(lds + PG8_SA(b, h) + aoff + m * 2048 + k * 1024); } while (0)
#define PG8_LDB(dst, b, h) do { _Pragma("unroll") for (int n = 0; n < 2; ++n) _Pragma("unroll") for (int k = 0; k < 2; ++k) dst[n][k] = *(const LAS bf16x8*)(lds + PG8_SB(b, h) + boff + n * 2048 + k * 1024); } while (0)
#define PG8_MMA(ai, bj, At, Bt) do { __builtin_amdgcn_s_setprio(1); _Pragma("unroll") for (int m = 0; m < 4; ++m) _Pragma("unroll") for (int n = 0; n < 2; ++n) _Pragma("unroll") for (int k = 0; k < 2; ++k) \
        acc[ai][bj][m][n] = __builtin_amdgcn_mfma_f32_16x16x32_bf16(Bt[n][k], At[m][k], acc[ai][bj][m][n], 0, 0, 0); __builtin_amdgcn_s_setprio(0); } while (0)
#define PG8_WAIT_V(n) asm volatile("s_waitcnt vmcnt(" #n ")" ::: "memory")
#define PG8_WAIT_L(n) asm volatile("s_waitcnt lgkmcnt(" #n ")" ::: "memory")
#define PG8_BAR __builtin_amdgcn_s_barrier()
#define PG8_SCHED __builtin_amdgcn_sched_barrier(0)
    Unit cur, nxt; int ui = 0;
    if (!S.next(0, cur)) return;
    f32x4 acc[2][2][4][2];
#pragma unroll
    for (int a = 0; a < 2; ++a)
#pragma unroll
        for (int b = 0; b < 2; ++b)
#pragma unroll
            for (int m = 0; m < 4; ++m)
#pragma unroll
                for (int n = 0; n < 2; ++n) acc[a][b][m][n] = (f32x4){0.f, 0.f, 0.f, 0.f};
    bf16x8 At[4][2], B0[2][2], B1[2][2];
    const char* cA = cur.A; const char* cB = cur.B;
    PG8_STAGE(PG8_SB(0, 0), cB, voffB); PG8_STAGE(PG8_SA(0, 0), cA, voffA); PG8_STAGE(PG8_SB(0, 1), cB + hstepB, voffB); PG8_STAGE(PG8_SA(0, 1), cA + hstepA, voffA);
    if (wr == 1) PG8_BAR;
    PG8_WAIT_V(4); PG8_BAR;
    PG8_STAGE(PG8_SB(1, 0), cB + kstep, voffB); PG8_STAGE(PG8_SA(1, 0), cA + kstep, voffA); PG8_STAGE(PG8_SB(1, 1), cB + hstepB + kstep, voffB);
    PG8_WAIT_V(6); PG8_BAR;
    for (;;) {
        const bool has_next = S.next(ui + 1, nxt);
        const char* nA = has_next ? nxt.A : cA; const char* nB = has_next ? nxt.B : cB;
        const int nt = cur.nt;
        for (int t = 0; t < nt; t += 2) {
            const bool last = (t == nt - 2);
            const char* a1 = cA + (size_t)(t + 1) * kstep;
            const char* a2 = last ? nA : cA + (size_t)(t + 2) * kstep; const char* b2 = last ? nB : cB + (size_t)(t + 2) * kstep;
            const char* a3 = a2 + kstep; const char* b3 = b2 + kstep;
            PG8_LDB(B0, 0, 0); PG8_SCHED; PG8_LDA(At, 0, 0); PG8_STAGE(PG8_SA(1, 1), a1 + hstepA, voffA);
            PG8_WAIT_L(8); PG8_BAR; PG8_WAIT_L(0); PG8_MMA(0, 0, At, B0); PG8_BAR; PG8_SCHED;
            PG8_LDB(B1, 0, 1); PG8_STAGE(PG8_SB(0, 0), b2, voffB);
            PG8_BAR; PG8_WAIT_L(0); PG8_MMA(0, 1, At, B1); PG8_BAR;
            PG8_LDA(At, 0, 1); PG8_STAGE(PG8_SA(0, 0), a2, voffA);
            PG8_BAR; PG8_WAIT_L(0); PG8_MMA(1, 0, At, B0); PG8_BAR; PG8_SCHED;
            PG8_STAGE(PG8_SB(0, 1), b2 + hstepB, voffB);
            PG8_WAIT_V(6); PG8_BAR; PG8_MMA(1, 1, At, B1); PG8_BAR;
            PG8_LDB(B0, 1, 0); PG8_SCHED; PG8_LDA(At, 1, 0); PG8_STAGE(PG8_SA(0, 1), a2 + hstepA, voffA);
            PG8_WAIT_L(8); PG8_BAR; PG8_WAIT_L(0); PG8_MMA(0, 0, At, B0); PG8_BAR; PG8_SCHED;
            PG8_LDB(B1, 1, 1); PG8_STAGE(PG8_SB(1, 0), b3, voffB);
            PG8_BAR; PG8_WAIT_L(0); PG8_MMA(0, 1, At, B1); PG8_BAR;
            PG8_LDA(At, 1, 1); PG8_STAGE(PG8_SA(1, 0), a3, voffA);
            PG8_BAR; PG8_WAIT_L(0); PG8_MMA(1, 0, At, B0); PG8_BAR; PG8_SCHED;
            PG8_STAGE(PG8_SB(1, 1), b3 + hstepB, voffB);
            PG8_WAIT_V(6); PG8_BAR; PG8_MMA(1, 1, At, B1); PG8_BAR;
        }
        E(acc, cur, wr, wc, fr, fq);
        if (!has_next) break;
#pragma unroll
        for (int a = 0; a < 2; ++a)
#pragma unroll
            for (int b = 0; b < 2; ++b)
#pragma unroll
                for (int m = 0; m < 4; ++m)
#pragma unroll
                    for (int n = 0; n < 2; ++n) acc[a][b][m][n] = (f32x4){0.f, 0.f, 0.f, 0.f};
        cur = nxt; cA = nA; cB = nB; ++ui;
    }
    PG8_WAIT_V(0);
    if (wr == 0) PG8_BAR;
    PG8_BAR;
#undef PG8_SA
#undef PG8_SB
#undef PG8_STAGE
#undef PG8_LDA
#undef PG8_LDB
#undef PG8_MMA
#undef PG8_WAIT_V
#undef PG8_WAIT_L
#undef PG8_BAR
#undef PG8_SCHED
}

template <int ACT> struct EpiBf16 {
    static constexpr bool PERM = true;
    bf16_t* O; int ldc;
    __device__ __forceinline__ void operator()(const f32x4 (&acc)[2][2][4][2], const Unit& u, int wr, int wc, int fr, int fq) const {
        const int row0 = u.pm * BM + wr * 64 + fr, col0 = u.pn * BM + wc * 32 + 8 * fq;
#pragma unroll
        for (int ai = 0; ai < 2; ++ai)
#pragma unroll
            for (int m = 0; m < 4; ++m) { bf16_t* rowp = O + (size_t)(row0 + ai * HALF + m * 16) * ldc + col0;
#pragma unroll
                for (int bj = 0; bj < 2; ++bj) { f32x4 v0 = acc[ai][bj][m][0], v1 = acc[ai][bj][m][1];
                    if (ACT == 1) {
#pragma unroll
                        for (int e = 0; e < 4; ++e) { float a = fmaxf(v0[e], 0.f), b = fmaxf(v1[e], 0.f); v0[e] = a * a; v1[e] = b * b; } }
                    u32x4 o; o.x = pk2(v0[0], v0[1]); o.y = pk2(v0[2], v0[3]); o.z = pk2(v1[0], v1[1]); o.w = pk2(v1[2], v1[3]);
                    *(u32x4*)(rowp + bj * HALF) = o; } }
    }
};
struct EpiRes {
    static constexpr bool PERM = true;
    bf16_t* T; const float* X; const float* mod; int gidx; float* PART;
    __device__ __forceinline__ void operator()(const f32x4 (&acc)[2][2][4][2], const Unit& u, int wr, int wc, int fr, int fq) const {
        const int row0 = u.pm * BM + wr * 64 + fr, col0 = u.pn * BM + wc * 32 + 8 * fq;
        const int b = u.pm / 17, isctx = (u.pm - b * 17) == 0;
        const float* gv = mod + (size_t)(isctx ? 2 : b) * (6 * D) + (size_t)gidx * D;
#pragma unroll
        for (int bj = 0; bj < 2; ++bj) { const int col = col0 + bj * HALF; const f32x4 g0 = *(const f32x4*)(gv + col), g1 = *(const f32x4*)(gv + col + 4);
#pragma unroll
            for (int ai = 0; ai < 2; ++ai)
#pragma unroll
                for (int m = 0; m < 4; ++m) { const int row = row0 + ai * HALF + m * 16; const size_t o = (size_t)row * D + col;
                    const f32x4 t0 = g0 * acc[ai][bj][m][0], t1 = g1 * acc[ai][bj][m][1];
                    if (u.split) { float* pp = PART + ((size_t)u.slot * 512 + (row - u.pm * BM + (u.pm ? 256 : 0))) * D + col; *(f32x4*)pp = t0; *(f32x4*)(pp + 4) = t1; }
                    else { u32x4 ov; ov.x = pk2(t0[0], t0[1]); ov.y = pk2(t0[2], t0[3]); ov.z = pk2(t1[0], t1[1]); ov.w = pk2(t1[2], t1[3]); *(u32x4*)(T + o) = ov; } } }
    }
};
struct EpiBranch {
    static constexpr bool PERM = true;
    float* S; bf16_t* SB; const bf16_t* H; float* SCTX;
    __device__ __forceinline__ void operator()(const f32x4 (&acc)[2][2][4][2], const Unit& u, int wr, int wc, int fr, int fq) const {
        const int row0 = u.pm * BM + wr * 64 + fr, col0 = u.pn * BM + wc * 32 + 8 * fq; const int g = u.g;
#pragma unroll
        for (int ai = 0; ai < 2; ++ai)
#pragma unroll
            for (int m = 0; m < 4; ++m) { const int row = row0 + ai * HALF + m * 16;
#pragma unroll
                for (int bj = 0; bj < 2; ++bj) { const int col = col0 + bj * HALF;
                    float gt[8]; unpack8(*(const u32x4*)(H + (size_t)row * NPAD + C_GATE + g * D + col), gt);
                    float v[8];
#pragma unroll
                    for (int e = 0; e < 4; ++e) { v[e] = sigm(gt[e]) * acc[ai][bj][m][0][e]; v[4 + e] = sigm(gt[4 + e]) * acc[ai][bj][m][1][e]; }
                    if (u.split) { float* cp = SCTX + ((size_t)u.slot * 512 + (row - u.pm * BM + (u.pm ? 256 : 0))) * D + col;
                        *(f32x4*)cp = (f32x4){v[0], v[1], v[2], v[3]}; *(f32x4*)(cp + 4) = (f32x4){v[4], v[5], v[6], v[7]}; }
                    else {
                        bf16_t* sp = SB + (size_t)row * D + col;
                        if (g > 0) { float pv[8]; unpack8(*(const u32x4*)sp, pv);
#pragma unroll
                            for (int e = 0; e < 8; ++e) v[e] += pv[e]; }
                        u32x4 o; o.x = pk2(v[0], v[1]); o.y = pk2(v[2], v[3]); o.z = pk2(v[4], v[5]); o.w = pk2(v[6], v[7]); *(u32x4*)sp = o; } } }
    }
};
}

__device__ __forceinline__ void transpose_item(const float* __restrict__ W, int K, int N, bf16_t* __restrict__ WT, LAS float* scr, int item, int lane) {
    const int nblk = N / 32, kb = item / nblk, nb = item - kb * nblk, k0 = 64 * kb, n0 = 32 * nb;
#pragma unroll 8
    for (int i = 0; i < 32; ++i) { const int kk = 2 * i + (lane >> 5); scr[kk * 33 + (lane & 31)] = W[(size_t)(k0 + kk) * N + n0 + (lane & 31)]; }
    LDS_WAIT();
    const int c = lane & 7;
#pragma unroll
    for (int j = 0; j < 4; ++j) { const int n = (lane >> 3) + 8 * j; const LAS float* s = scr + (8 * c) * 33 + n;
        u32x4 o; o.x = pk2(s[0 * 33], s[1 * 33]); o.y = pk2(s[2 * 33], s[3 * 33]); o.z = pk2(s[4 * 33], s[5 * 33]); o.w = pk2(s[6 * 33], s[7 * 33]);
        *(u32x4*)(WT + (size_t)(n0 + n) * K + k0 + 8 * c) = o; }
    LDS_WAIT();
}

__device__ __forceinline__ void transpose_item64(const float* __restrict__ W, int K, int N, bf16_t* __restrict__ WT, LAS float* scr, int item, int lane) {
    const int nblk = (N + 63) >> 6, kb = item / nblk, nb = item - kb * nblk, k0 = 64 * kb, n0 = 64 * nb;
    const bool valid = (n0 + lane) < N;
    float wv[64];
    const float* wp = W + (size_t)k0 * N + n0 + (valid ? lane : 0);
#pragma unroll
    for (int i = 0; i < 64; ++i) wv[i] = __builtin_nontemporal_load(wp + (size_t)i * N);
#pragma unroll
    for (int i = 0; i < 64; ++i) scr[i * 65 + lane] = wv[i];
    LDS_WAIT();
#pragma unroll
    for (int j = 0; j < 8; ++j) { const int task = lane + 64 * j, n = task >> 3, c = task & 7; const LAS float* s = scr + (8 * c) * 65 + n;
        u32x4 o; o.x = pk2(s[0 * 65], s[1 * 65]); o.y = pk2(s[2 * 65], s[3 * 65]); o.z = pk2(s[4 * 65], s[5 * 65]); o.w = pk2(s[6 * 65], s[7 * 65]);
        if (n0 + n < N) *(u32x4*)(WT + (size_t)(n0 + n) * K + k0 + 8 * c) = o; }
    LDS_WAIT();
}

__device__ __forceinline__ void phase0(const Params& P, LAS unsigned char* lds) {
    const int tid = otid(), lane = tid & 63, wave = tid >> 6, G = gridDim.x;
    unsigned char* ws = P.ws;
    {
        LAS float* sil = (LAS float*)lds;
        LAS float* red = sil + 3 * 2048;
        for (int i = tid; i < 3 * 2048; i += NTHR) { const int v = i >> 11, k = i & 2047; const float x = (v < 2) ? P.in[1][v * 2048 + k] : P.in[3][k]; sil[i] = silu(x); }
        __syncthreads();
        for (int vb = blockIdx.x; vb < 256; vb += G) {
            const int colg = vb * 96, l = colg / 12288, cl = colg - l * 12288;
            if (tid < 504) {
                const int c4 = tid % 24, kg = tid / 24;
                f32x4 a0 = {0.f, 0.f, 0.f, 0.f}, a1 = a0, a2 = a0;
                const float* wp = P.in[4] + (size_t)l * 2048 * 12288 + cl + c4 * 4;
                int k = kg;
#pragma unroll 1
                for (; k + 21 * 15 < 2048; k += 21 * 16) {
                    f32x4 w[16];
#pragma unroll
                    for (int u = 0; u < 16; ++u) w[u] = __builtin_nontemporal_load((const f32x4*)(wp + (size_t)(k + 21 * u) * 12288));
#pragma unroll
                    for (int u = 0; u < 16; ++u) { a0 += sil[k + 21 * u] * w[u]; a1 += sil[2048 + k + 21 * u] * w[u]; a2 += sil[4096 + k + 21 * u] * w[u]; } }
                for (; k < 2048; k += 21) { const f32x4 w = *(const f32x4*)(wp + (size_t)k * 12288); a0 += sil[k] * w; a1 += sil[2048 + k] * w; a2 += sil[4096 + k] * w; }
                LAS float* rp = red + (kg * 24 + c4) * 12;
#pragma unroll
                for (int e = 0; e < 4; ++e) { rp[e] = a0[e]; rp[4 + e] = a1[e]; rp[8 + e] = a2[e]; }
            }
            __syncthreads();
            if (tid < 288) { const int c4 = tid / 12, ve = tid - c4 * 12, v = ve >> 2, e = ve & 3; float s = 0.f;
                for (int kg = 0; kg < 21; ++kg) s += red[(kg * 24 + c4) * 12 + ve];
                const int col = cl + c4 * 4 + e;
                ((float*)(ws + WS_MOD))[(size_t)(l * 3 + v) * 12288 + col] = s + P.in[5][l * 12288 + col]; }
            __syncthreads();
        }
    }
    {
        LAS float* feats = (LAS float*)lds;
        LAS float* hid1 = feats + 8 * 36;
        for (int item = blockIdx.x; item < 2 * 544; item += G) {
            const int l = item / 544, it = item - l * 544, lsel = it >= 512, L = lsel ? 256 : 4096, t0 = (lsel ? it - 512 : it) * 8;
            const int tt = tid >> 6, j = tid & 63, t = t0 + tt;
            if (j < 33) { float f;
                if (j == 0) f = (float)t / (float)(L - 1);
                else { const int bi = (j - 1) & 15; const float band = 1e-4f + (float)bi * ((15.f - 1e-4f) / 15.f); float rev = band * ((float)t / (float)L); rev = rev - floorf(rev);
                    f = (j <= 16) ? __builtin_amdgcn_cosf(rev) : -__builtin_amdgcn_sinf(rev); }
                feats[tt * 36 + j] = f; }
            __syncthreads();
            { const float* w1 = P.in[9] + (size_t)l * 33 * 64; float a = P.in[10][l * 64 + j];
              for (int f = 0; f < 33; ++f) a += feats[tt * 36 + f] * w1[f * 64 + j];
              hid1[tt * 64 + j] = sin_rad(a); }
            __syncthreads();
            { const float* w2 = P.in[11] + (size_t)l * 64 * 64; float a = P.in[12][l * 64 + j];
              for (int i = 0; i < 64; ++i) a += hid1[tt * 64 + i] * w2[i * 64 + j];
              float* hid = (float*)(ws + WS_HID + (size_t)l * SZ_HID1) + (lsel ? 64 * 4096 : 0);
              hid[(size_t)j * L + t] = sin_rad(a); }
            __syncthreads();
        }
    }
    if (tid == 0) (void)__hip_atomic_fetch_add((unsigned*)(ws + WS_BAR) + XB_CNT(xcc_id()), 1u, __ATOMIC_RELAXED, __HIP_MEMORY_SCOPE_AGENT);
    for (int i = blockIdx.x * NTHR + tid; i < DEPTH * 2 * 1024; i += G * NTHR) {
        const int l = i >> 11, dir = (i >> 10) & 1, ch = i & 1023;
        float x[DEPTH], mx = -1e30f;
#pragma unroll
        for (int q = 0; q < DEPTH; ++q) { x[q] = P.in[15][((size_t)dir * DEPTH + q) * 1024 + ch]; mx = fmaxf(mx, x[q]); }
        float den = 0.f, num = 0.f;
#pragma unroll
        for (int q = 0; q < DEPTH; ++q) { const float e = __expf(x[q] - mx); den += e; if (q >= 1 && q <= l) num += e; }
        ((float*)(ws + WS_LB))[i] = num / den;
    }
    for (int i = blockIdx.x * NTHR + tid; i < DEPTH * (NPAD - INC) * D / 8; i += G * NTHR) {
        const int per = (NPAD - INC) * D / 8, l = i / per, r = i - l * per;
        ((u32x4*)(ws + WS_WIN + (size_t)l * SZ_WIN + (size_t)INC * D * 2))[r] = (u32x4){0u, 0u, 0u, 0u};
    }
    {
        LAS float* scr = (LAS float*)(lds + wave * 16896);
        const int gw = blockIdx.x * NWAVES + wave, NGW = G * NWAVES;
        constexpr int I_IN = 32 * 273, I_BR = 16 * 32, I_OUT = 32 * 32, I_F1 = 32 * 128, I_F2 = 128 * 32;
        constexpr int PER = I_IN + 3 * I_BR + I_OUT + I_F1 + I_F2;
        for (int it = gw; it < (DEPTH - 1) * PER; it += NGW) {
            const int l = it / PER; int r = it - l * PER;
            if (r < I_IN) { transpose_item64(P.in[6] + (size_t)l * D * INC, D, INC, (bf16_t*)(ws + WS_WIN + (size_t)l * SZ_WIN), scr, r, lane); continue; } r -= I_IN;
            if (r < 3 * I_BR) { const int g = r / I_BR; transpose_item64(P.in[23] + (size_t)(l * 3 + g) * 1024 * D, 1024, D, (bf16_t*)(ws + WS_WBR + (size_t)(l * 3 + g) * SZ_WBR), scr, r - g * I_BR, lane); continue; } r -= 3 * I_BR;
            if (r < I_OUT) { transpose_item64(P.in[24] + (size_t)l * D * D, D, D, (bf16_t*)(ws + WS_WOUT + (size_t)l * SZ_WOUT), scr, r, lane); continue; } r -= I_OUT;
            if (r < I_F1) { transpose_item64(P.in[27] + (size_t)l * D * DFF, D, DFF, (bf16_t*)(ws + WS_WFF1 + (size_t)l * SZ_WFF), scr, r, lane); continue; } r -= I_F1;
            transpose_item64(P.in[28] + (size_t)l * DFF * D, DFF, D, (bf16_t*)(ws + WS_WFF2 + (size_t)l * SZ_WFF), scr, r, lane);
        }
    }
}

__device__ __forceinline__ void init_rows(const Params& P) {
    const int tid = otid(); const int lane = tid & 63, gw = blockIdx.x * NWAVES + (tid >> 6), NGW = gridDim.x * NWAVES;
    float* X = (float*)(P.ws + WS_X); bf16_t* U = (bf16_t*)(P.ws + WS_U); const float* mod = (const float*)(P.ws + WS_MOD);
#define INIT_SRC(r_) (((r_) % TPB) < CTX ? P.in[2] + ((size_t)((r_) / TPB) * CTX + ((r_) % TPB)) * D : P.in[0] + ((size_t)((r_) / TPB) * SEQ + (((r_) % TPB) - CTX)) * D)
    f32x4 cv[8];
#pragma unroll
    for (int j = 0; j < 8; ++j) cv[j] = (f32x4){0.f, 0.f, 0.f, 0.f};
    if (gw < M) { const float* s0 = INIT_SRC(gw);
#pragma unroll
        for (int j = 0; j < 8; ++j) cv[j] = __builtin_nontemporal_load((const f32x4*)(s0 + (j * 64 + lane) * 4)); }
#pragma unroll 1
    for (int r = gw; r < M; r += NGW) {
        const int b = r / TPB, p = r - b * TPB; const bool isctx = p < CTX;
        f32x4 nv[8];
#pragma unroll
        for (int j = 0; j < 8; ++j) nv[j] = (f32x4){0.f, 0.f, 0.f, 0.f};
        if (r + NGW < M) { const float* s1 = INIT_SRC(r + NGW);
#pragma unroll
            for (int j = 0; j < 8; ++j) nv[j] = __builtin_nontemporal_load((const f32x4*)(s1 + (j * 64 + lane) * 4)); }
        const float* mv = mod + (size_t)(isctx ? 2 : b) * (6 * D);
#pragma unroll
        for (int j = 0; j < 8; ++j) { const int c = (j * 64 + lane) * 4; const f32x4 v = cv[j];
            *(f32x4*)(X + (size_t)r * D + c) = v;
            const f32x4 sh = *(const f32x4*)(mv + c), sc = *(const f32x4*)(mv + D + c); const f32x4 y = v * (1.f + sc) + sh;
            u32x2 o; o.x = pk2(y[0], y[1]); o.y = pk2(y[2], y[3]); *(u32x2*)(U + (size_t)r * D + c) = o; }
#pragma unroll
        for (int j = 0; j < 8; ++j) cv[j] = nv[j];
    }
#undef INIT_SRC
}
__device__ __forceinline__ void ln_rows(const Params& P, const float* gam, const float* bet, const float* modU, int shidx, bool writeU, bool writeOut, int nsplit, bool skipctx) {
    const int tid = otid(); const int lane = tid & 63, gw = blockIdx.x * NWAVES + (tid >> 6), NGW = gridDim.x * NWAVES;
    float* X = (float*)(P.ws + WS_X); bf16_t* U = (bf16_t*)(P.ws + WS_U); const bf16_t* T = (const bf16_t*)(P.ws + WS_SO + (size_t)M * D * 4);
    f32x4 gv[8], bv[8];
#pragma unroll
    for (int j = 0; j < 8; ++j) { gv[j] = *(const f32x4*)(gam + (j * 64 + lane) * 4); bv[j] = *(const f32x4*)(bet + (j * 64 + lane) * 4); }
    int r = gw;
    while (r < M && skipctx && (r % TPB) < CTX) r += NGW;
    f32x4 cx[8]; u32x2 ct[8]; bool pf = false;
#pragma unroll
    for (int j = 0; j < 8; ++j) { cx[j] = (f32x4){0.f, 0.f, 0.f, 0.f}; ct[j] = (u32x2){0u, 0u}; }
    if (r < M && !((r % TPB) < CTX && nsplit > 0)) { pf = true;
#pragma unroll
        for (int j = 0; j < 8; ++j) { const int c = (j * 64 + lane) * 4; cx[j] = *(const f32x4*)(X + (size_t)r * D + c); ct[j] = *(const u32x2*)(T + (size_t)r * D + c); } }
#pragma unroll 1
    while (r < M) {
        int rn = r + NGW;
        while (rn < M && skipctx && (rn % TPB) < CTX) rn += NGW;
        f32x4 nx[8]; u32x2 nt[8]; bool npf = false;
#pragma unroll
        for (int j = 0; j < 8; ++j) { nx[j] = (f32x4){0.f, 0.f, 0.f, 0.f}; nt[j] = (u32x2){0u, 0u}; }
        if (rn < M && !((rn % TPB) < CTX && nsplit > 0)) { npf = true;
#pragma unroll
            for (int j = 0; j < 8; ++j) { const int c = (j * 64 + lane) * 4; nx[j] = *(const f32x4*)(X + (size_t)rn * D + c); nt[j] = *(const u32x2*)(T + (size_t)rn * D + c); } }
        const int b = r / TPB, p = r - b * TPB; const bool isctx = p < CTX;
        f32x4 v[8]; float s = 0.f;
#pragma unroll
        for (int j = 0; j < 8; ++j) { const int c = (j * 64 + lane) * 4;
            if (!pf) {
                f32x4 a = *(const f32x4*)(X + (size_t)r * D + c) * ALPHA; const float* pp = (const float*)(P.ws + WS_SCTX) + ((size_t)b * 256 + p) * D + c;
                for (int q = 0; q < nsplit; ++q) a += *(const f32x4*)(pp + (size_t)q * 512 * D);
                v[j] = a; }
            else v[j] = cx[j] * ALPHA + (f32x4){bflo(ct[j].x), bfhi(ct[j].x), bflo(ct[j].y), bfhi(ct[j].y)};
            s += (v[j][0] + v[j][1]) + (v[j][2] + v[j][3]); }
        const float mean = wave_sum(s) * (1.f / D); float s2 = 0.f;
#pragma unroll
        for (int j = 0; j < 8; ++j) { v[j] = v[j] - mean; s2 += (v[j][0] * v[j][0] + v[j][1] * v[j][1]) + (v[j][2] * v[j][2] + v[j][3] * v[j][3]); }
        const float rstd = __builtin_amdgcn_rsqf(wave_sum(s2) * (1.f / D) + 1e-5f);
        const float* mv = modU + (size_t)(isctx ? 2 : b) * (6 * D) + (size_t)shidx * D;
#pragma unroll
        for (int j = 0; j < 8; ++j) { const int c = (j * 64 + lane) * 4;
            const f32x4 y = v[j] * rstd * gv[j] + bv[j];
            if (!writeOut) *(f32x4*)(X + (size_t)r * D + c) = y;
            if (writeU) { const f32x4 sh = *(const f32x4*)(mv + c), sc = *(const f32x4*)(mv + D + c); const f32x4 z = y * (1.f + sc) + sh;
                u32x2 o; o.x = pk2(z[0], z[1]); o.y = pk2(z[2], z[3]); *(u32x2*)(U + (size_t)r * D + c) = o; }
            if (writeOut && !isctx) *(f32x4*)(P.out + ((size_t)b * SEQ + (p - CTX)) * D + c) = y; }
#pragma unroll
        for (int j = 0; j < 8; ++j) { cx[j] = nx[j]; ct[j] = nt[j]; }
        pf = npf; r = rn;
    }
}

__device__ __forceinline__ void prep_phase(const Params& P, int l, LAS unsigned char* lds) {
    const int tid = otid(), lane = tid & 63, wave = tid >> 6, G = gridDim.x;
    const int gw = blockIdx.x * NWAVES + wave, NGW = G * NWAVES;
    unsigned char* ws = P.ws;
    const bf16_t* H = (const bf16_t*)(ws + WS_H);
    float* DNK = (float*)(ws + WS_DN + OFF_DNK); float* DNQ = (float*)(ws + WS_DN + OFF_DNQ); float* DNV = (float*)(ws + WS_DN + OFF_DNV); float* DNS = (float*)(ws + WS_DN + OFF_DNS);
    {
        const u32x4 z4 = {0u, 0u, 0u, 0u};
#define DNP_LOAD(hu, ga, gb, row) do { const int p_ = (row) % TPB; \
            const bool hasL_ = (p_ < CTX) ? (p_ > 0) : ((p_ & 63) != 0), hasR_ = (p_ < CTX) ? (p_ < CTX - 1) : ((p_ & 63) != 63); \
            const bf16_t* h_ = H + (size_t)(row) * NPAD; \
            _Pragma("unroll") for (int w_ = 0; w_ < 4; ++w_) { const int col_ = (w_ == 0 ? C_DNK : w_ == 1 ? C_DNQ : C_DNV + (w_ - 2) * 512) + lane * 8; \
                hu[3 * w_ + 0] = hasL_ ? *(const u32x4*)(h_ - NPAD + col_) : z4; hu[3 * w_ + 1] = *(const u32x4*)(h_ + col_); hu[3 * w_ + 2] = hasR_ ? *(const u32x4*)(h_ + NPAD + col_) : z4; } \
            ga = h_[C_DNA + (lane & 15)]; gb = h_[C_DNB + (lane & 15)]; } while (0)
        float cwk[3][8], cwq[3][8], cwv[2][3][8];
#pragma unroll
        for (int j = 0; j < 3; ++j)
#pragma unroll
            for (int e = 0; e < 8; ++e) { cwk[j][e] = P.in[18][(size_t)l * 3 * 512 + j * 512 + lane * 8 + e]; cwq[j][e] = P.in[17][(size_t)l * 3 * 512 + j * 512 + lane * 8 + e];
                cwv[0][j][e] = P.in[19][(size_t)l * 3 * 1024 + j * 1024 + lane * 8 + e]; cwv[1][j][e] = P.in[19][(size_t)l * 3 * 1024 + j * 1024 + 512 + lane * 8 + e]; }
        int r = gw;
        u32x4 ch_[12]; bf16_t cga = 0, cgb = 0;
#pragma unroll
        for (int i = 0; i < 12; ++i) ch_[i] = z4;
        if (r < M) DNP_LOAD(ch_, cga, cgb, r);
#pragma unroll 1
        while (r < M) {
            const int rn_ = r + NGW;
            u32x4 nh_[12]; bf16_t nga = 0, ngb = 0;
#pragma unroll
            for (int i = 0; i < 12; ++i) nh_[i] = z4;
            if (rn_ < M) DNP_LOAD(nh_, nga, ngb, rn_);
            float kn[8], qn[8];
#pragma unroll
            for (int which = 0; which < 2; ++which) {
                float xm[8], x0[8], xp[8]; unpack8(ch_[3 * which], xm); unpack8(ch_[3 * which + 1], x0); unpack8(ch_[3 * which + 2], xp);
                float y[8], ss = 0.f;
#pragma unroll
                for (int e = 0; e < 8; ++e) { y[e] = silu(xm[e] * (which ? cwq[0][e] : cwk[0][e]) + x0[e] * (which ? cwq[1][e] : cwk[1][e]) + xp[e] * (which ? cwq[2][e] : cwk[2][e])); ss += y[e] * y[e]; }
                ss = row_sum16(ss);
                const float rn = __builtin_amdgcn_rsqf(ss + 1e-6f) * (which ? 0.08838834764831845f : 1.f);
#pragma unroll
                for (int e = 0; e < 8; ++e) { if (which) qn[e] = y[e] * rn; else kn[e] = y[e] * rn; }
            }
            float qk = 0.f;
#pragma unroll
            for (int e = 0; e < 8; ++e) qk += qn[e] * kn[e];
            qk = row_sum16(qk);
            *(f32x4*)(DNK + (size_t)r * 512 + lane * 8) = (f32x4){kn[0], kn[1], kn[2], kn[3]}; *(f32x4*)(DNK + (size_t)r * 512 + lane * 8 + 4) = (f32x4){kn[4], kn[5], kn[6], kn[7]};
            *(f32x4*)(DNQ + (size_t)r * 512 + lane * 8) = (f32x4){qn[0], qn[1], qn[2], qn[3]}; *(f32x4*)(DNQ + (size_t)r * 512 + lane * 8 + 4) = (f32x4){qn[4], qn[5], qn[6], qn[7]};
#pragma unroll
            for (int half = 0; half < 2; ++half) {
                const int cc = half * 512 + lane * 8;
                float xm[8], x0[8], xp[8]; unpack8(ch_[6 + 3 * half], xm); unpack8(ch_[6 + 3 * half + 1], x0); unpack8(ch_[6 + 3 * half + 2], xp);
                float y[8];
#pragma unroll
                for (int e = 0; e < 8; ++e) y[e] = silu(xm[e] * cwv[half][0][e] + x0[e] * cwv[half][1][e] + xp[e] * cwv[half][2][e]);
                *(f32x4*)(DNV + (size_t)r * 1024 + cc) = (f32x4){y[0], y[1], y[2], y[3]}; *(f32x4*)(DNV + (size_t)r * 1024 + cc + 4) = (f32x4){y[4], y[5], y[6], y[7]};
            }
            {
                const int hd = lane & 7, dir = (lane >> 3) & 1;
                const float qkh = __shfl(qk, 16 * (hd >> 1));
                if (lane < 16) {
                    const float araw = bf1(cga), braw = bf1(cgb);
                    const float xx = araw + P.in[21][(l * 2 + dir) * 8 + hd];
                    float sp; if (xx > 15.f) sp = xx; else { const float e = __expf(xx); sp = (e < 1e-3f) ? e * (1.f - e * (0.5f - e * (1.f / 3.f))) : __logf(1.f + e); }
                    const float gg = -__expf(P.in[20][(l * 2 + dir) * 8 + hd]) * sp;
                    *(f32x4*)(DNS + ((size_t)r * 16 + dir * 8 + hd) * 4) = (f32x4){__expf(gg), sigm(braw), qkh, gg};
                }
            }
#pragma unroll
            for (int i = 0; i < 12; ++i) ch_[i] = nh_[i];
            cga = nga; cgb = ngb; r = rn_;
        }
#undef DNP_LOAD
    }
    {
        LAS float* L = (LAS float*)lds;
        unsigned* ZT = (unsigned*)(ws + WS_ZT);
#define HYP_LOAD(hv_, item_) do { const int ti_ = (item_) / 48, ct_ = (item_) - ti_ * 48; \
            _Pragma("unroll") for (int u = 0; u < 2; ++u) { const int rowi = (tid >> 3) + 64 * u, bb = rowi >> 6, tt = rowi & 63, ch8 = tid & 7; \
                hv_[u] = *(const u32x4*)(H + ((size_t)bb * TPB + CTX + ti_ * 64 + tt) * NPAD + C_HY + ct_ * 64 + ch8 * 8); } } while (0)
        u32x4 chv[2] = {(u32x4){0u, 0u, 0u, 0u}, (u32x4){0u, 0u, 0u, 0u}};
        if ((int)blockIdx.x < 64 * 48) HYP_LOAD(chv, blockIdx.x);
#pragma unroll 1
        for (int item = blockIdx.x; item < 64 * 48; item += G) {
            const int ti = item / 48, ct = item - ti * 48;
            u32x4 nhv[2] = {(u32x4){0u, 0u, 0u, 0u}, (u32x4){0u, 0u, 0u, 0u}};
            if (item + G < 64 * 48) HYP_LOAD(nhv, item + G);
#pragma unroll
            for (int u = 0; u < 2; ++u) { const int rowi = (tid >> 3) + 64 * u, bb = rowi >> 6, tt = rowi & 63, ch8 = tid & 7;
                float f[8]; unpack8(chv[u], f);
#pragma unroll
                for (int e = 0; e < 8; ++e) L[(bb * 64 + tt) * 65 + ch8 * 8 + e] = f[e]; }
            asm volatile("s_waitcnt lgkmcnt(0)" ::: "memory"); __builtin_amdgcn_s_barrier(); asm volatile("" ::: "memory");
            { const int tt = tid & 63;
#pragma unroll
              for (int u = 0; u < 8; ++u) { const int cc = (tid >> 6) + 8 * u, ch = ct * 64 + cc;
                const float* cw = P.in[7] + (size_t)l * 3 * 3072 + ch; const float w0 = cw[0], w1 = cw[3072], w2 = cw[6144], bias = P.in[8][l * 3072 + ch];
                f32x2 o;
#pragma unroll
                for (int bb = 0; bb < 2; ++bb) { const LAS float* lp = L + (bb * 64 + tt) * 65 + cc;
                    const float xm = tt > 0 ? lp[-65] : 0.f, xp = tt < 63 ? lp[65] : 0.f; o[bb] = xm * w0 + lp[0] * w1 + xp * w2 + bias; }
                ZT[(size_t)ch * 4096 + ti * 64 + tt] = pk2(o[0], o[1]); } }
            asm volatile("s_waitcnt lgkmcnt(0)" ::: "memory"); __builtin_amdgcn_s_barrier(); asm volatile("" ::: "memory");
            chv[0] = nhv[0]; chv[1] = nhv[1];
        }
#undef HYP_LOAD
    }
    if (l == 0) {
        float* ZC = (float*)(ws + WS_ZC);
        const u32x4 z4 = {0u, 0u, 0u, 0u};
        for (int i8 = blockIdx.x * NTHR + tid; i8 < 2 * 256 * 384; i8 += G * NTHR) {
            const int ch = (i8 % 384) * 8, bt = i8 / 384, t = bt & 255, bb = bt >> 8;
            const bf16_t* hp = H + ((size_t)bb * TPB + t) * NPAD + C_HY + ch;
            float xm[8], x0[8], xp[8]; unpack8(t > 0 ? *(const u32x4*)(hp - NPAD) : z4, xm); unpack8(*(const u32x4*)hp, x0); unpack8(t < 255 ? *(const u32x4*)(hp + NPAD) : z4, xp);
            const float* cw = P.in[7] + ch; const float* cb = P.in[8] + ch;
            float y[8];
#pragma unroll
            for (int e = 0; e < 8; ++e) y[e] = xm[e] * cw[e] + x0[e] * cw[3072 + e] + xp[e] * cw[6144 + e] + cb[e];
            float* zp = ZC + (size_t)bt * 3072 + ch;
            *(f32x4*)zp = (f32x4){y[0], y[1], y[2], y[3]}; *(f32x4*)(zp + 4) = (f32x4){y[4], y[5], y[6], y[7]};
        }
    }
}

__device__ __forceinline__ void chunkprep_phase(const Params& P, LAS unsigned char* lds) {
    const int tid = otid(), lane = tid & 63, wave = tid >> 6, t = lane & 15, kq = lane >> 4;
    const int gw = blockIdx.x * NWAVES + wave, NGW = gridDim.x * NWAVES;
    unsigned char* ws = P.ws;
    const float* DNK = (const float*)(ws + WS_DN + OFF_DNK); const float* DNQ = (const float*)(ws + WS_DN + OFF_DNQ); const float* DNS = (const float*)(ws + WS_DN + OFF_DNS);
    LAS float* Kf = (LAS float*)(lds + wave * 16384);
    LAS bf16_t* Wb = (LAS bf16_t*)(Kf + 16 * 132);
    LAS float* Am = (LAS float*)(Wb + 16 * 136);
    LAS float* St = Am + 256;
    LAS float* Tt = St + 272;
    LAS float* be = Tt + 272;
#pragma unroll 1
    for (int task = gw; task < NTASK; task += NGW) {
        const int c = task % NCHUNK, grp = task / NCHUNK, dir = grp & 1, h = (grp >> 1) & 7, b = grp >> 4;
        const int n0 = c * 16, plo = dir ? (n0 < 256 ? 240 - n0 : TPB + 240 - n0) : n0;
        const size_t prow = (size_t)b * TPB + (dir ? plo + 15 - t : plo + t);
        const float* kp = DNK + prow * 512 + (h >> 1) * 128 + 4 * kq; const float* qp = DNQ + prow * 512 + (h >> 1) * 128 + 4 * kq;
        f32x4 ka[4], kb[4], qa[4], qb[4];
#pragma unroll
        for (int j = 0; j < 4; ++j) { ka[j] = *(const f32x4*)(kp + 32 * j); kb[j] = *(const f32x4*)(kp + 32 * j + 16); qa[j] = *(const f32x4*)(qp + 32 * j); qb[j] = *(const f32x4*)(qp + 32 * j + 16); }
        const f32x4 sc = *(const f32x4*)(DNS + (prow * 16 + dir * 8 + h) * 4);
        const float beta = sc[1];
        float gc = sc[3];
        gc += dppf<0x111>(gc); gc += dppf<0x112>(gc); gc += dppf<0x114>(gc); gc += dppf<0x118>(gc);
        const float gC = __shfl(gc, 15);
        const float egc = __expf(gc);
#pragma unroll
        for (int j = 0; j < 4; ++j) { *(LAS f32x4*)(Kf + t * 132 + 32 * j + 4 * kq) = ka[j]; *(LAS f32x4*)(Kf + t * 132 + 32 * j + 16 + 4 * kq) = kb[j]; }
        if (kq == 0) be[t] = beta * egc;
        f32x4 KK = {0.f, 0.f, 0.f, 0.f}, QK = KK;
#pragma unroll
        for (int j = 0; j < 4; ++j) {
            float kv[8] = {ka[j][0], ka[j][1], ka[j][2], ka[j][3], kb[j][0], kb[j][1], kb[j][2], kb[j][3]};
            float qv[8] = {qa[j][0], qa[j][1], qa[j][2], qa[j][3], qb[j][0], qb[j][1], qb[j][2], qb[j][3]};
            u32x4 kh, kl, qh, ql;
#pragma unroll
            for (int e = 0; e < 4; ++e) { const unsigned hh = pk2n(kv[2 * e], kv[2 * e + 1]); kh[e] = hh; kl[e] = pk2n(kv[2 * e] - bflo(hh), kv[2 * e + 1] - bfhi(hh));
                const unsigned gh = pk2n(qv[2 * e], qv[2 * e + 1]); qh[e] = gh; ql[e] = pk2n(qv[2 * e] - bflo(gh), qv[2 * e + 1] - bfhi(gh)); }
            const bf16x8 Kh = __builtin_bit_cast(bf16x8, kh), Kl = __builtin_bit_cast(bf16x8, kl), Qh = __builtin_bit_cast(bf16x8, qh), Ql = __builtin_bit_cast(bf16x8, ql);
            KK = __builtin_amdgcn_mfma_f32_16x16x32_bf16(Kh, Kh, KK, 0, 0, 0); KK = __builtin_amdgcn_mfma_f32_16x16x32_bf16(Kh, Kl, KK, 0, 0, 0); KK = __builtin_amdgcn_mfma_f32_16x16x32_bf16(Kl, Kh, KK, 0, 0, 0);
            QK = __builtin_amdgcn_mfma_f32_16x16x32_bf16(Qh, Kh, QK, 0, 0, 0); QK = __builtin_amdgcn_mfma_f32_16x16x32_bf16(Qh, Kl, QK, 0, 0, 0); QK = __builtin_amdgcn_mfma_f32_16x16x32_bf16(Ql, Kh, QK, 0, 0, 0);
            u32x4 fq; fq[0] = pk2n(qv[0] * egc, qv[1] * egc); fq[1] = pk2n(qv[2] * egc, qv[3] * egc); fq[2] = pk2n(qv[4] * egc, qv[5] * egc); fq[3] = pk2n(qv[6] * egc, qv[7] * egc);
            *(u32x4*)(ws + WS_CP1 + (size_t)task * CP1_STRIDE + 4096 + (size_t)(j * 64 + lane) * 16) = fq;
        }
#pragma unroll
        for (int e = 0; e < 4; ++e) { const int tp = 4 * kq + e; const float gct = __shfl(gc, tp), bt = __shfl(beta, tp);
            const float dec = __expf(fminf(gct - gc, 0.f));
            Am[tp * 16 + t] = (t < tp) ? bt * KK[e] * dec : 0.f;
            St[tp * 17 + t] = (t <= tp) ? QK[e] * dec : 0.f; }
        LDS_WAIT();
        {
            u32x2 fa; fa[0] = pk2n(St[t * 17 + 4 * kq], St[t * 17 + 4 * kq + 1]); fa[1] = pk2n(St[t * 17 + 4 * kq + 2], St[t * 17 + 4 * kq + 3]);
            *(u32x2*)(ws + WS_CP2 + (size_t)task * CP2_STRIDE + (size_t)lane * 8) = fa;
            float ds[4];
#pragma unroll
            for (int e = 0; e < 4; ++e) ds[e] = __expf(gC - __shfl(gc, 4 * kq + e));
#pragma unroll
            for (int m = 0; m < 8; ++m) { u32x2 fk;
                fk[0] = pk2n(Kf[(4 * kq + 0) * 132 + 16 * m + t] * ds[0], Kf[(4 * kq + 1) * 132 + 16 * m + t] * ds[1]);
                fk[1] = pk2n(Kf[(4 * kq + 2) * 132 + 16 * m + t] * ds[2], Kf[(4 * kq + 3) * 132 + 16 * m + t] * ds[3]);
                *(u32x2*)(ws + WS_CPK + (size_t)task * 4096 + (size_t)(m * 64 + lane) * 8) = fk; }
        }
#pragma unroll 1
        for (int pass = 0; pass < 3; ++pass) {
            if (pass < 2 || lane < 16) {
                const int col = (pass & 1) * 64 + lane;
                float x[16];
#pragma unroll
                for (int tt = 0; tt < 16; ++tt) {
                    float acc = (pass < 2) ? be[tt] * Kf[tt * 132 + col] : ((tt == lane) ? 1.f : 0.f);
#pragma unroll
                    for (int s = 0; s < tt; ++s) acc -= Am[tt * 16 + s] * x[s];
                    x[tt] = acc;
                    if (pass < 2) Wb[tt * 136 + col] = (bf16_t)(pk2n(acc, 0.f) & 0xffffu); else Tt[tt * 17 + lane] = acc; }
            }
        }
        LDS_WAIT();
        {
#pragma unroll
            for (int j = 0; j < 4; ++j) { const u32x2 lo = *(const LAS u32x2*)(Wb + t * 136 + 32 * j + 4 * kq), hi = *(const LAS u32x2*)(Wb + t * 136 + 32 * j + 16 + 4 * kq);
                *(u32x4*)(ws + WS_CP1 + (size_t)task * CP1_STRIDE + (size_t)(j * 64 + lane) * 16) = (u32x4){lo[0], lo[1], hi[0], hi[1]}; }
            u32x2 ft; ft[0] = pk2n(Tt[t * 17 + 4 * kq], Tt[t * 17 + 4 * kq + 1]); ft[1] = pk2n(Tt[t * 17 + 4 * kq + 2], Tt[t * 17 + 4 * kq + 3]);
            *(u32x2*)(ws + WS_CP2 + (size_t)task * CP2_STRIDE + 512 + (size_t)lane * 8) = ft;
            float* misc = (float*)(ws + WS_CP2 + (size_t)task * CP2_STRIDE + 1024);
            if (lane < 16) misc[lane] = beta; else if (lane == 16) misc[16] = __expf(gC);
        }
        LDS_WAIT();
    }
}

__device__ __forceinline__ void hgprep_phase(const Params& P, int l, LAS unsigned char* lds) {
    const int tid = otid(), lane = tid & 63, wave = tid >> 6, t = lane & 15, kq = lane >> 4;
    const int gw = blockIdx.x * NWAVES + wave, NGW = gridDim.x * NWAVES;
    unsigned char* ws = P.ws;
    const bf16_t* H = (const bf16_t*)(ws + WS_H);
    LAS float* Kf = (LAS float*)(lds + wave * 16384);
    LAS float* St = Kf + 16 * 132;
#pragma unroll 1
    for (int task = gw; task < NTASK; task += NGW) {
        const int c = task % NCHUNK, grp = task / NCHUNK, dir = grp & 1, h = (grp >> 1) & 7, b = grp >> 4;
        const int n0 = c * 16, plo = dir ? (n0 < 256 ? 240 - n0 : TPB + 240 - n0) : n0;
        const size_t prow = (size_t)b * TPB + (dir ? plo + 15 - t : plo + t);
        const bf16_t* hp = H + prow * NPAD + h * 128 + 4 * kq;
        const float* lbp = (const float*)(ws + WS_LB) + ((size_t)l * 2 + dir) * 1024 + h * 128 + 4 * kq;
        float L[32], kk[32], q[32];
#pragma unroll
        for (int j = 0; j < 4; ++j)
#pragma unroll
            for (int hh = 0; hh < 2; ++hh) { const int ko = 32 * j + 16 * hh;
                const u32x2 fr = *(const u32x2*)(hp + (dir ? C_HGFB : C_HGFF) + ko), qr = *(const u32x2*)(hp + C_HGQ + ko); const f32x4 lb = *(const f32x4*)(lbp + ko);
                const float fx[4] = {bflo(fr[0]), bfhi(fr[0]), bflo(fr[1]), bfhi(fr[1])}, qx[4] = {bflo(qr[0]), bfhi(qr[0]), bflo(qr[1]), bfhi(qr[1])};
#pragma unroll
                for (int e = 0; e < 4; ++e) { const int ix = 8 * j + 4 * hh + e; const float f = lb[e] + (1.f - lb[e]) * sigm(fx[e]);
                    L[ix] = __logf(fmaxf(f, 1e-30f)); kk[ix] = 1.f - f; q[ix] = silu(qx[e]); } }
        float Lt15[32];
#pragma unroll
        for (int ix = 0; ix < 32; ++ix) { float x = L[ix]; Lt15[ix] = row_sum16(x); x += dppf<0x111>(x); x += dppf<0x112>(x); x += dppf<0x114>(x); x += dppf<0x118>(x); L[ix] = x; }
        f32x4 Att = {0.f, 0.f, 0.f, 0.f};
#pragma unroll
        for (int j = 0; j < 4; ++j) {
            u32x4 fqv, qp, kp; float khat[8];
#pragma unroll
            for (int e2 = 0; e2 < 4; ++e2) {
                float qt[2], qq[2], kx[2];
#pragma unroll
                for (int z = 0; z < 2; ++z) { const int ix = 8 * j + 2 * e2 + z; const float Lt = L[ix];
                    const float L15 = Lt15[ix];
                    qt[z] = q[ix] * __expf(Lt);
                    const float d = fminf(Lt - L15, 80.f);
                    qq[z] = q[ix] * __expf(d); kx[z] = kk[ix] * __expf(-d);
                    khat[2 * e2 + z] = kx[z];
                    if (t == 15) ((float*)(ws + WS_HGA + (size_t)task * 1024 + 512))[32 * j + 16 * ((2 * e2 + z) >> 2) + 4 * kq + ((2 * e2 + z) & 3)] = __expf(Lt); }
                fqv[e2] = pk2n(qt[0], qt[1]); qp[e2] = pk2n(qq[0], qq[1]); kp[e2] = pk2n(kx[0], kx[1]); }
            *(u32x4*)(ws + WS_HGQ + (size_t)task * 4096 + (size_t)(j * 64 + lane) * 16) = fqv;
            Att = __builtin_amdgcn_mfma_f32_16x16x32_bf16(__builtin_bit_cast(bf16x8, qp), __builtin_bit_cast(bf16x8, kp), Att, 0, 0, 0);
            *(LAS f32x4*)(Kf + t * 132 + 32 * j + 4 * kq) = (f32x4){khat[0], khat[1], khat[2], khat[3]};
            *(LAS f32x4*)(Kf + t * 132 + 32 * j + 16 + 4 * kq) = (f32x4){khat[4], khat[5], khat[6], khat[7]};
        }
#pragma unroll
        for (int e = 0; e < 4; ++e) { const int tp = 4 * kq + e; St[tp * 17 + t] = (t <= tp) ? Att[e] : 0.f; }
        LDS_WAIT();
        { u32x2 fa; fa[0] = pk2n(St[t * 17 + 4 * kq], St[t * 17 + 4 * kq + 1]); fa[1] = pk2n(St[t * 17 + 4 * kq + 2], St[t * 17 + 4 * kq + 3]);
          *(u32x2*)(ws + WS_HGA + (size_t)task * 1024 + (size_t)lane * 8) = fa;
#pragma unroll
          for (int m = 0; m < 8; ++m) { u32x2 fk;
              fk[0] = pk2n(Kf[(4 * kq + 0) * 132 + 16 * m + t], Kf[(4 * kq + 1) * 132 + 16 * m + t]);
              fk[1] = pk2n(Kf[(4 * kq + 2) * 132 + 16 * m + t], Kf[(4 * kq + 3) * 132 + 16 * m + t]);
              *(u32x2*)(ws + WS_HGK + (size_t)task * 4096 + (size_t)(m * 64 + lane) * 8) = fk; } }
        LDS_WAIT();
    }
}

constexpr int T32_IN = 32 * 545, T32_BR = 16 * 64, T32_OUT = 32 * 64, T32_F1 = 32 * 256, T32_F2 = 128 * 64, T32_PER = T32_IN + 3 * T32_BR + T32_OUT + T32_F1 + T32_F2;
struct TItem { const float* W; bf16_t* WT; int K, N, k0, n0; };
__device__ __forceinline__ TItem titem_decode(const Params& P, int l, int r) {
    unsigned char* ws = P.ws; TItem t; int item;
    if (r < T32_IN) { t.W = P.in[6] + (size_t)l * D * INC; t.K = D; t.N = INC; t.WT = (bf16_t*)(ws + WS_WIN + (size_t)l * SZ_WIN); item = r; }
    else if ((r -= T32_IN) < 3 * T32_BR) { const int g = r / T32_BR; t.W = P.in[23] + (size_t)(l * 3 + g) * 1024 * D; t.K = 1024; t.N = D; t.WT = (bf16_t*)(ws + WS_WBR + (size_t)(l * 3 + g) * SZ_WBR); item = r - g * T32_BR; }
    else if ((r -= 3 * T32_BR) < T32_OUT) { t.W = P.in[24] + (size_t)l * D * D; t.K = D; t.N = D; t.WT = (bf16_t*)(ws + WS_WOUT + (size_t)l * SZ_WOUT); item = r; }
    else if ((r -= T32_OUT) < T32_F1) { t.W = P.in[27] + (size_t)l * D * DFF; t.K = D; t.N = DFF; t.WT = (bf16_t*)(ws + WS_WFF1 + (size_t)l * SZ_WFF); item = r; }
    else { r -= T32_F1; t.W = P.in[28] + (size_t)l * DFF * D; t.K = DFF; t.N = D; t.WT = (bf16_t*)(ws + WS_WFF2 + (size_t)l * SZ_WFF); item = r; }
    const int nblk = t.N / 32, kb = item / nblk, nb = item - kb * nblk; t.k0 = 64 * kb; t.n0 = 32 * nb;
    return t;
}
#define TSTAGE1(wv, ti) do { const TItem t_ = titem_decode(P, DEPTH - 1, (ti)); const float* wp_ = t_.W + (size_t)(t_.k0 + (lane >> 5)) * t_.N + t_.n0 + (lane & 31); \
    _Pragma("unroll") for (int i_ = 0; i_ < 32; ++i_) wv[i_] = __builtin_nontemporal_load(wp_ + (size_t)(2 * i_) * t_.N); } while (0)
#define TSTAGE2(wv, ti, scr) do { const TItem t_ = titem_decode(P, DEPTH - 1, (ti)); \
    _Pragma("unroll") for (int i_ = 0; i_ < 32; ++i_) (scr)[(2 * i_ + (lane >> 5)) * 33 + (lane & 31)] = wv[i_]; \
    LDS_WAIT(); \
    { const int c_ = lane & 7; _Pragma("unroll") for (int j_ = 0; j_ < 4; ++j_) { const int n_ = (lane >> 3) + 8 * j_; const LAS float* s_ = (scr) + (8 * c_) * 33 + n_; \
        u32x4 o_; o_.x = pk2(s_[0 * 33], s_[1 * 33]); o_.y = pk2(s_[2 * 33], s_[3 * 33]); o_.z = pk2(s_[4 * 33], s_[5 * 33]); o_.w = pk2(s_[6 * 33], s_[7 * 33]); \
        *(u32x4*)(t_.WT + (size_t)(t_.n0 + n_) * t_.K + t_.k0 + 8 * c_) = o_; } } \
    LDS_WAIT(); } while (0)

#define SCAN_BAR() do { asm volatile("s_waitcnt lgkmcnt(0)" ::: "memory"); __builtin_amdgcn_s_barrier(); asm volatile("" ::: "memory"); } while (0)
__device__ __forceinline__ void scan_phase(const Params& P, int l, LAS unsigned char* lds) {
    const int tid = otid(), wid = __builtin_amdgcn_readfirstlane(tid >> 6), lane = tid & 63, col = lane & 15, quad = lane >> 4;
    unsigned char* ws = P.ws;
    const bf16_t* H = (const bf16_t*)(ws + WS_H);
    const float* DNV = (const float*)(ws + WS_DN + OFF_DNV);
    constexpr int TS = 16, NT = NCHUNK;
    constexpr int SLOT = 25856, HGO = 15616;
    const f32x4 zero4 = {0.f, 0.f, 0.f, 0.f};
    for (int vb = blockIdx.x; vb < 256; vb += gridDim.x) {
        const int xcd = vb & 7, idx = vb >> 3, grp = xcd * 4 + (idx >> 3), sub = idx & 7;
        const int b = grp >> 4, h = (grp >> 1) & 7, dir = grp & 1, col0 = sub * 16;
        const size_t rowbase = (size_t)b * TPB;
        if (wid == 0) {
            bf16_t* Odn = (bf16_t*)(ws + WS_SO + (size_t)(2 + dir) * SZ_SOB);
            f32x4 St[8];
#pragma unroll
            for (int m = 0; m < 8; ++m) St[m] = zero4;
#pragma unroll 1
            for (int it = -4; it < NT; ++it) {
                if (it >= 0) {
                    const LAS unsigned char* sl = lds + (it & 1) * SLOT;
                    const int n0 = it * TS; const int plo = dir ? (n0 < 256 ? 256 - TS - n0 : TPB + 256 - TS - n0) : n0;
                    u32x4 fw[4], fq[4]; u32x2 fk[8];
#pragma unroll
                    for (int j = 0; j < 4; ++j) { fw[j] = *(const LAS u32x4*)(sl + (j * 64 + lane) * 16); fq[j] = *(const LAS u32x4*)(sl + 4096 + (j * 64 + lane) * 16); }
#pragma unroll
                    for (int m = 0; m < 8; ++m) fk[m] = *(const LAS u32x2*)(sl + 8192 + (m * 64 + lane) * 8);
                    const u32x2 fa = *(const LAS u32x2*)(sl + 12288 + lane * 8), ft = *(const LAS u32x2*)(sl + 12800 + lane * 8);
                    const f32x4 b4 = *(const LAS f32x4*)(sl + 13312 + lane * 16), v4 = *(const LAS f32x4*)(sl + 14336 + lane * 16);
                    const float egC = *(const LAS float*)(sl + 15360);
                    bf16x8 sf[4];
#pragma unroll
                    for (int j = 0; j < 4; ++j) sf[j] = __builtin_bit_cast(bf16x8, (u32x4){pk2n(St[2 * j][0], St[2 * j][1]), pk2n(St[2 * j][2], St[2 * j][3]), pk2n(St[2 * j + 1][0], St[2 * j + 1][1]), pk2n(St[2 * j + 1][2], St[2 * j + 1][3])});
                    const bf16x8 bv = __builtin_bit_cast(bf16x8, (u32x4){pk2n(b4[0] * v4[0], b4[1] * v4[1]), pk2n(b4[2] * v4[2], b4[3] * v4[3]), 0u, 0u});
                    const bf16x8 FT8 = __builtin_bit_cast(bf16x8, (u32x4){ft[0], ft[1], 0u, 0u}), FA8 = __builtin_bit_cast(bf16x8, (u32x4){fa[0], fa[1], 0u, 0u});
                    const f32x4 U = __builtin_amdgcn_mfma_f32_16x16x32_bf16(FT8, bv, zero4, 0, 0, 0);
                    f32x4 Pw = zero4, O = zero4;
#pragma unroll
                    for (int j = 0; j < 4; ++j) { Pw = __builtin_amdgcn_mfma_f32_16x16x32_bf16(__builtin_bit_cast(bf16x8, fw[j]), sf[j], Pw, 0, 0, 0);
                        O = __builtin_amdgcn_mfma_f32_16x16x32_bf16(__builtin_bit_cast(bf16x8, fq[j]), sf[j], O, 0, 0, 0); }
                    const f32x4 Vn = U - Pw;
                    const bf16x8 vn8 = __builtin_bit_cast(bf16x8, (u32x4){pk2n(Vn[0], Vn[1]), pk2n(Vn[2], Vn[3]), 0u, 0u});
                    O = __builtin_amdgcn_mfma_f32_16x16x32_bf16(FA8, vn8, O, 0, 0, 0);
#pragma unroll
                    for (int m = 0; m < 8; ++m) St[m] = __builtin_amdgcn_mfma_f32_16x16x32_bf16(__builtin_bit_cast(bf16x8, (u32x4){fk[m][0], fk[m][1], 0u, 0u}), vn8, St[m] * egC, 0, 0, 0);
#pragma unroll
                    for (int e = 0; e < 4; ++e) { const int t = 4 * quad + e; const int p = dir ? plo + TS - 1 - t : plo + t;
                        Odn[(rowbase + p) * 1024 + h * 128 + col0 + col] = (bf16_t)(pk2n(O[e], 0.f) & 0xffffu); }
                }
                SCAN_BAR();
            }
        } else if (wid == 1) {
            bf16_t* Ohg = (bf16_t*)(ws + WS_SO + (size_t)dir * SZ_SOB);
            f32x4 St[8];
#pragma unroll
            for (int m = 0; m < 8; ++m) St[m] = zero4;
#pragma unroll 1
            for (int it = -4; it < NT; ++it) {
                if (it >= 0) {
                    const LAS unsigned char* sl = lds + (it & 1) * SLOT + HGO;
                    const int n0 = it * TS; const int plo = dir ? (n0 < 256 ? 256 - TS - n0 : TPB + 256 - TS - n0) : n0;
                    u32x4 fq[4]; u32x2 fk[8]; f32x4 p15[8];
#pragma unroll
                    for (int j = 0; j < 4; ++j) fq[j] = *(const LAS u32x4*)(sl + (j * 64 + lane) * 16);
#pragma unroll
                    for (int m = 0; m < 8; ++m) { fk[m] = *(const LAS u32x2*)(sl + 4096 + (m * 64 + lane) * 8); p15[m] = *(const LAS f32x4*)(sl + 8704 + (16 * m + 4 * quad) * 4); }
                    const u32x2 fa = *(const LAS u32x2*)(sl + 8192 + lane * 8); const f32x4 v4 = *(const LAS f32x4*)(sl + 9216 + lane * 16);
                    bf16x8 sf[4];
#pragma unroll
                    for (int j = 0; j < 4; ++j) sf[j] = __builtin_bit_cast(bf16x8, (u32x4){pk2n(St[2 * j][0], St[2 * j][1]), pk2n(St[2 * j][2], St[2 * j][3]), pk2n(St[2 * j + 1][0], St[2 * j + 1][1]), pk2n(St[2 * j + 1][2], St[2 * j + 1][3])});
                    const bf16x8 bv = __builtin_bit_cast(bf16x8, (u32x4){pk2n(v4[0], v4[1]), pk2n(v4[2], v4[3]), 0u, 0u});
                    const bf16x8 FA8 = __builtin_bit_cast(bf16x8, (u32x4){fa[0], fa[1], 0u, 0u});
                    f32x4 O = __builtin_amdgcn_mfma_f32_16x16x32_bf16(FA8, bv, zero4, 0, 0, 0);
#pragma unroll
                    for (int j = 0; j < 4; ++j) O = __builtin_amdgcn_mfma_f32_16x16x32_bf16(__builtin_bit_cast(bf16x8, fq[j]), sf[j], O, 0, 0, 0);
#pragma unroll
                    for (int m = 0; m < 8; ++m) St[m] = __builtin_amdgcn_mfma_f32_16x16x32_bf16(__builtin_bit_cast(bf16x8, (u32x4){fk[m][0], fk[m][1], 0u, 0u}), bv, St[m] * p15[m], 0, 0, 0);
#pragma unroll
                    for (int e = 0; e < 4; ++e) { const int t = 4 * quad + e; const int p = dir ? plo + TS - 1 - t : plo + t;
                        Ohg[(rowbase + p) * 1024 + h * 128 + col0 + col] = (bf16_t)(pk2n(O[e], 0.f) & 0xffffu); }
                }
                SCAN_BAR();
            }
        } else if (wid < 5) {
            const int k = wid - 2;
            u32x4 fw[4], fq[4]; u32x2 fk[8], fa, ft; f32x4 b4, v4; float egC = 0.f;
#pragma unroll
            for (int j = 0; j < 4; ++j) { fw[j] = (u32x4){0u, 0u, 0u, 0u}; fq[j] = fw[j]; }
#pragma unroll
            for (int m = 0; m < 8; ++m) fk[m] = (u32x2){0u, 0u};
            fa = (u32x2){0u, 0u}; ft = fa; b4 = zero4; v4 = zero4;
            float twv[32]; int tn = 0; bool thave = false; const int tlw = blockIdx.x * 6 + (wid - 2), TNLW = gridDim.x * 6; LAS float* tscr = (LAS float*)(lds + 2 * SLOT + (wid - 2) * 8448);
#pragma unroll
            for (int i_ = 0; i_ < 32; ++i_) twv[i_] = 0.f;
#pragma unroll 1
            for (int it = -4; it < NT; ++it) {
                if ((it + 4) % 3 == k) {
                    const int jw = it + 1, jl = it + 4;
                    if (jw >= 0 && jw < NT) {
                        LAS unsigned char* sl = lds + (jw & 1) * SLOT;
#pragma unroll
                        for (int j = 0; j < 4; ++j) { *(LAS u32x4*)(sl + (j * 64 + lane) * 16) = fw[j]; *(LAS u32x4*)(sl + 4096 + (j * 64 + lane) * 16) = fq[j]; }
#pragma unroll
                        for (int m = 0; m < 8; ++m) *(LAS u32x2*)(sl + 8192 + (m * 64 + lane) * 8) = fk[m];
                        *(LAS u32x2*)(sl + 12288 + lane * 8) = fa; *(LAS u32x2*)(sl + 12800 + lane * 8) = ft;
                        *(LAS f32x4*)(sl + 13312 + lane * 16) = b4; *(LAS f32x4*)(sl + 14336 + lane * 16) = v4;
                        if (lane == 0) *(LAS float*)(sl + 15360) = egC;
                    }
                    if (jl < NT) {
                        const int n0 = jl * TS; const int plo = dir ? (n0 < 256 ? 256 - TS - n0 : TPB + 256 - TS - n0) : n0;
                        const size_t task = (size_t)grp * NCHUNK + jl;
                        const unsigned char* c1 = ws + WS_CP1 + task * CP1_STRIDE; const unsigned char* ck = ws + WS_CPK + task * 4096; const unsigned char* c2 = ws + WS_CP2 + task * CP2_STRIDE;
#pragma unroll
                        for (int j = 0; j < 4; ++j) { fw[j] = *(const u32x4*)(c1 + (size_t)(j * 64 + lane) * 16); fq[j] = *(const u32x4*)(c1 + 4096 + (size_t)(j * 64 + lane) * 16); }
#pragma unroll
                        for (int m = 0; m < 8; ++m) fk[m] = *(const u32x2*)(ck + (size_t)(m * 64 + lane) * 8);
                        fa = *(const u32x2*)(c2 + (size_t)lane * 8); ft = *(const u32x2*)(c2 + 512 + (size_t)lane * 8);
                        b4 = *(const f32x4*)(c2 + 1024 + quad * 16); egC = *(const float*)(c2 + 1024 + 64);
#pragma unroll
                        for (int e = 0; e < 4; ++e) { const int s = 4 * quad + e; const int p = dir ? plo + TS - 1 - s : plo + s;
                            v4[e] = DNV[(rowbase + p) * 1024 + h * 128 + col0 + col]; }
                    }
                }
                if (l == 0) {
                    const int ti = tlw + TNLW * tn;
                    if (ti < T32_PER) {
                        if ((it + 4) % 3 == (k + 1) % 3) { TSTAGE1(twv, ti); thave = true; }
                        else if ((it + 4) % 3 == (k + 2) % 3 && thave) { TSTAGE2(twv, ti, tscr); ++tn; thave = false; }
                    }
                }
                SCAN_BAR();
            }
        } else {
            const int k = wid - 5;
            u32x4 fq[4]; u32x2 fk[8], fa; f32x4 p15 = zero4; bf16_t vr[4] = {0, 0, 0, 0};
#pragma unroll
            for (int j = 0; j < 4; ++j) fq[j] = (u32x4){0u, 0u, 0u, 0u};
#pragma unroll
            for (int m = 0; m < 8; ++m) fk[m] = (u32x2){0u, 0u};
            fa = (u32x2){0u, 0u};
            float twv[32]; int tn = 0; bool thave = false; const int tlw = blockIdx.x * 6 + (wid - 2), TNLW = gridDim.x * 6; LAS float* tscr = (LAS float*)(lds + 2 * SLOT + (wid - 2) * 8448);
#pragma unroll
            for (int i_ = 0; i_ < 32; ++i_) twv[i_] = 0.f;
#pragma unroll 1
            for (int it = -4; it < NT; ++it) {
                if ((it + 4) % 3 == k) {
                    const int jw = it + 1, jl = it + 4;
                    if (jw >= 0 && jw < NT) {
                        LAS unsigned char* sl = lds + (jw & 1) * SLOT + HGO;
#pragma unroll
                        for (int j = 0; j < 4; ++j) *(LAS u32x4*)(sl + (j * 64 + lane) * 16) = fq[j];
#pragma unroll
                        for (int m = 0; m < 8; ++m) *(LAS u32x2*)(sl + 4096 + (m * 64 + lane) * 8) = fk[m];
                        *(LAS u32x2*)(sl + 8192 + lane * 8) = fa;
                        if (lane < 32) *(LAS f32x4*)(sl + 8704 + lane * 16) = p15;
                        *(LAS f32x4*)(sl + 9216 + lane * 16) = (f32x4){bf1(vr[0]), bf1(vr[1]), bf1(vr[2]), bf1(vr[3])};
                    }
                    if (jl < NT) {
                        const int n0 = jl * TS; const int plo = dir ? (n0 < 256 ? 256 - TS - n0 : TPB + 256 - TS - n0) : n0;
                        const size_t task = (size_t)grp * NCHUNK + jl;
                        const unsigned char* cq = ws + WS_HGQ + task * 4096; const unsigned char* ck = ws + WS_HGK + task * 4096; const unsigned char* ca = ws + WS_HGA + task * 1024;
#pragma unroll
                        for (int j = 0; j < 4; ++j) fq[j] = *(const u32x4*)(cq + (size_t)(j * 64 + lane) * 16);
#pragma unroll
                        for (int m = 0; m < 8; ++m) fk[m] = *(const u32x2*)(ck + (size_t)(m * 64 + lane) * 8);
                        fa = *(const u32x2*)(ca + (size_t)lane * 8);
                        if (lane < 32) p15 = *(const f32x4*)(ca + 512 + (size_t)lane * 16);
#pragma unroll
                        for (int e = 0; e < 4; ++e) { const int s = 4 * quad + e; const int p = dir ? plo + TS - 1 - s : plo + s;
                            vr[e] = H[(rowbase + p) * NPAD + C_HGI + h * 128 + col0 + col]; }
                    }
                }
                if (l == 0) {
                    const int ti = tlw + TNLW * tn;
                    if (ti < T32_PER) {
                        if ((it + 4) % 3 == (k + 1) % 3) { TSTAGE1(twv, ti); thave = true; }
                        else if ((it + 4) % 3 == (k + 2) % 3 && thave) { TSTAGE2(twv, ti, tscr); ++tn; thave = false; }
                    }
                }
                SCAN_BAR();
            }
        }
    }
}

__device__ __forceinline__ f32x2 cmul(f32x2 a, f32x2 b) { return (f32x2){a.x * b.x - a.y * b.y, a.x * b.y + a.y * b.x}; }
__device__ __forceinline__ f32x2 cmulc(f32x2 a, f32x2 b) { return (f32x2){a.x * b.x + a.y * b.y, a.y * b.x - a.x * b.y}; }
#define PADI(i) ((i) + (((i) >> 5) << 1))
constexpr int FFT_PADN = 8192 + 512;
template <bool INV, int ST> __device__ __forceinline__ void fft_pass16(LAS f32x2* buf, int base, int bl) {
    constexpr float C16[8] = {1.f, 0.92387953251f, 0.70710678119f, 0.38268343237f, 0.f, -0.38268343237f, -0.70710678119f, -0.92387953251f};
    constexpr float S16[8] = {0.f, 0.38268343237f, 0.70710678119f, 0.92387953251f, 1.f, 0.92387953251f, 0.70710678119f, 0.38268343237f};
    f32x2 x[16];
    constexpr int STEP = (1 << ST) + ((1 << ST) >> 4);
    LAS f32x2* pb = buf + PADI(base);
#pragma unroll
    for (int d = 0; d < 16; ++d) x[d] = pb[d * STEP];
    const float th = (float)bl * (1.f / (float)(16 << ST));
    const f32x2 W1 = {__builtin_amdgcn_cosf(th), -__builtin_amdgcn_sinf(th)};
    const f32x2 W2 = cmul(W1, W1), W4 = cmul(W2, W2), W8 = cmul(W4, W4);
    if (!INV) {
#pragma unroll
        for (int d = 0; d < 8; ++d) { const f32x2 w = cmul(W1, (f32x2){C16[d], -S16[d]}); const f32x2 a = x[d], b = x[d + 8]; x[d] = a + b; x[d + 8] = cmul(a - b, w); }
#pragma unroll
        for (int g = 0; g < 16; g += 8)
#pragma unroll
            for (int dd = 0; dd < 4; ++dd) { const int d = g + dd; const f32x2 w = cmul(W2, (f32x2){C16[2 * dd], -S16[2 * dd]}); const f32x2 a = x[d], b = x[d + 4]; x[d] = a + b; x[d + 4] = cmul(a - b, w); }
#pragma unroll
        for (int g = 0; g < 16; g += 4)
#pragma unroll
            for (int dd = 0; dd < 2; ++dd) { const int d = g + dd; const f32x2 w = dd ? (f32x2){W4.y, -W4.x} : W4; const f32x2 a = x[d], b = x[d + 2]; x[d] = a + b; x[d + 2] = cmul(a - b, w); }
#pragma unroll
        for (int g = 0; g < 16; g += 2) { const f32x2 a = x[g], b = x[g + 1]; x[g] = a + b; x[g + 1] = cmul(a - b, W8); }
    } else {
#pragma unroll
        for (int g = 0; g < 16; g += 2) { const f32x2 a = x[g], b = cmulc(x[g + 1], W8); x[g] = a + b; x[g + 1] = a - b; }
#pragma unroll
        for (int g = 0; g < 16; g += 4)
#pragma unroll
            for (int dd = 0; dd < 2; ++dd) { const int d = g + dd; const f32x2 w = dd ? (f32x2){W4.y, -W4.x} : W4; const f32x2 a = x[d], b = cmulc(x[d + 2], w); x[d] = a + b; x[d + 2] = a - b; }
#pragma unroll
        for (int g = 0; g < 16; g += 8)
#pragma unroll
            for (int dd = 0; dd < 4; ++dd) { const int d = g + dd; const f32x2 w = cmul(W2, (f32x2){C16[2 * dd], -S16[2 * dd]}); const f32x2 a = x[d], b = cmulc(x[d + 4], w); x[d] = a + b; x[d + 4] = a - b; }
#pragma unroll
        for (int d = 0; d < 8; ++d) { const f32x2 w = cmul(W1, (f32x2){C16[d], -S16[d]}); const f32x2 a = x[d], b = cmulc(x[d + 8], w); x[d] = a + b; x[d + 8] = a - b; }
    }
#pragma unroll
    for (int d = 0; d < 16; ++d) pb[d * STEP] = x[d];
}
__device__ __forceinline__ void fft_fwd_abc(LAS f32x2* buf, int tid) {
    asm volatile("" : "+v"(tid));
    fft_pass16<false, 9>(buf, tid, tid); __syncthreads();
    fft_pass16<false, 5>(buf, ((tid >> 5) << 9) + (tid & 31), tid & 31); __syncthreads();
    fft_pass16<false, 1>(buf, ((tid >> 1) << 5) + (tid & 1), tid & 1); __syncthreads();
}
__device__ __forceinline__ void fft_inv_cba(LAS f32x2* buf, int tid) {
    asm volatile("" : "+v"(tid));
    fft_pass16<true, 1>(buf, ((tid >> 1) << 5) + (tid & 1), tid & 1); __syncthreads();
    fft_pass16<true, 5>(buf, ((tid >> 5) << 9) + (tid & 31), tid & 31); __syncthreads();
    fft_pass16<true, 9>(buf, tid, tid); __syncthreads();
}
__device__ __forceinline__ float hy_delta(int c) {
    const float a = -3.0701134573253944f, bq = -15.350567286626972f;
    return fabsf(a + (float)c * ((bq - a) / 1023.f));
}
__device__ __forceinline__ void hyena_phase(const Params& P, int l, LAS unsigned char* lds) {
    const int G = gridDim.x;
    unsigned char* ws = P.ws;
    const unsigned* ZT = (const unsigned*)(ws + WS_ZT);
    const float* HID = (const float*)(ws + WS_HID + (size_t)l * SZ_HID1);
    const float* w3 = P.in[13] + (size_t)l * 64 * 4096;
    const int nitems = 1024 + (l == 0 ? 128 : 0);
#pragma unroll 1
    for (int item = blockIdx.x; item < nitems; item += G) {
        const int tid = otid();
        if (item < 1024) {
            const int c = item;
            LAS f32x2* bufA = (LAS f32x2*)lds; LAS f32x2* bufB = bufA + FFT_PADN; LAS f32x4* w3s = (LAS f32x4*)(lds + 2 * FFT_PADN * 8);
            if (tid < 256) ((LAS float*)w3s)[tid] = w3[(size_t)(tid >> 2) * 4096 + ((tid >> 1) & 1) * 2048 + (tid & 1) * 1024 + c];
            __syncthreads();
            const float dl = hy_delta(c);
            {
                f32x4 hacc[8];
#pragma unroll
                for (int e = 0; e < 8; ++e) hacc[e] = (f32x4){0.f, 0.f, 0.f, 0.f};
#pragma unroll 16
                for (int j = 0; j < 64; ++j) { const f32x4 w = w3s[j]; const f32x4 h0 = *(const f32x4*)(HID + (size_t)j * 4096 + 4 * tid), h1 = *(const f32x4*)(HID + (size_t)j * 4096 + 2048 + 4 * tid);
#pragma unroll
                    for (int e = 0; e < 4; ++e) { hacc[e] += h0[e] * w; hacc[4 + e] += h1[e] * w; } }
#pragma unroll
                for (int e = 0; e < 8; ++e) { const int t = 4 * tid + (e & 3) + (e >> 2) * 2048; const float win = __expf(-((float)t * (1.f / 4095.f)) * dl);
                    bufB[PADI(4 * tid) + (e & 3) + (e >> 2) * 2176] = (f32x2){win * hacc[e][0], win * hacc[e][2]};
                    if (t >= 1) bufB[PADI(8192 - t)] = (f32x2){win * hacc[e][1], win * hacc[e][3]}; else bufB[PADI(4096)] = (f32x2){0.f, 0.f}; }
            }
            __syncthreads();
            fft_fwd_abc(bufB, tid);
#pragma unroll
            for (int u = 0; u < 8; ++u) { LAS f32x4* pp = (LAS f32x4*)(bufB + PADI(2 * tid) + 1088 * u); const f32x4 v = *pp;
                *pp = (f32x4){v[0] + v[2], v[1] + v[3], v[0] - v[2], v[1] - v[3]}; }
            f32x2 vv[8], y1[8];
#pragma unroll
            for (int u = 0; u < 8; ++u) { const int t = tid + 512 * u; { const unsigned w_ = ZT[(size_t)c * 4096 + t]; vv[u] = (f32x2){bflo(w_), bfhi(w_)}; } bufA[PADI(tid) + 544 * u] = vv[u]; bufA[PADI(tid) + 544 * u + 4352] = (f32x2){0.f, 0.f}; }
            __syncthreads();
#pragma unroll
            for (int ord = 0; ord < 2; ++ord) {
                fft_fwd_abc(bufA, tid);
#pragma unroll 2
                for (int u = 0; u < 8; ++u) { const int i0 = 2 * (tid + 512 * u); LAS f32x4* pp = (LAS f32x4*)(bufA + PADI(2 * tid) + 1088 * u); const f32x4 v = *pp;
                    f32x2 xs[2] = {(f32x2){v[0] + v[2], v[1] + v[3]}, (f32x2){v[0] - v[2], v[1] - v[3]}};
                    const f32x4 zz = *(const LAS f32x4*)(bufB + PADI(2 * tid) + 1088 * u);
#pragma unroll
                    for (int q = 0; q < 2; ++q) { const unsigned f = __brev((unsigned)(i0 + q)) >> 19, fp = (8192u - f) & 8191u, ip = __brev(fp) >> 19;
                        const f32x2 Z = q ? (f32x2){zz[2], zz[3]} : (f32x2){zz[0], zz[1]}; const f32x2 Zp = bufB[PADI((int)ip)]; f32x2 Kf;
                        if (ord == 0) Kf = (f32x2){Z.x + Zp.x, Z.y - Zp.y}; else Kf = (f32x2){Z.y + Zp.y, Zp.x - Z.x};
                        Kf *= (0.5f / 8192.f);
                        xs[q] = cmul(xs[q], Kf); }
                    *pp = (f32x4){xs[0].x + xs[1].x, xs[0].y + xs[1].y, xs[0].x - xs[1].x, xs[0].y - xs[1].y}; }
                __syncthreads();
                fft_inv_cba(bufA, tid);
                const float skip = P.in[14][(size_t)(l * 2 + ord) * 1024 + c];
#pragma unroll
                for (int u = 0; u < 8; ++u) { const int t = tid + 512 * u; const f32x2 cv = bufA[PADI(tid) + 544 * u]; const unsigned gw_ = ZT[(size_t)((ord + 1) * 1024 + c) * 4096 + t]; const f32x2 gt = {bflo(gw_), bfhi(gw_)};
                    if (ord == 0) { y1[u] = gt * (cv + skip * vv[u]); bufA[PADI(tid) + 544 * u] = y1[u]; bufA[PADI(tid) + 544 * u + 4352] = (f32x2){0.f, 0.f}; }
                    else { const f32x2 yo = gt * (cv + skip * y1[u]); ((unsigned*)(ws + WS_ZY))[(size_t)c * 4096 + t] = pk2(yo.x, yo.y); } }
                __syncthreads();
            }
        } else {
            const int it = item - 1024, bb = it >> 6, cg = it & 63, ch = tid & 15, tg = tid >> 4, c = cg * 16 + ch;
            LAS float* filt = (LAS float*)lds;
            LAS float* vbuf = filt + 511 * 16;
            LAS float* ybuf = vbuf + 256 * 16;
            const float* ZC = (const float*)(ws + WS_ZC) + (size_t)bb * 256 * 3072;
            const float* HC = HID + 64 * 4096;
            bf16_t* HYC = (bf16_t*)(ws + WS_HYC);
            const float dl = hy_delta(c);
            for (int i = tid; i < 256 * 16; i += NTHR) vbuf[i] = ZC[(size_t)(i >> 4) * 3072 + cg * 16 + (i & 15)];
#pragma unroll 1
            for (int ord = 0; ord < 2; ++ord) {
                {
                    const float* wpf = w3 + ord * 2048 + c; const float* wpb = wpf + 1024;
                    f32x4 af0 = {0.f, 0.f, 0.f, 0.f}, af1 = af0, ab0 = af0, ab1 = af0;
#pragma unroll 4
                    for (int j = 0; j < 64; ++j) { const float wf = wpf[(size_t)j * 4096], wb = wpb[(size_t)j * 4096];
                        const f32x4 h0 = *(const f32x4*)(HC + j * 256 + tg * 8), h1 = *(const f32x4*)(HC + j * 256 + tg * 8 + 4);
                        af0 += h0 * wf; af1 += h1 * wf; ab0 += h0 * wb; ab1 += h1 * wb; }
#pragma unroll
                    for (int e = 0; e < 8; ++e) { const int tau = tg * 8 + e; const float win = __expf(-((float)tau * (1.f / 255.f)) * dl);
                        filt[(255 + tau) * 16 + ch] = win * (e < 4 ? af0[e & 3] : af1[e & 3]);
                        if (tau >= 1) filt[(255 - tau) * 16 + ch] = win * (e < 4 ? ab0[e & 3] : ab1[e & 3]); }
                }
                __syncthreads();
                const int tq = tg >> 1;
                (void)tq;
                float acc[8];
#pragma unroll
                for (int i = 0; i < 8; ++i) acc[i] = 0.f;
                const LAS float* src = ord ? ybuf : vbuf;
                for (int s = 0; s < 256; ++s) { const float vs = src[s * 16 + ch];
#pragma unroll
                    for (int i = 0; i < 8; ++i) acc[i] += filt[(tg * 8 + i - s + 255) * 16 + ch] * vs; }
                const float skip = P.in[14][(size_t)ord * 1024 + c];
                float res[8];
#pragma unroll
                for (int i = 0; i < 8; ++i) { const int t = tg * 8 + i; res[i] = ZC[(size_t)t * 3072 + (ord + 1) * 1024 + c] * (acc[i] + skip * src[t * 16 + ch]); }
                __syncthreads();
#pragma unroll
                for (int i = 0; i < 8; ++i) { const int t = tg * 8 + i;
                    if (ord == 0) ybuf[t * 16 + ch] = res[i];
                    else HYC[((size_t)bb * 256 + t) * 1024 + c] = (bf16_t)(pk2(res[i], 0.f) & 0xffffu); }
                __syncthreads();
            }
        }
    }
}

__device__ __forceinline__ void assemble_phase(const Params& P, int l, LAS unsigned char* lds) {
    const int tid = otid(), lane = tid & 63, wave = tid >> 6, G = gridDim.x;
    const int gw = blockIdx.x * NWAVES + wave, NGW = G * NWAVES;
    unsigned char* ws = P.ws;
    const bf16_t* H = (const bf16_t*)(ws + WS_H); bf16_t* BR = (bf16_t*)(ws + WS_DN);
    {
        LAS float* L = (LAS float*)lds;
        const unsigned* ZT = (const unsigned*)(ws + WS_ZY);
#define ASY_LOAD(rv_, item_) do { const int ti_ = (item_) >> 4, ct_ = (item_) & 15, tt_ = tid & 63; \
            _Pragma("unroll") for (int u = 0; u < 8; ++u) { const int cc = (tid >> 6) + 8 * u; rv_[u] = ZT[(size_t)(ct_ * 64 + cc) * 4096 + ti_ * 64 + tt_]; } } while (0)
        unsigned crv[8];
#pragma unroll
        for (int u = 0; u < 8; ++u) crv[u] = 0u;
        if ((int)blockIdx.x < 64 * 16) ASY_LOAD(crv, blockIdx.x);
#pragma unroll 1
        for (int item = blockIdx.x; item < 64 * 16; item += G) {
            const int ti = item >> 4, ct = item & 15;
            unsigned nrv[8];
#pragma unroll
            for (int u = 0; u < 8; ++u) nrv[u] = 0u;
            if (item + G < 64 * 16) ASY_LOAD(nrv, item + G);
            { const int tt = tid & 63;
#pragma unroll
              for (int u = 0; u < 8; ++u) { const int cc = (tid >> 6) + 8 * u; const unsigned v = crv[u];
                L[(0 * 64 + tt) * 65 + cc] = bflo(v); L[(1 * 64 + tt) * 65 + cc] = bfhi(v); } }
            asm volatile("s_waitcnt lgkmcnt(0)" ::: "memory"); __builtin_amdgcn_s_barrier(); asm volatile("" ::: "memory");
#pragma unroll
            for (int u = 0; u < 2; ++u) { const int task = tid + 512 * u, rowi = task >> 3, bb = rowi >> 6, tt = rowi & 63, ch8 = task & 7;
                const LAS float* lp = L + (bb * 64 + tt) * 65 + ch8 * 8;
                u32x4 o; o.x = pk2(lp[0], lp[1]); o.y = pk2(lp[2], lp[3]); o.z = pk2(lp[4], lp[5]); o.w = pk2(lp[6], lp[7]);
                *(u32x4*)(BR + ((size_t)bb * TPB + CTX + ti * 64 + tt) * 3072 + ct * 64 + ch8 * 8) = o; }
            asm volatile("s_waitcnt lgkmcnt(0)" ::: "memory"); __builtin_amdgcn_s_barrier(); asm volatile("" ::: "memory");
#pragma unroll
            for (int u = 0; u < 8; ++u) crv[u] = nrv[u];
        }
#undef ASY_LOAD
    }
    if (l == 0) {
        const u32x4* HYC = (const u32x4*)(ws + WS_HYC);
        for (int i = blockIdx.x * NTHR + tid; i < 512 * 128; i += G * NTHR) { const int r = i >> 7, c8 = i & 127;
            *(u32x4*)(BR + ((size_t)(r >> 8) * TPB + (r & 255)) * 3072 + c8 * 8) = HYC[i]; }
    }
    {
        const bf16_t* SOb = (const bf16_t*)(ws + WS_SO);
        const bool skipc = (l == DEPTH - 1);
        int r = gw;
        while (r < M && skipc && (r % TPB) < CTX) r += NGW;
        float nwr[2][8];
#pragma unroll
        for (int mix = 0; mix < 2; ++mix)
#pragma unroll
            for (int e = 0; e < 8; ++e) nwr[mix][e] = P.in[mix ? 22 : 16][l * 128 + (lane & 15) * 8 + e];
        u32x4 cs[2][2][2], cg[2][2];
#define ASM_LOAD(so, gg, row) do { _Pragma("unroll") for (int mix = 0; mix < 2; ++mix) _Pragma("unroll") for (int half = 0; half < 2; ++half) { const int ch = half * 512 + lane * 8; \
            so[mix][half][0] = *(const u32x4*)(SOb + (size_t)(mix * 2) * (SZ_SOB / 2) + (size_t)(row) * 1024 + ch); \
            so[mix][half][1] = *(const u32x4*)(SOb + (size_t)(mix * 2 + 1) * (SZ_SOB / 2) + (size_t)(row) * 1024 + ch); \
            gg[mix][half] = *(const u32x4*)(H + (size_t)(row) * NPAD + (mix ? C_DNZ : C_HGG) + ch); } } while (0)
#pragma unroll
        for (int mix = 0; mix < 2; ++mix)
#pragma unroll
            for (int half = 0; half < 2; ++half) { cs[mix][half][0] = (u32x4){0u, 0u, 0u, 0u}; cs[mix][half][1] = cs[mix][half][0]; cg[mix][half] = cs[mix][half][0]; }
        if (r < M) ASM_LOAD(cs, cg, r);
#pragma unroll 1
        while (r < M) {
            int rn = r + NGW;
            while (rn < M && skipc && (rn % TPB) < CTX) rn += NGW;
            u32x4 ns[2][2][2], ng[2][2];
#pragma unroll
            for (int mix = 0; mix < 2; ++mix)
#pragma unroll
                for (int half = 0; half < 2; ++half) { ns[mix][half][0] = (u32x4){0u, 0u, 0u, 0u}; ns[mix][half][1] = ns[mix][half][0]; ng[mix][half] = ns[mix][half][0]; }
            if (rn < M) ASM_LOAD(ns, ng, rn);
#pragma unroll
            for (int mix = 0; mix < 2; ++mix) {
#pragma unroll
                for (int half = 0; half < 2; ++half) {
                    const int ch = half * 512 + lane * 8;
                    float o[8], o2[8]; unpack8(cs[mix][half][0], o); unpack8(cs[mix][half][1], o2);
#pragma unroll
                    for (int e = 0; e < 8; ++e) o[e] += o2[e];
                    float ss = 0.f;
#pragma unroll
                    for (int e = 0; e < 8; ++e) ss += o[e] * o[e];
                    ss = row_sum16(ss);
                    const float rs = __builtin_amdgcn_rsqf(ss * (1.f / 128.f) + 1e-6f);
                    float gt[8]; unpack8(cg[mix][half], gt);
                    float res[8];
#pragma unroll
                    for (int e = 0; e < 8; ++e) res[e] = o[e] * rs * nwr[mix][e] * (mix ? silu(gt[e]) : sigm(gt[e]));
                    u32x4 ov; ov.x = pk2(res[0], res[1]); ov.y = pk2(res[2], res[3]); ov.z = pk2(res[4], res[5]); ov.w = pk2(res[6], res[7]);
                    *(u32x4*)(BR + (size_t)r * 3072 + (mix ? 2048 : 1024) + ch) = ov;
                }
            }
#pragma unroll
            for (int mix = 0; mix < 2; ++mix)
#pragma unroll
                for (int half = 0; half < 2; ++half) { cs[mix][half][0] = ns[mix][half][0]; cs[mix][half][1] = ns[mix][half][1]; cg[mix][half] = ng[mix][half]; }
            r = rn;
        }
#undef ASM_LOAD
    }
}

__device__ __forceinline__ void ctx_sb_from_sctx(const Params& P) {
    const float* SC = (const float*)(P.ws + WS_SCTX); bf16_t* SB = (bf16_t*)(P.ws + WS_U);
    for (int i = blockIdx.x * NTHR + threadIdx.x; i < 512 * D / 4; i += gridDim.x * NTHR) {
        const int r = i / (D / 4), c4 = i - r * (D / 4); f32x4 v = *(const f32x4*)(SC + (size_t)i * 4);
#pragma unroll
        for (int s = 1; s < 12; ++s) v += *(const f32x4*)(SC + (size_t)s * 512 * D + (size_t)i * 4);
        u32x2 o; o.x = pk2(v[0], v[1]); o.y = pk2(v[2], v[3]);
        *(u32x2*)(SB + ((size_t)(r >> 8) * TPB + (r & 255)) * D + c4 * 4) = o; }
}
__device__ __forceinline__ void gbar_impl(unsigned* bar, unsigned& gen, unsigned nloc, unsigned nx) {
    asm volatile("s_waitcnt vmcnt(0)" ::: "memory");
    __syncthreads();
    gen += 1u;
    if (threadIdx.x == 0) {
        __builtin_amdgcn_s_waitcnt(0);
        const unsigned x = xcc_id();
        const unsigned old = __hip_atomic_fetch_add(bar + XB_SUB(x), 1u, __ATOMIC_RELAXED, __HIP_MEMORY_SCOPE_AGENT);
        if (old + 1u == gen * nloc) {
            __builtin_amdgcn_fence(__ATOMIC_RELEASE, "agent");
            asm volatile("s_waitcnt vmcnt(0)" ::: "memory");
            const unsigned og = __hip_atomic_fetch_add(bar + XB_TOP, 1u, __ATOMIC_RELAXED, __HIP_MEMORY_SCOPE_AGENT);
            if (og + 1u == gen * nx) (void)__hip_atomic_fetch_add(bar + XB_GEN, 1u, __ATOMIC_RELAXED, __HIP_MEMORY_SCOPE_AGENT);
        }
        unsigned sp = 0u;
        while (__hip_atomic_load(bar + XB_GEN, __ATOMIC_RELAXED, __HIP_MEMORY_SCOPE_AGENT) < gen) { __builtin_amdgcn_s_sleep(1); if (++sp > (1u << 22)) break; }
        __builtin_amdgcn_fence(__ATOMIC_ACQUIRE, "agent");
        asm volatile("s_waitcnt vmcnt(0)" ::: "memory");
    }
    __syncthreads();
}
#define gbar(bar, gen, G) gbar_impl(bar, gen, bar_nloc, bar_nx)
#ifndef REPM
#define REPM 0
#endif
#define REP(bit) for (int _rp = 0; _rp < (((REPM) >> (bit)) & 1) + 1; ++_rp)
__global__ void __launch_bounds__(NTHR, 2) mega(Params P) {
    extern __shared__ __attribute__((aligned(16))) unsigned char smem[];
    LAS unsigned char* lds = (LAS unsigned char*)smem;
    cg::grid_group grid = cg::this_grid();
    unsigned char* ws = P.ws;
    const int G = gridDim.x, cidx = blockIdx.x;
    unsigned* bar = (unsigned*)(ws + WS_BAR); unsigned bgen = 0u;

    REP(0) { phase0(P, lds);
    grid.sync(); }
    unsigned bar_nloc, bar_nx;
    { unsigned nl = __hip_atomic_load(bar + XB_CNT(xcc_id()), __ATOMIC_RELAXED, __HIP_MEMORY_SCOPE_AGENT), nxx = 0u;
#pragma unroll
      for (int j = 0; j < 16; ++j) nxx += (__hip_atomic_load(bar + XB_CNT(j), __ATOMIC_RELAXED, __HIP_MEMORY_SCOPE_AGENT) != 0u) ? 1u : 0u;
      bar_nloc = (unsigned)__builtin_amdgcn_readfirstlane((int)(nl ? nl : 1u)); bar_nx = (unsigned)__builtin_amdgcn_readfirstlane((int)(nxx ? nxx : 1u)); }
    init_rows(P);
    gbar(bar, bgen, (unsigned)G);

#pragma unroll 1
    for (int l = 0; l < DEPTH; ++l) {
        const float* modl = (const float*)(ws + WS_MOD) + (size_t)l * 3 * 6 * D;
        { pg8::Order S{(const bf16_t*)(ws + WS_U), (const bf16_t*)(ws + WS_WIN + (size_t)l * SZ_WIN), D, D, l ? 32 : M / 256, NPAD / 256, G, cidx, 1, 0, 0, D, l ? 1 : 0, l ? 19 : 0, 0};
          pg8::EpiBf16<0> E{(bf16_t*)(ws + WS_H), NPAD};
          REP(1) pg8::gemm_phase(lds, D, D, S, E); }
        gbar(bar, bgen, (unsigned)G);
        REP(2) { prep_phase(P, l, lds);
        gbar(bar, bgen, (unsigned)G); }
        REP(4) { hyena_phase(P, l, lds);
        gbar(bar, bgen, (unsigned)G); }
        chunkprep_phase(P, lds);
        gbar(bar, bgen, (unsigned)G);
        hgprep_phase(P, l, lds);
        gbar(bar, bgen, (unsigned)G);
        REP(3) { scan_phase(P, l, lds);
        gbar(bar, bgen, (unsigned)G); }
        REP(5) { assemble_phase(P, l, lds);
        gbar(bar, bgen, (unsigned)G); }
        { pg8::Order S{(const bf16_t*)(ws + WS_DN), (const bf16_t*)(ws + WS_WBR + (size_t)l * 3 * SZ_WBR), 3072, 1024, 32, D / 256, G, cidx, 3, 1024, (size_t)D * 1024, 1024, 1, 0, l ? 0 : 4};
          pg8::EpiBranch E{(float*)(ws + WS_SO), (bf16_t*)(ws + WS_U), (const bf16_t*)(ws + WS_H), (float*)(ws + WS_SCTX)};
          pg8::gemm_phase(lds, 3072, 1024, S, E); }
        gbar(bar, bgen, (unsigned)G);
        if (l == 0) { ctx_sb_from_sctx(P); gbar(bar, bgen, (unsigned)G); }
        { pg8::Order S{(const bf16_t*)(ws + WS_U), (const bf16_t*)(ws + WS_WOUT + (size_t)l * SZ_WOUT), D, D, 32, D / 256, G, cidx, 1, 0, 0, D, 1, 0, l ? 0 : 8};
          pg8::EpiRes E{(bf16_t*)(ws + WS_SO + (size_t)M * D * 4), (const float*)(ws + WS_X), modl, 2, (float*)(ws + WS_SCTX)};
          pg8::gemm_phase(lds, D, D, S, E); }
        gbar(bar, bgen, (unsigned)G);
        REP(8) { ln_rows(P, P.in[25] + l * D, P.in[26] + l * D, modl, 3, true, false, l ? 0 : 8, l == DEPTH - 1);
        gbar(bar, bgen, (unsigned)G); }
        { pg8::Order S{(const bf16_t*)(ws + WS_U), (const bf16_t*)(ws + WS_WFF1 + (size_t)l * SZ_WFF), D, D, l ? 32 : M / 256, DFF / 256, G, cidx, 1, 0, 0, D, l ? 1 : 0, 0, 0};
          pg8::EpiBf16<1> E{(bf16_t*)(ws + WS_H), DFF};
          REP(9) pg8::gemm_phase(lds, D, D, S, E); }
        gbar(bar, bgen, (unsigned)G);
        { pg8::Order S{(const bf16_t*)(ws + WS_H), (const bf16_t*)(ws + WS_WFF2 + (size_t)l * SZ_WFF), DFF, DFF, 32, D / 256, G, cidx, 1, 0, 0, DFF, 1, 0, l ? 0 : 16};
          pg8::EpiRes E{(bf16_t*)(ws + WS_SO + (size_t)M * D * 4), (const float*)(ws + WS_X), modl, 5, (float*)(ws + WS_SCTX)};
          pg8::gemm_phase(lds, DFF, DFF, S, E); }
        gbar(bar, bgen, (unsigned)G);
        const bool lastl = (l == DEPTH - 1);
        ln_rows(P, P.in[29] + l * D, P.in[30] + l * D, modl + (lastl ? 0 : 3 * 6 * D), 0, !lastl, lastl, l ? 0 : 16, lastl);
        if (!lastl) gbar(bar, bgen, (unsigned)G);
    }
}

extern "C" void kernel_launch(void* const* d_in, const int* in_sizes, int n_in, void* d_out, int out_size, void* d_ws, size_t ws_size, hipStream_t stream) {
    static int grid_blocks = 0;
    if (grid_blocks == 0) {
        if (n_in != 31 || ws_size < WS_END) { fprintf(stderr, "kernel_launch: unexpected n_in %d or ws_size %zu (need %zu)\n", n_in, ws_size, (size_t)WS_END); grid_blocks = -1; return; }
        int dev = 0, cus = 0, per_cu = 0;
        hipGetDevice(&dev);
        hipDeviceGetAttribute(&cus, hipDeviceAttributeMultiprocessorCount, dev);
        if (hipFuncSetAttribute((const void*)mega, hipFuncAttributeMaxDynamicSharedMemorySize, LDS_BYTES) != hipSuccess) fprintf(stderr, "kernel_launch: hipFuncSetAttribute failed\n");
        hipOccupancyMaxActiveBlocksPerMultiprocessor(&per_cu, (const void*)mega, NTHR, LDS_BYTES);
        if (per_cu < 1) { fprintf(stderr, "kernel_launch: occupancy query says %d blocks per CU\n", per_cu); per_cu = 1; }
        (void)hipGetLastError();
        grid_blocks = cus;
    }
    if (grid_blocks < 0) return;
    Params p{};
    for (int i = 0; i < 31; ++i) p.in[i] = (const float*)d_in[i];
    p.out = (float*)d_out; p.ws = (unsigned char*)d_ws;
    (void)hipMemsetAsync((unsigned char*)d_ws + WS_BAR, 0, 16384, stream);
    void* args[] = {&p};
    hipError_t e = hipLaunchCooperativeKernel((const void*)mega, dim3(grid_blocks), dim3(NTHR), args, LDS_BYTES, stream);
    if (e != hipSuccess) fprintf(stderr, "cooperative launch failed: %s (grid %d)\n", hipGetErrorString(e), grid_blocks);
}
```

```cpp
#include <hip/hip_runtime.h>
#include <hip/hip_cooperative_groups.h>
#include <cstdio>
#include <cstdint>
namespace cg = cooperative_groups;

#define LAS __attribute__((address_space(3)))
typedef unsigned short bf16_t;
typedef short bf16x8 __attribute__((ext_vector_type(8)));
typedef float f32x4 __attribute__((ext_vector_type(4)));
typedef float f32x2 __attribute__((ext_vector_type(2)));
typedef unsigned u32x4 __attribute__((ext_vector_type(4)));
typedef unsigned u32x2 __attribute__((ext_vector_type(2)));

constexpr int D = 2048, NB = 2, SEQ = 4096, CTX = 256, TPB = SEQ + CTX, M = NB * TPB, DEPTH = 2;
constexpr int INC = 17440, NPAD = 17664, DFF = 8192;
constexpr int C_HGFF = 0, C_HGFB = 1024, C_HGI = 2048, C_DNK = 3072, C_DNV = 3584, C_DNA = 4608, C_DNB = 4624,
              C_HGQ = 4640, C_HGG = 5664, C_DNQ = 6688, C_DNZ = 7200, C_HY = 8224, C_GATE = 11296;
constexpr int NTHR = 512, NWAVES = 8;
constexpr int LDS_BYTES = 147456;
constexpr float ALPHA = 1.41421356237f;

constexpr size_t al256(size_t x) { return (x + 255) & ~(size_t)255; }
constexpr size_t SZ_WIN = (size_t)NPAD * D * 2, SZ_WBR = (size_t)D * 1024 * 2, SZ_WOUT = (size_t)D * D * 2, SZ_WFF = (size_t)DFF * D * 2;
constexpr size_t WS_WIN = 0;
constexpr size_t WS_WBR = WS_WIN + DEPTH * SZ_WIN;
constexpr size_t WS_WOUT = WS_WBR + DEPTH * 3 * SZ_WBR;
constexpr size_t WS_WFF1 = WS_WOUT + DEPTH * SZ_WOUT;
constexpr size_t WS_WFF2 = WS_WFF1 + DEPTH * SZ_WFF;
constexpr size_t WS_X = WS_WFF2 + DEPTH * SZ_WFF;
constexpr size_t WS_U = WS_X + (size_t)M * D * 4;
constexpr size_t WS_H = WS_U + (size_t)M * D * 2;
constexpr size_t WS_DN = WS_H + (size_t)M * NPAD * 2;
constexpr size_t OFF_DNK = 0, OFF_DNQ = (size_t)M * 512 * 4, OFF_DNV = 2 * OFF_DNQ, OFF_DNS = OFF_DNV + (size_t)M * 1024 * 4;
constexpr size_t SZ_DN = OFF_DNS + (size_t)M * 64 * 4;
constexpr size_t WS_SO = WS_DN + SZ_DN;
constexpr size_t SZ_SO1 = (size_t)M * 1024 * 4;
constexpr size_t SZ_SOB = (size_t)M * 1024 * 2;
constexpr size_t WS_ZT = WS_SO + 4 * SZ_SO1;
constexpr size_t WS_ZY = WS_ZT + (size_t)3072 * 4096 * 8;
constexpr size_t WS_ZC = WS_ZY + (size_t)1024 * 4096 * 8;
constexpr size_t WS_MOD = WS_ZC + (size_t)2 * 256 * 3072 * 4;
constexpr size_t WS_HID = WS_MOD + (size_t)DEPTH * 3 * 6 * D * 4;
constexpr size_t SZ_HID1 = (size_t)64 * (4096 + 256) * 4;
constexpr size_t WS_LB = WS_HID + DEPTH * SZ_HID1;
constexpr size_t WS_BAR = WS_LB + (size_t)DEPTH * 2 * 1024 * 4;
constexpr size_t WS_SCTX = WS_ZT;
constexpr int NCHUNK = TPB / 16, NTASK = NB * 8 * 2 * NCHUNK;
constexpr size_t WS_CP1 = WS_ZT;
constexpr size_t CP1_STRIDE = 8192;
constexpr size_t WS_CPK = WS_U;
constexpr size_t WS_CP2 = WS_BAR + 16384;
constexpr size_t CP2_STRIDE = 512 + 512 + 128;
static_assert((size_t)NTASK * 4096 <= (size_t)M * D * 2, "CPK alias");
constexpr size_t WS_HGQ = WS_DN + OFF_DNK;
constexpr size_t WS_HGA = WS_ZT + (size_t)NTASK * CP1_STRIDE;
constexpr size_t WS_HGK = WS_CP2 + (size_t)NTASK * CP2_STRIDE;
constexpr size_t WS_HYC = WS_HGK + (size_t)NTASK * 4096;
static_assert((size_t)NTASK * 4096 <= 2 * (size_t)M * 512 * 4 && (size_t)NTASK * (CP1_STRIDE + 1024) <= (size_t)3072 * 4096 * 8, "HG fragment aliases");
constexpr size_t WS_END = WS_HYC + (size_t)512 * 1024 * 2;
static_assert((size_t)NTASK * CP1_STRIDE <= (size_t)3072 * 4096 * 8, "CP1 alias");
static_assert((size_t)16 * 512 * D * 4 <= (size_t)3072 * 4096 * 8, "PART alias");
static_assert(WS_END < (size_t)1142900000, "workspace too large");
static_assert((size_t)M * 3072 * 2 <= SZ_DN && (size_t)M * DFF * 2 <= (size_t)M * NPAD * 2 && 2 * (size_t)M * D * 4 <= 4 * SZ_SO1, "aliases");

struct Params { const float* in[31]; float* out; unsigned char* ws; };

#define LDS_WAIT() asm volatile("s_waitcnt lgkmcnt(0)" ::: "memory")
#define XB_CNT(j) (64 * (j))
#define XB_SUB(j) (1024 + 64 * (j))
#define XB_TOP 2048
#define XB_GEN 2112
__device__ __forceinline__ unsigned xcc_id() { return (unsigned)__builtin_amdgcn_s_getreg((3 << 11) | 20) & 0xFu; }
__device__ __forceinline__ int otid() { int t = threadIdx.x; asm volatile("" : "+v"(t)); return t; }
__device__ __forceinline__ int obid() { int t = blockIdx.x; asm volatile("" : "+s"(t)); return t; }
__device__ __forceinline__ unsigned pk2(float lo, float hi) { unsigned r; asm("v_cvt_pk_bf16_f32 %0, %1, %2" : "=v"(r) : "v"(lo), "v"(hi)); return r; }
typedef __bf16 bf16v2 __attribute__((ext_vector_type(2)));
__device__ __forceinline__ unsigned pk2n(float lo, float hi) { return __builtin_bit_cast(unsigned, __builtin_convertvector((f32x2){lo, hi}, bf16v2)); }
__device__ __forceinline__ float bflo(unsigned u) { return __uint_as_float(u << 16); }
__device__ __forceinline__ float bfhi(unsigned u) { return __uint_as_float(u & 0xffff0000u); }
__device__ __forceinline__ float bf1(bf16_t u) { return __uint_as_float(((unsigned)u) << 16); }
__device__ __forceinline__ float sigm(float x) { return __builtin_amdgcn_rcpf(1.f + __expf(-x)); }
__device__ __forceinline__ float silu(float x) { return x * sigm(x); }
__device__ __forceinline__ float sin_rad(float x) { float r = x * 0.15915494309189535f; r = r - floorf(r); return __builtin_amdgcn_sinf(r); }
template <int CTRL> __device__ __forceinline__ float dppf(float x) { return __builtin_bit_cast(float, __builtin_amdgcn_update_dpp(0, __builtin_bit_cast(int, x), CTRL, 0xf, 0xf, true)); }
__device__ __forceinline__ float row_sum16(float x) {
    x += dppf<0x128>(x); x += dppf<0x124>(x); x += dppf<0x122>(x); x += dppf<0x121>(x); return x;
}
__device__ __forceinline__ float wave_sum(float v) {
    v = row_sum16(v);
    const int iv = __builtin_bit_cast(int, v);
    const float a = __builtin_bit_cast(float, __builtin_amdgcn_readlane(iv, 0)), b = __builtin_bit_cast(float, __builtin_amdgcn_readlane(iv, 16));
    const float c = __builtin_bit_cast(float, __builtin_amdgcn_readlane(iv, 32)), d = __builtin_bit_cast(float, __builtin_amdgcn_readlane(iv, 48));
    return (a + b) + (c + d);
}
__device__ __forceinline__ void unpack8(u32x4 u, float* f) {
    f[0] = bflo(u.x); f[1] = bfhi(u.x); f[2] = bflo(u.y); f[3] = bfhi(u.y); f[4] = bflo(u.z); f[5] = bfhi(u.z); f[6] = bflo(u.w); f[7] = bfhi(u.w);
}

namespace pg8 {
constexpr int BM = 256, BK = 64, HALF = 128, HTB = HALF * BK * 2, NXCD = 8, WGM = 8;
__device__ __forceinline__ int lds_byte(int r, int c) { const int st = (r >> 4) * 2 + (c >> 5), rr = r & 15, cc = c & 31, ob = rr * 64 + cc * 2; return st * 1024 + (ob ^ (((ob >> 9) & 1) << 5)); }
__device__ __forceinline__ void stage_rc(int b, int& R, int& C) { const int st = b / 1024, sb = b % 1024, swz = sb ^ (((sb >> 9) & 1) << 5); R = (st >> 1) * 16 + swz / 64; C = (st & 1) * 32 + (swz % 64) / 2; }
__device__ __forceinline__ int perm32(int rho) { const int n = rho >> 4, i = rho & 15; return 8 * (i >> 2) + 4 * n + (i & 3); }

struct Unit { int pm, pn, g, nt, split, slot; const char* A; const char* B; };

__device__ __forceinline__ void tile_of(int L, int nM, int nN, int& pm, int& pn) {
    const int nwg = nM * nN; int wgid = L;
    { const int q = nwg / NXCD, r = nwg % NXCD, xcd = wgid % NXCD, off = wgid / NXCD; wgid = (xcd < r ? xcd * (q + 1) : r * (q + 1) + (xcd - r) * q) + off; }
    const int nig = WGM * nN, gid = wgid / nig, fm = gid * WGM, gsz = (nM - fm) < WGM ? (nM - fm) : WGM;
    pm = fm + ((wgid % nig) % gsz); pn = (wgid % nig) / gsz;
}
struct Order {
    const bf16_t* A; const bf16_t* Bt; int lda, ldb, nM, nN, G, c, nsub; size_t aks, bstride;
    int K;
    int latent_only, ctx_ncols;
    int ksplit;
    __device__ __forceinline__ bool next(int i, Unit& u) const {
        const int nmain = nM * nN;
        const int rounds = (nmain > c) ? (nmain - c + G - 1) / G : 0;
        if (i < rounds * nsub) {
            const int ti = i / nsub, g = i - ti * nsub; const int L = ti * G + c;
            tile_of(L, nM, nN, u.pm, u.pn); if (latent_only) u.pm += 1 + (u.pm >= 16);
            u.g = g; u.nt = K / BK; u.split = 0;
            u.A = (const char*)(A + (size_t)u.pm * BM * lda + (size_t)g * aks);
            u.B = (const char*)(Bt + (size_t)g * bstride + (size_t)u.pn * BM * ldb);
            return true;
        }
        const int e = i - rounds * nsub; const long Lx = (long)e * G + c;
        if (ksplit > 0) {
            if (Lx >= (long)2 * nN * nsub * ksplit) return false;
            const int s = (int)Lx, per = nsub * ksplit, tile = s / per, r = s - tile * per, g = r / ksplit, ks = r - g * ksplit, Ks = K / ksplit;
            const int q = tile / nN; u.pm = q * 17; u.pn = tile - q * nN; u.g = g; u.nt = Ks / BK; u.split = 1; u.slot = r;
            u.A = (const char*)(A + (size_t)u.pm * BM * lda + (size_t)g * aks + (size_t)ks * Ks);
            u.B = (const char*)(Bt + (size_t)g * bstride + (size_t)u.pn * BM * ldb + (size_t)ks * Ks);
            return true;
        }
        if (Lx >= (long)2 * ctx_ncols) return false;
        { const int j = (int)Lx; const int q = j / ctx_ncols; u.pm = q * 17; u.pn = j - q * ctx_ncols; }
        u.g = 0; u.nt = K / BK; u.split = 0;
        u.A = (const char*)(A + (size_t)u.pm * BM * lda);
        u.B = (const char*)(Bt + (size_t)u.pn * BM * ldb);
        return true;
    }
};

template <class Epi, class Sched>
__device__ __forceinline__ void gemm_phase(LAS unsigned char* lds, const int lda, const int ldb, const Sched& S, const Epi& E) {
    const int tid = otid(), wid = __builtin_amdgcn_readfirstlane(tid >> 6), lane = tid & 63, wr = wid >> 2, wc = wid & 3, fr = lane & 15, fq = lane >> 4;
    unsigned voffA[2], voffB[2];
#pragma unroll
    for (int i = 0; i < 2; ++i) { int R, C; stage_rc(tid * 16 + i * 8192, R, C); const int Rb = Epi::PERM ? ((R & ~31) + perm32(R & 31)) : R;
        voffA[i] = (unsigned)(R * lda + C) * 2u; voffB[i] = (unsigned)(Rb * ldb + C) * 2u; }
    const size_t kstep = (size_t)(BK * 2);
    const size_t hstepA = (size_t)HALF * lda * 2, hstepB = (size_t)HALF * ldb * 2;
    const unsigned ldsw = (unsigned)wid * 1024u;
    const int aoff = lds_byte(wr * 64 + fr, fq * 8), boff = lds_byte(wc * 32 + fr, fq * 8);
#define PG8_SA(b, h) (((b) * 2 + (h)) * HTB)
#define PG8_SB(b, h) ((4 + (b) * 2 + (h)) * HTB)
#define PG8_STAGE(bufoff, gbase, voff) do { _Pragma("unroll") for (int _i = 0; _i < 2; ++_i) \
        __builtin_amdgcn_global_load_lds((const unsigned*)((const char*)(gbase) + (voff)[_i]), (LAS unsigned*)(lds + (bufoff) + ldsw + _i * 8192), 16, 0, 0); } while (0)
#define PG8_LDA(dst, b, h) do { _Pragma("unroll") for (int m = 0; m < 4; ++m) _Pragma("unroll") for (int k = 0; k < 2; ++k) dst[m][k] = *(const LAS bf16x8*)(lds + PG8_SA(b, h) + aoff + m * 2048 + k * 1024); } while (0)
#define PG8_LDB(dst, b, h) do { _Pragma("unroll") for (int n = 0; n < 2; ++n) _Pragma("unroll") for (int k = 0; k < 2; ++k) dst[n][k] = *(const LAS bf16x8*)(lds + PG8_SB(b, h) + boff + n * 2048 + k * 1024); } while (0)
#define PG8_MMA(ai, bj, At, Bt) do { __builtin_amdgcn_s_setprio(1); _Pragma("unroll") for (int m = 0; m < 4; ++m) _Pragma("unroll") for (int n = 0; n < 2; ++n) _Pragma("unroll") for (int k = 0; k < 2; ++k) \
        acc[ai][bj][m][n] = __builtin_amdgcn_mfma_f32_16x16x32_bf16(Bt[n][k], At[m][k], acc[ai][bj][m][n], 0, 0, 0); __builtin_amdgcn_s_setprio(0); } while (0)
#define PG8_WAIT_V(n) asm volatile("s_waitcnt vmcnt(" #n ")" ::: "memory")
#define PG8_WAIT_L(n) asm volatile("s_waitcnt lgkmcnt(" #n ")" ::: "memory")
#define PG8_BAR __builtin_amdgcn_s_barrier()
#define PG8_SCHED __builtin_amdgcn_sched_barrier(0)
    Unit cur, nxt; int ui = 0;
    if (!S.next(0, cur)) return;
    f32x4 acc[2][2][4][2];
#pragma unroll
    for (int a = 0; a < 2; ++a)
#pragma unroll
        for (int b = 0; b < 2; ++b)
#pragma unroll
            for (int m = 0; m < 4; ++m)
#pragma unroll
                for (int n = 0; n < 2; ++n) acc[a][b][m][n] = (f32x4){0.f, 0.f, 0.f, 0.f};
    bf16x8 At[4][2], B0[2][2], B1[2][2];
    const char* cA = cur.A; const char* cB = cur.B;
    PG8_STAGE(PG8_SB(0, 0), cB, voffB); PG8_STAGE(PG8_SA(0, 0), cA, voffA); PG8_STAGE(PG8_SB(0, 1), cB + hstepB, voffB); PG8_STAGE(PG8_SA(0, 1), cA + hstepA, voffA);
    if (wr == 1) PG8_BAR;
    PG8_WAIT_V(4); PG8_BAR;
    PG8_STAGE(PG8_SB(1, 0), cB + kstep, voffB); PG8_STAGE(PG8_SA(1, 0), cA + kstep, voffA); PG8_STAGE(PG8_SB(1, 1), cB + hstepB + kstep, voffB);
    PG8_WAIT_V(6); PG8_BAR;
    for (;;) {
        const bool has_next = S.next(ui + 1, nxt);
        const char* nA = has_next ? nxt.A : cA; const char* nB = has_next ? nxt.B : cB;
        const int nt = cur.nt;
        for (int t = 0; t < nt; t += 2) {
            const bool last = (t == nt - 2);
            const char* a1 = cA + (size_t)(t + 1) * kstep;
            const char* a2 = last ? nA : cA + (size_t)(t + 2) * kstep; const char* b2 = last ? nB : cB + (size_t)(t + 2) * kstep;
            const char* a3 = a2 + kstep; const char* b3 = b2 + kstep;
            PG8_LDB(B0, 0, 0); PG8_SCHED; PG8_LDA(At, 0, 0); PG8_STAGE(PG8_SA(1, 1), a1 + hstepA, voffA);
            PG8_WAIT_L(8); PG8_BAR; PG8_WAIT_L(0); PG8_MMA(0, 0, At, B0); PG8_BAR; PG8_SCHED;
            PG8_LDB(B1, 0, 1); PG8_STAGE(PG8_SB(0, 0), b2, voffB);
            PG8_BAR; PG8_WAIT_L(0); PG8_MMA(0, 1, At, B1); PG8_BAR;
            PG8_LDA(At, 0, 1); PG8_STAGE(PG8_SA(0, 0), a2, voffA);
            PG8_BAR; PG8_WAIT_L(0); PG8_MMA(1, 0, At, B0); PG8_BAR; PG8_SCHED;
            PG8_STAGE(PG8_SB(0, 1), b2 + hstepB, voffB);
            PG8_WAIT_V(6); PG8_BAR; PG8_MMA(1, 1, At, B1); PG8_BAR;
            PG8_LDB(B0, 1, 0); PG8_SCHED; PG8_LDA(At, 1, 0); PG8_STAGE(PG8_SA(0, 1), a2 + hstepA, voffA);
            PG8_WAIT_L(8); PG8_BAR; PG8_WAIT_L(0); PG8_MMA(0, 0, At, B0); PG8_BAR; PG8_SCHED;
            PG8_LDB(B1, 1, 1); PG8_STAGE(PG8_SB(1, 0), b3, voffB);
            PG8_BAR; PG8_WAIT_L(0); PG8_MMA(0, 1, At, B1); PG8_BAR;
            PG8_LDA(At, 1, 1); PG8_STAGE(PG8_SA(1, 0), a3, voffA);
            PG8_BAR; PG8_WAIT_L(0); PG8_MMA(1, 0, At, B0); PG8_BAR; PG8_SCHED;
            PG8_STAGE(PG8_SB(1, 1), b3 + hstepB, voffB);
            PG8_WAIT_V(6); PG8_BAR; PG8_MMA(1, 1, At, B1); PG8_BAR;
        }
        E(acc, cur, wr, wc, fr, fq);
        if (!has_next) break;
#pragma unroll
        for (int a = 0; a < 2; ++a)
#pragma unroll
            for (int b = 0; b < 2; ++b)
#pragma unroll
                for (int m = 0; m < 4; ++m)
#pragma unroll
                    for (int n = 0; n < 2; ++n) acc[a][b][m][n] = (f32x4){0.f, 0.f, 0.f, 0.f};
        cur = nxt; cA = nA; cB = nB; ++ui;
    }
    PG8_WAIT_V(0);
    if (wr == 0) PG8_BAR;
    PG8_BAR;
#undef PG8_SA
#undef PG8_SB
#undef PG8_STAGE
#undef PG8_LDA
#undef PG8_LDB
#undef PG8_MMA
#undef PG8_WAIT_V
#undef PG8_WAIT_L
#undef PG8_BAR
#undef PG8_SCHED
}

template <int ACT> struct EpiBf16 {
    static constexpr bool PERM = true;
    bf16_t* O; int ldc;
    __device__ __forceinline__ void operator()(const f32x4 (&acc)[2][2][4][2], const Unit& u, int wr, int wc, int fr, int fq) const {
        const int row0 = u.pm * BM + wr * 64 + fr, col0 = u.pn * BM + wc * 32 + 8 * fq;
#pragma unroll
        for (int ai = 0; ai < 2; ++ai)
#pragma unroll
            for (int m = 0; m < 4; ++m) { bf16_t* rowp = O + (size_t)(row0 + ai * HALF + m * 16) * ldc + col0;
#pragma unroll
                for (int bj = 0; bj < 2; ++bj) { f32x4 v0 = acc[ai][bj][m][0], v1 = acc[ai][bj][m][1];
                    if (ACT == 1) {
#pragma unroll
                        for (int e = 0; e < 4; ++e) { float a = fmaxf(v0[e], 0.f), b = fmaxf(v1[e], 0.f); v0[e] = a * a; v1[e] = b * b; } }
                    u32x4 o; o.x = pk2(v0[0], v0[1]); o.y = pk2(v0[2], v0[3]); o.z = pk2(v1[0], v1[1]); o.w = pk2(v1[2], v1[3]);
                    *(u32x4*)(rowp + bj * HALF) = o; } }
    }
};
struct EpiRes {
    static constexpr bool PERM = true;
    bf16_t* T; const float* X; const float* mod; int gidx; float* PART;
    __device__ __forceinline__ void operator()(const f32x4 (&acc)[2][2][4][2], const Unit& u, int wr, int wc, int fr, int fq) const {
        const int row0 = u.pm * BM + wr * 64 + fr, col0 = u.pn * BM + wc * 32 + 8 * fq;
        const int b = u.pm / 17, isctx = (u.pm - b * 17) == 0;
        const float* gv = mod + (size_t)(isctx ? 2 : b) * (6 * D) + (size_t)gidx * D;
#pragma unroll
        for (int bj = 0; bj < 2; ++bj) { const int col = col0 + bj * HALF; const f32x4 g0 = *(const f32x4*)(gv + col), g1 = *(const f32x4*)(gv + col + 4);
#pragma unroll
            for (int ai = 0; ai < 2; ++ai)
#pragma unroll
                for (int m = 0; m < 4; ++m) { const int row = row0 + ai * HALF + m * 16; const size_t o = (size_t)row * D + col;
                    const f32x4 t0 = g0 * acc[ai][bj][m][0], t1 = g1 * acc[ai][bj][m][1];
                    if (u.split) { float* pp = PART + ((size_t)u.slot * 512 + (row - u.pm * BM + (u.pm ? 256 : 0))) * D + col; *(f32x4*)pp = t0; *(f32x4*)(pp + 4) = t1; }
                    else { u32x4 ov; ov.x = pk2(t0[0], t0[1]); ov.y = pk2(t0[2], t0[3]); ov.z = pk2(t1[0], t1[1]); ov.w = pk2(t1[2], t1[3]); *(u32x4*)(T + o) = ov; } } }
    }
};
struct EpiBranch {
    static constexpr bool PERM = true;
    float* S; bf16_t* SB; const bf16_t* H; float* SCTX;
    __device__ __forceinline__ void operator()(const f32x4 (&acc)[2][2][4][2], const Unit& u, int wr, int wc, int fr, int fq) const {
        const int row0 = u.pm * BM + wr * 64 + fr, col0 = u.pn * BM + wc * 32 + 8 * fq; const int g = u.g;
#pragma unroll
        for (int ai = 0; ai < 2; ++ai)
#pragma unroll
            for (int m = 0; m < 4; ++m) { const int row = row0 + ai * HALF + m * 16;
#pragma unroll
                for (int bj = 0; bj < 2; ++bj) { const int col = col0 + bj * HALF;
                    float gt[8]; unpack8(*(const u32x4*)(H + (size_t)row * NPAD + C_GATE + g * D + col), gt);
                    float v[8];
#pragma unroll
                    for (int e = 0; e < 4; ++e) { v[e] = sigm(gt[e]) * acc[ai][bj][m][0][e]; v[4 + e] = sigm(gt[4 + e]) * acc[ai][bj][m][1][e]; }
                    if (u.split) { float* cp = SCTX + ((size_t)u.slot * 512 + (row - u.pm * BM + (u.pm ? 256 : 0))) * D + col;
                        *(f32x4*)cp = (f32x4){v[0], v[1], v[2], v[3]}; *(f32x4*)(cp + 4) = (f32x4){v[4], v[5], v[6], v[7]}; }
                    else {
                        bf16_t* sp = SB + (size_t)row * D + col;
                        if (g > 0) { float pv[8]; unpack8(*(const u32x4*)sp, pv);
#pragma unroll
                            for (int e = 0; e < 8; ++e) v[e] += pv[e]; }
                        u32x4 o; o.x = pk2(v[0], v[1]); o.y = pk2(v[2], v[3]); o.z = pk2(v[4], v[5]); o.w = pk2(v[6], v[7]); *(u32x4*)sp = o; } } }
    }
};
}

__device__ __forceinline__ void transpose_item(const float* __restrict__ W, int K, int N, bf16_t* __restrict__ WT, LAS float* scr, int item, int lane) {
    const int nblk = N / 32, kb = item / nblk, nb = item - kb * nblk, k0 = 64 * kb, n0 = 32 * nb;
#pragma unroll 8
    for (int i = 0; i < 32; ++i) { const int kk = 2 * i + (lane >> 5); scr[kk * 33 + (lane & 31)] = W[(size_t)(k0 + kk) * N + n0 + (lane & 31)]; }
    LDS_WAIT();
    const int c = lane & 7;
#pragma unroll
    for (int j = 0; j < 4; ++j) { const int n = (lane >> 3) + 8 * j; const LAS float* s = scr + (8 * c) * 33 + n;
        u32x4 o; o.x = pk2(s[0 * 33], s[1 * 33]); o.y = pk2(s[2 * 33], s[3 * 33]); o.z = pk2(s[4 * 33], s[5 * 33]); o.w = pk2(s[6 * 33], s[7 * 33]);
        *(u32x4*)(WT + (size_t)(n0 + n) * K + k0 + 8 * c) = o; }
    LDS_WAIT();
}

__device__ __forceinline__ void transpose_item64(const float* __restrict__ W, int K, int N, bf16_t* __restrict__ WT, LAS float* scr, int item, int lane) {
    const int nblk = (N + 63) >> 6, kb = item / nblk, nb = item - kb * nblk, k0 = 64 * kb, n0 = 64 * nb;
    const bool valid = (n0 + lane) < N;
    float wv[64];
    const float* wp = W + (size_t)k0 * N + n0 + (valid ? lane : 0);
#pragma unroll
    for (int i = 0; i < 64; ++i) wv[i] = __builtin_nontemporal_load(wp + (size_t)i * N);
#pragma unroll
    for (int i = 0; i < 64; ++i) scr[i * 65 + lane] = wv[i];
    LDS_WAIT();
#pragma unroll
    for (int j = 0; j < 8; ++j) { const int task = lane + 64 * j, n = task >> 3, c = task & 7; const LAS float* s = scr + (8 * c) * 65 + n;
        u32x4 o; o.x = pk2(s[0 * 65], s[1 * 65]); o.y = pk2(s[2 * 65], s[3 * 65]); o.z = pk2(s[4 * 65], s[5 * 65]); o.w = pk2(s[6 * 65], s[7 * 65]);
        if (n0 + n < N) *(u32x4*)(WT + (size_t)(n0 + n) * K + k0 + 8 * c) = o; }
    LDS_WAIT();
}

__device__ __forceinline__ void phase0(const Params& P, LAS unsigned char* lds) {
    const int tid = otid(), lane = tid & 63, wave = tid >> 6, G = gridDim.x;
    unsigned char* ws = P.ws;
    {
        LAS float* sil = (LAS float*)lds;
        LAS float* red = sil + 3 * 2048;
        for (int i = tid; i < 3 * 2048; i += NTHR) { const int v = i >> 11, k = i & 2047; const float x = (v < 2) ? P.in[1][v * 2048 + k] : P.in[3][k]; sil[i] = silu(x); }
        __syncthreads();
        for (int vb = blockIdx.x; vb < 256; vb += G) {
            const int colg = vb * 96, l = colg / 12288, cl = colg - l * 12288;
            if (tid < 504) {
                const int c4 = tid % 24, kg = tid / 24;
                f32x4 a0 = {0.f, 0.f, 0.f, 0.f}, a1 = a0, a2 = a0;
                const float* wp = P.in[4] + (size_t)l * 2048 * 12288 + cl + c4 * 4;
                int k = kg;
#pragma unroll 1
                for (; k + 21 * 15 < 2048; k += 21 * 16) {
                    f32x4 w[16];
#pragma unroll
                    for (int u = 0; u < 16; ++u) w[u] = __builtin_nontemporal_load((const f32x4*)(wp + (size_t)(k + 21 * u) * 12288));
#pragma unroll
                    for (int u = 0; u < 16; ++u) { a0 += sil[k + 21 * u] * w[u]; a1 += sil[2048 + k + 21 * u] * w[u]; a2 += sil[4096 + k + 21 * u] * w[u]; } }
                for (; k < 2048; k += 21) { const f32x4 w = *(const f32x4*)(wp + (size_t)k * 12288); a0 += sil[k] * w; a1 += sil[2048 + k] * w; a2 += sil[4096 + k] * w; }
                LAS float* rp = red + (kg * 24 + c4) * 12;
#pragma unroll
                for (int e = 0; e < 4; ++e) { rp[e] = a0[e]; rp[4 + e] = a1[e]; rp[8 + e] = a2[e]; }
            }
            __syncthreads();
            if (tid < 288) { const int c4 = tid / 12, ve = tid - c4 * 12, v = ve >> 2, e = ve & 3; float s = 0.f;
                for (int kg = 0; kg < 21; ++kg) s += red[(kg * 24 + c4) * 12 + ve];
                const int col = cl + c4 * 4 + e;
                ((float*)(ws + WS_MOD))[(size_t)(l * 3 + v) * 12288 + col] = s + P.in[5][l * 12288 + col]; }
            __syncthreads();
        }
    }
    {
        LAS float* feats = (LAS float*)lds;
        LAS float* hid1 = feats + 8 * 36;
        for (int item = blockIdx.x; item < 2 * 544; item += G) {
            const int l = item / 544, it = item - l * 544, lsel = it >= 512, L = lsel ? 256 : 4096, t0 = (lsel ? it - 512 : it) * 8;
            const int tt = tid >> 6, j = tid & 63, t = t0 + tt;
            if (j < 33) { float f;
                if (j == 0) f = (float)t / (float)(L - 1);
                else { const int bi = (j - 1) & 15; const float band = 1e-4f + (float)bi * ((15.f - 1e-4f) / 15.f); float rev = band * ((float)t / (float)L); rev = rev - floorf(rev);
                    f = (j <= 16) ? __builtin_amdgcn_cosf(rev) : -__builtin_amdgcn_sinf(rev); }
                feats[tt * 36 + j] = f; }
            __syncthreads();
            { const float* w1 = P.in[9] + (size_t)l * 33 * 64; float a = P.in[10][l * 64 + j];
              for (int f = 0; f < 33; ++f) a += feats[tt * 36 + f] * w1[f * 64 + j];
              hid1[tt * 64 + j] = sin_rad(a); }
            __syncthreads();
            { const float* w2 = P.in[11] + (size_t)l * 64 * 64; float a = P.in[12][l * 64 + j];
              for (int i = 0; i < 64; ++i) a += hid1[tt * 64 + i] * w2[i * 64 + j];
              float* hid = (float*)(ws + WS_HID + (size_t)l * SZ_HID1) + (lsel ? 64 * 4096 : 0);
              hid[(size_t)j * L + t] = sin_rad(a); }
            __syncthreads();
        }
    }
    if (tid == 0) (void)__hip_atomic_fetch_add((unsigned*)(ws + WS_BAR) + XB_CNT(xcc_id()), 1u, __ATOMIC_RELAXED, __HIP_MEMORY_SCOPE_AGENT);
    for (int i = blockIdx.x * NTHR + tid; i < DEPTH * 2 * 1024; i += G * NTHR) {
        const int l = i >> 11, dir = (i >> 10) & 1, ch = i & 1023;
        float x[DEPTH], mx = -1e30f;
#pragma unroll
        for (int q = 0; q < DEPTH; ++q) { x[q] = P.in[15][((size_t)dir * DEPTH + q) * 1024 + ch]; mx = fmaxf(mx, x[q]); }
        float den = 0.f, num = 0.f;
#pragma unroll
        for (int q = 0; q < DEPTH; ++q) { const float e = __expf(x[q] - mx); den += e; if (q >= 1 && q <= l) num += e; }
        ((float*)(ws + WS_LB))[i] = num / den;
    }
    for (int i = blockIdx.x * NTHR + tid; i < DEPTH * (NPAD - INC) * D / 8; i += G * NTHR) {
        const int per = (NPAD - INC) * D / 8, l = i / per, r = i - l * per;
        ((u32x4*)(ws + WS_WIN + (size_t)l * SZ_WIN + (size_t)INC * D * 2))[r] = (u32x4){0u, 0u, 0u, 0u};
    }
    {
        LAS float* scr = (LAS float*)(lds + wave * 16896);
        const int gw = blockIdx.x * NWAVES + wave, NGW = G * NWAVES;
        constexpr int I_IN = 32 * 273, I_BR = 16 * 32, I_OUT = 32 * 32, I_F1 = 32 * 128, I_F2 = 128 * 32;
        constexpr int PER = I_IN + 3 * I_BR + I_OUT + I_F1 + I_F2;
        for (int it = gw; it < (DEPTH - 1) * PER; it += NGW) {
            const int l = it / PER; int r = it - l * PER;
            if (r < I_IN) { transpose_item64(P.in[6] + (size_t)l * D * INC, D, INC, (bf16_t*)(ws + WS_WIN + (size_t)l * SZ_WIN), scr, r, lane); continue; } r -= I_IN;
            if (r < 3 * I_BR) { const int g = r / I_BR; transpose_item64(P.in[23] + (size_t)(l * 3 + g) * 1024 * D, 1024, D, (bf16_t*)(ws + WS_WBR + (size_t)(l * 3 + g) * SZ_WBR), scr, r - g * I_BR, lane); continue; } r -= 3 * I_BR;
            if (r < I_OUT) { transpose_item64(P.in[24] + (size_t)l * D * D, D, D, (bf16_t*)(ws + WS_WOUT + (size_t)l * SZ_WOUT), scr, r, lane); continue; } r -= I_OUT;
            if (r < I_F1) { transpose_item64(P.in[27] + (size_t)l * D * DFF, D, DFF, (bf16_t*)(ws + WS_WFF1 + (size_t)l * SZ_WFF), scr, r, lane); continue; } r -= I_F1;
            transpose_item64(P.in[28] + (size_t)l * DFF * D, DFF, D, (bf16_t*)(ws + WS_WFF2 + (size_t)l * SZ_WFF), scr, r, lane);
        }
    }
}

__device__ __forceinline__ void init_rows(const Params& P) {
    const int tid = otid(); const int lane = tid & 63, gw = blockIdx.x * NWAVES + (tid >> 6), NGW = gridDim.x * NWAVES;
    float* X = (float*)(P.ws + WS_X); bf16_t* U = (bf16_t*)(P.ws + WS_U); const float* mod = (const float*)(P.ws + WS_MOD);
#define INIT_SRC(r_) (((r_) % TPB) < CTX ? P.in[2] + ((size_t)((r_) / TPB) * CTX + ((r_) % TPB)) * D : P.in[0] + ((size_t)((r_) / TPB) * SEQ + (((r_) % TPB) - CTX)) * D)
    f32x4 cv[8];
#pragma unroll
    for (int j = 0; j < 8; ++j) cv[j] = (f32x4){0.f, 0.f, 0.f, 0.f};
    if (gw < M) { const float* s0 = INIT_SRC(gw);
#pragma unroll
        for (int j = 0; j < 8; ++j) cv[j] = __builtin_nontemporal_load((const f32x4*)(s0 + (j * 64 + lane) * 4)); }
#pragma unroll 1
    for (int r = gw; r < M; r += NGW) {
        const int b = r / TPB, p = r - b * TPB; const bool isctx = p < CTX;
        f32x4 nv[8];
#pragma unroll
        for (int j = 0; j < 8; ++j) nv[j] = (f32x4){0.f, 0.f, 0.f, 0.f};
        if (r + NGW < M) { const float* s1 = INIT_SRC(r + NGW);
#pragma unroll
            for (int j = 0; j < 8; ++j) nv[j] = __builtin_nontemporal_load((const f32x4*)(s1 + (j * 64 + lane) * 4)); }
        const float* mv = mod + (size_t)(isctx ? 2 : b) * (6 * D);
#pragma unroll
        for (int j = 0; j < 8; ++j) { const int c = (j * 64 + lane) * 4; const f32x4 v = cv[j];
            *(f32x4*)(X + (size_t)r * D + c) = v;
            const f32x4 sh = *(const f32x4*)(mv + c), sc = *(const f32x4*)(mv + D + c); const f32x4 y = v * (1.f + sc) + sh;
            u32x2 o; o.x = pk2(y[0], y[1]); o.y = pk2(y[2], y[3]); *(u32x2*)(U + (size_t)r * D + c) = o; }
#pragma unroll
        for (int j = 0; j < 8; ++j) cv[j] = nv[j];
    }
#undef INIT_SRC
}
__device__ __forceinline__ void ln_rows(const Params& P, const float* gam, const float* bet, const float* modU, int shidx, bool writeU, bool writeOut, int nsplit, bool skipctx) {
    const int tid = otid(); const int lane = tid & 63, gw = blockIdx.x * NWAVES + (tid >> 6), NGW = gridDim.x * NWAVES;
    float* X = (float*)(P.ws + WS_X); bf16_t* U = (bf16_t*)(P.ws + WS_U); const bf16_t* T = (const bf16_t*)(P.ws + WS_SO + (size_t)M * D * 4);
    f32x4 gv[8], bv[8];
#pragma unroll
    for (int j = 0; j < 8; ++j) { const int c = ((j >> 1) * 64 + lane) * 8 + (j & 1) * 4; gv[j] = *(const f32x4*)(gam + c); bv[j] = *(const f32x4*)(bet + c); }
    int r = gw;
    while (r < M && skipctx && (r % TPB) < CTX) r += NGW;
    f32x4 cx[8]; u32x4 ct[4]; bool pf = false;
#pragma unroll
    for (int j = 0; j < 8; ++j) cx[j] = (f32x4){0.f, 0.f, 0.f, 0.f};
#pragma unroll
    for (int j = 0; j < 4; ++j) ct[j] = (u32x4){0u, 0u, 0u, 0u};
    if (r < M && !((r % TPB) < CTX && nsplit > 0)) { pf = true;
#pragma unroll
        for (int jj = 0; jj < 4; ++jj) { const int c = (jj * 64 + lane) * 8; cx[2 * jj] = *(const f32x4*)(X + (size_t)r * D + c); cx[2 * jj + 1] = *(const f32x4*)(X + (size_t)r * D + c + 4); ct[jj] = *(const u32x4*)(T + (size_t)r * D + c); } }
#pragma unroll 1
    while (r < M) {
        int rn = r + NGW;
        while (rn < M && skipctx && (rn % TPB) < CTX) rn += NGW;
        f32x4 nx[8]; u32x4 nt[4]; bool npf = false;
#pragma unroll
        for (int j = 0; j < 8; ++j) nx[j] = (f32x4){0.f, 0.f, 0.f, 0.f};
#pragma unroll
        for (int j = 0; j < 4; ++j) nt[j] = (u32x4){0u, 0u, 0u, 0u};
        if (rn < M && !((rn % TPB) < CTX && nsplit > 0)) { npf = true;
#pragma unroll
            for (int jj = 0; jj < 4; ++jj) { const int c = (jj * 64 + lane) * 8; nx[2 * jj] = *(const f32x4*)(X + (size_t)rn * D + c); nx[2 * jj + 1] = *(const f32x4*)(X + (size_t)rn * D + c + 4); nt[jj] = *(const u32x4*)(T + (size_t)rn * D + c); } }
        const int b = r / TPB, p = r - b * TPB; const bool isctx = p < CTX;
        f32x4 v[8]; float s = 0.f;
#pragma unroll
        for (int j = 0; j < 8; ++j) { const int c = ((j >> 1) * 64 + lane) * 8 + (j & 1) * 4;
            if (!pf) {
                f32x4 a = *(const f32x4*)(X + (size_t)r * D + c) * ALPHA; const float* pp = (const float*)(P.ws + WS_SCTX) + ((size_t)b * 256 + p) * D + c;
                for (int q = 0; q < nsplit; ++q) a += *(const f32x4*)(pp + (size_t)q * 512 * D);
                v[j] = a; }
            else { const unsigned t0 = (j & 1) ? ct[j >> 1].z : ct[j >> 1].x, t1 = (j & 1) ? ct[j >> 1].w : ct[j >> 1].y;
                v[j] = cx[j] * ALPHA + (f32x4){bflo(t0), bfhi(t0), bflo(t1), bfhi(t1)}; }
            s += (v[j][0] + v[j][1]) + (v[j][2] + v[j][3]); }
        const float mean = wave_sum(s) * (1.f / D); float s2 = 0.f;
#pragma unroll
        for (int j = 0; j < 8; ++j) { v[j] = v[j] - mean; s2 += (v[j][0] * v[j][0] + v[j][1] * v[j][1]) + (v[j][2] * v[j][2] + v[j][3] * v[j][3]); }
        const float rstd = __builtin_amdgcn_rsqf(wave_sum(s2) * (1.f / D) + 1e-5f);
        const float* mv = modU + (size_t)(isctx ? 2 : b) * (6 * D) + (size_t)shidx * D;
#pragma unroll
        for (int jj = 0; jj < 4; ++jj) { const int c = (jj * 64 + lane) * 8;
            const f32x4 y0 = v[2 * jj] * rstd * gv[2 * jj] + bv[2 * jj], y1 = v[2 * jj + 1] * rstd * gv[2 * jj + 1] + bv[2 * jj + 1];
            if (!writeOut) { *(f32x4*)(X + (size_t)r * D + c) = y0; *(f32x4*)(X + (size_t)r * D + c + 4) = y1; }
            if (writeU) { const f32x4 sh0 = *(const f32x4*)(mv + c), sc0 = *(const f32x4*)(mv + D + c), sh1 = *(const f32x4*)(mv + c + 4), sc1 = *(const f32x4*)(mv + D + c + 4);
                const f32x4 z0 = y0 * (1.f + sc0) + sh0, z1 = y1 * (1.f + sc1) + sh1;
                u32x4 o; o.x = pk2(z0[0], z0[1]); o.y = pk2(z0[2], z0[3]); o.z = pk2(z1[0], z1[1]); o.w = pk2(z1[2], z1[3]); *(u32x4*)(U + (size_t)r * D + c) = o; }
            if (writeOut && !isctx) { float* op = P.out + ((size_t)b * SEQ + (p - CTX)) * D + c; *(f32x4*)op = y0; *(f32x4*)(op + 4) = y1; } }
#pragma unroll
        for (int j = 0; j < 8; ++j) cx[j] = nx[j];
#pragma unroll
        for (int j = 0; j < 4; ++j) ct[j] = nt[j];
        pf = npf; r = rn;
    }
}

__device__ __forceinline__ void prep_phase(const Params& P, int l, LAS unsigned char* lds) {
    const int tid = otid(), lane = tid & 63, wave = tid >> 6, G = gridDim.x;
    const int gw = blockIdx.x * NWAVES + wave, NGW = G * NWAVES;
    unsigned char* ws = P.ws;
    const bf16_t* H = (const bf16_t*)(ws + WS_H);
    float* DNK = (float*)(ws + WS_DN + OFF_DNK); float* DNQ = (float*)(ws + WS_DN + OFF_DNQ); float* DNV = (float*)(ws + WS_DN + OFF_DNV); float* DNS = (float*)(ws + WS_DN + OFF_DNS);
    {
        const u32x4 z4 = {0u, 0u, 0u, 0u};
#define DNP_LOAD(hu, ga, gb, row) do { const int p_ = (row) % TPB; \
            const bool hasL_ = (p_ < CTX) ? (p_ > 0) : ((p_ & 63) != 0), hasR_ = (p_ < CTX) ? (p_ < CTX - 1) : ((p_ & 63) != 63); \
            const bf16_t* h_ = H + (size_t)(row) * NPAD; \
            _Pragma("unroll") for (int w_ = 0; w_ < 4; ++w_) { const int col_ = (w_ == 0 ? C_DNK : w_ == 1 ? C_DNQ : C_DNV + (w_ - 2) * 512) + lane * 8; \
                hu[3 * w_ + 0] = hasL_ ? *(const u32x4*)(h_ - NPAD + col_) : z4; hu[3 * w_ + 1] = *(const u32x4*)(h_ + col_); hu[3 * w_ + 2] = hasR_ ? *(const u32x4*)(h_ + NPAD + col_) : z4; } \
            ga = h_[C_DNA + (lane & 15)]; gb = h_[C_DNB + (lane & 15)]; } while (0)
        float cwk[3][8], cwq[3][8], cwv[2][3][8];
#pragma unroll
        for (int j = 0; j < 3; ++j)
#pragma unroll
            for (int e = 0; e < 8; ++e) { cwk[j][e] = P.in[18][(size_t)l * 3 * 512 + j * 512 + lane * 8 + e]; cwq[j][e] = P.in[17][(size_t)l * 3 * 512 + j * 512 + lane * 8 + e];
                cwv[0][j][e] = P.in[19][(size_t)l * 3 * 1024 + j * 1024 + lane * 8 + e]; cwv[1][j][e] = P.in[19][(size_t)l * 3 * 1024 + j * 1024 + 512 + lane * 8 + e]; }
        int r = gw;
        u32x4 ch_[12]; bf16_t cga = 0, cgb = 0;
#pragma unroll
        for (int i = 0; i < 12; ++i) ch_[i] = z4;
        if (r < M) DNP_LOAD(ch_, cga, cgb, r);
#pragma unroll 1
        while (r < M) {
            const int rn_ = r + NGW;
            u32x4 nh_[12]; bf16_t nga = 0, ngb = 0;
#pragma unroll
            for (int i = 0; i < 12; ++i) nh_[i] = z4;
            if (rn_ < M) DNP_LOAD(nh_, nga, ngb, rn_);
            float kn[8], qn[8];
#pragma unroll
            for (int which = 0; which < 2; ++which) {
                float xm[8], x0[8], xp[8]; unpack8(ch_[3 * which], xm); unpack8(ch_[3 * which + 1], x0); unpack8(ch_[3 * which + 2], xp);
                float y[8], ss = 0.f;
#pragma unroll
                for (int e = 0; e < 8; ++e) { y[e] = silu(xm[e] * (which ? cwq[0][e] : cwk[0][e]) + x0[e] * (which ? cwq[1][e] : cwk[1][e]) + xp[e] * (which ? cwq[2][e] : cwk[2][e])); ss += y[e] * y[e]; }
                ss = row_sum16(ss);
                const float rn = __builtin_amdgcn_rsqf(ss + 1e-6f) * (which ? 0.08838834764831845f : 1.f);
#pragma unroll
                for (int e = 0; e < 8; ++e) { if (which) qn[e] = y[e] * rn; else kn[e] = y[e] * rn; }
            }
            float qk = 0.f;
#pragma unroll
            for (int e = 0; e < 8; ++e) qk += qn[e] * kn[e];
            qk = row_sum16(qk);
            *(f32x4*)(DNK + (size_t)r * 512 + lane * 8) = (f32x4){kn[0], kn[1], kn[2], kn[3]}; *(f32x4*)(DNK + (size_t)r * 512 + lane * 8 + 4) = (f32x4){kn[4], kn[5], kn[6], kn[7]};
            *(f32x4*)(DNQ + (size_t)r * 512 + lane * 8) = (f32x4){qn[0], qn[1], qn[2], qn[3]}; *(f32x4*)(DNQ + (size_t)r * 512 + lane * 8 + 4) = (f32x4){qn[4], qn[5], qn[6], qn[7]};
#pragma unroll
            for (int half = 0; half < 2; ++half) {
                const int cc = half * 512 + lane * 8;
                float xm[8], x0[8], xp[8]; unpack8(ch_[6 + 3 * half], xm); unpack8(ch_[6 + 3 * half + 1], x0); unpack8(ch_[6 + 3 * half + 2], xp);
                float y[8];
#pragma unroll
                for (int e = 0; e < 8; ++e) y[e] = silu(xm[e] * cwv[half][0][e] + x0[e] * cwv[half][1][e] + xp[e] * cwv[half][2][e]);
                *(f32x4*)(DNV + (size_t)r * 1024 + cc) = (f32x4){y[0], y[1], y[2], y[3]}; *(f32x4*)(DNV + (size_t)r * 1024 + cc + 4) = (f32x4){y[4], y[5], y[6], y[7]};
            }
            {
                const int hd = lane & 7, dir = (lane >> 3) & 1;
                const float qkh = __shfl(qk, 16 * (hd >> 1));
                if (lane < 16) {
                    const float araw = bf1(cga), braw = bf1(cgb);
                    const float xx = araw + P.in[21][(l * 2 + dir) * 8 + hd];
                    float sp; if (xx > 15.f) sp = xx; else { const float e = __expf(xx); sp = (e < 1e-3f) ? e * (1.f - e * (0.5f - e * (1.f / 3.f))) : __logf(1.f + e); }
                    const float gg = -__expf(P.in[20][(l * 2 + dir) * 8 + hd]) * sp;
                    *(f32x4*)(DNS + ((size_t)r * 16 + dir * 8 + hd) * 4) = (f32x4){__expf(gg), sigm(braw), qkh, gg};
                }
            }
#pragma unroll
            for (int i = 0; i < 12; ++i) ch_[i] = nh_[i];
            cga = nga; cgb = ngb; r = rn_;
        }
#undef DNP_LOAD
    }
    {
        LAS float* L = (LAS float*)lds;
        unsigned* ZT = (unsigned*)(ws + WS_ZT);
#define HYP_LOAD(hv_, item_) do { const int ti_ = (item_) / 48, ct_ = (item_) - ti_ * 48; \
            _Pragma("unroll") for (int u = 0; u < 2; ++u) { const int rowi = (tid >> 3) + 64 * u, bb = rowi >> 6, tt = rowi & 63, ch8 = tid & 7; \
                hv_[u] = *(const u32x4*)(H + ((size_t)bb * TPB + CTX + ti_ * 64 + tt) * NPAD + C_HY + ct_ * 64 + ch8 * 8); } } while (0)
        u32x4 chv[2] = {(u32x4){0u, 0u, 0u, 0u}, (u32x4){0u, 0u, 0u, 0u}};
        if ((int)blockIdx.x < 64 * 48) HYP_LOAD(chv, blockIdx.x);
#pragma unroll 1
        for (int item = blockIdx.x; item < 64 * 48; item += G) {
            const int ti = item / 48, ct = item - ti * 48;
            u32x4 nhv[2] = {(u32x4){0u, 0u, 0u, 0u}, (u32x4){0u, 0u, 0u, 0u}};
            if (item + G < 64 * 48) HYP_LOAD(nhv, item + G);
#pragma unroll
            for (int u = 0; u < 2; ++u) { const int rowi = (tid >> 3) + 64 * u, bb = rowi >> 6, tt = rowi & 63, ch8 = tid & 7;
                float f[8]; unpack8(chv[u], f);
#pragma unroll
                for (int e = 0; e < 8; ++e) L[(bb * 64 + tt) * 65 + ch8 * 8 + e] = f[e]; }
            asm volatile("s_waitcnt lgkmcnt(0)" ::: "memory"); __builtin_amdgcn_s_barrier(); asm volatile("" ::: "memory");
            { const int tt = tid & 63;
#pragma unroll
              for (int u = 0; u < 8; ++u) { const int cc = (tid >> 6) + 8 * u, ch = ct * 64 + cc;
                const float* cw = P.in[7] + (size_t)l * 3 * 3072 + ch; const float w0 = cw[0], w1 = cw[3072], w2 = cw[6144], bias = P.in[8][l * 3072 + ch];
                f32x2 o;
#pragma unroll
                for (int bb = 0; bb < 2; ++bb) { const LAS float* lp = L + (bb * 64 + tt) * 65 + cc;
                    const float xm = tt > 0 ? lp[-65] : 0.f, xp = tt < 63 ? lp[65] : 0.f; o[bb] = xm * w0 + lp[0] * w1 + xp * w2 + bias; }
                ZT[(size_t)ch * 4096 + ti * 64 + tt] = pk2(o[0], o[1]); } }
            asm volatile("s_waitcnt lgkmcnt(0)" ::: "memory"); __builtin_amdgcn_s_barrier(); asm volatile("" ::: "memory");
            chv[0] = nhv[0]; chv[1] = nhv[1];
        }
#undef HYP_LOAD
    }
    if (l == 0) {
        float* ZC = (float*)(ws + WS_ZC);
        const u32x4 z4 = {0u, 0u, 0u, 0u};
        for (int i8 = blockIdx.x * NTHR + tid; i8 < 2 * 256 * 384; i8 += G * NTHR) {
            const int ch = (i8 % 384) * 8, bt = i8 / 384, t = bt & 255, bb = bt >> 8;
            const bf16_t* hp = H + ((size_t)bb * TPB + t) * NPAD + C_HY + ch;
            float xm[8], x0[8], xp[8]; unpack8(t > 0 ? *(const u32x4*)(hp - NPAD) : z4, xm); unpack8(*(const u32x4*)hp, x0); unpack8(t < 255 ? *(const u32x4*)(hp + NPAD) : z4, xp);
            const float* cw = P.in[7] + ch; const float* cb = P.in[8] + ch;
            float y[8];
#pragma unroll
            for (int e = 0; e < 8; ++e) y[e] = xm[e] * cw[e] + x0[e] * cw[3072 + e] + xp[e] * cw[6144 + e] + cb[e];
            float* zp = ZC + (size_t)bt * 3072 + ch;
            *(f32x4*)zp = (f32x4){y[0], y[1], y[2], y[3]}; *(f32x4*)(zp + 4) = (f32x4){y[4], y[5], y[6], y[7]};
        }
    }
}

__device__ __forceinline__ void chunkprep_phase(const Params& P, LAS unsigned char* lds) {
    const int tid = otid(), lane = tid & 63, wave = tid >> 6, t = lane & 15, kq = lane >> 4;
    const int gw = blockIdx.x * NWAVES + wave, NGW = gridDim.x * NWAVES;
    unsigned char* ws = P.ws;
    const float* DNK = (const float*)(ws + WS_DN + OFF_DNK); const float* DNQ = (const float*)(ws + WS_DN + OFF_DNQ); const float* DNS = (const float*)(ws + WS_DN + OFF_DNS);
    LAS float* Kf = (LAS float*)(lds + wave * 16384);
    LAS bf16_t* Wb = (LAS bf16_t*)(Kf + 16 * 132);
    LAS float* Am = (LAS float*)(Wb + 16 * 136);
    LAS float* St = Am + 256;
    LAS float* Tt = St + 272;
    LAS float* be = Tt + 272;
#pragma unroll 1
    for (int task = gw; task < NTASK; task += NGW) {
        const int c = task % NCHUNK, grp = task / NCHUNK, dir = grp & 1, h = (grp >> 1) & 7, b = grp >> 4;
        const int n0 = c * 16, plo = dir ? (n0 < 256 ? 240 - n0 : TPB + 240 - n0) : n0;
        const size_t prow = (size_t)b * TPB + (dir ? plo + 15 - t : plo + t);
        const float* kp = DNK + prow * 512 + (h >> 1) * 128 + 4 * kq; const float* qp = DNQ + prow * 512 + (h >> 1) * 128 + 4 * kq;
        f32x4 ka[4], kb[4], qa[4], qb[4];
#pragma unroll
        for (int j = 0; j < 4; ++j) { ka[j] = *(const f32x4*)(kp + 32 * j); kb[j] = *(const f32x4*)(kp + 32 * j + 16); qa[j] = *(const f32x4*)(qp + 32 * j); qb[j] = *(const f32x4*)(qp + 32 * j + 16); }
        const f32x4 sc = *(const f32x4*)(DNS + (prow * 16 + dir * 8 + h) * 4);
        const float beta = sc[1];
        float gc = sc[3];
        gc += dppf<0x111>(gc); gc += dppf<0x112>(gc); gc += dppf<0x114>(gc); gc += dppf<0x118>(gc);
        const float gC = __shfl(gc, 15);
        const float egc = __expf(gc);
#pragma unroll
        for (int j = 0; j < 4; ++j) { *(LAS f32x4*)(Kf + t * 132 + 32 * j + 4 * kq) = ka[j]; *(LAS f32x4*)(Kf + t * 132 + 32 * j + 16 + 4 * kq) = kb[j]; }
        if (kq == 0) be[t] = beta * egc;
        f32x4 KK = {0.f, 0.f, 0.f, 0.f}, QK = KK;
#pragma unroll
        for (int j = 0; j < 4; ++j) {
            float kv[8] = {ka[j][0], ka[j][1], ka[j][2], ka[j][3], kb[j][0], kb[j][1], kb[j][2], kb[j][3]};
            float qv[8] = {qa[j][0], qa[j][1], qa[j][2], qa[j][3], qb[j][0], qb[j][1], qb[j][2], qb[j][3]};
            u32x4 kh, kl, qh, ql;
#pragma unroll
            for (int e = 0; e < 4; ++e) { const unsigned hh = pk2n(kv[2 * e], kv[2 * e + 1]); kh[e] = hh; kl[e] = pk2n(kv[2 * e] - bflo(hh), kv[2 * e + 1] - bfhi(hh));
                const unsigned gh = pk2n(qv[2 * e], qv[2 * e + 1]); qh[e] = gh; ql[e] = pk2n(qv[2 * e] - bflo(gh), qv[2 * e + 1] - bfhi(gh)); }
            const bf16x8 Kh = __builtin_bit_cast(bf16x8, kh), Kl = __builtin_bit_cast(bf16x8, kl), Qh = __builtin_bit_cast(bf16x8, qh), Ql = __builtin_bit_cast(bf16x8, ql);
            KK = __builtin_amdgcn_mfma_f32_16x16x32_bf16(Kh, Kh, KK, 0, 0, 0); KK = __builtin_amdgcn_mfma_f32_16x16x32_bf16(Kh, Kl, KK, 0, 0, 0); KK = __builtin_amdgcn_mfma_f32_16x16x32_bf16(Kl, Kh, KK, 0, 0, 0);
            QK = __builtin_amdgcn_mfma_f32_16x16x32_bf16(Qh, Kh, QK, 0, 0, 0); QK = __builtin_amdgcn_mfma_f32_16x16x32_bf16(Qh, Kl, QK, 0, 0, 0); QK = __builtin_amdgcn_mfma_f32_16x16x32_bf16(Ql, Kh, QK, 0, 0, 0);
            u32x4 fq; fq[0] = pk2n(qv[0] * egc, qv[1] * egc); fq[1] = pk2n(qv[2] * egc, qv[3] * egc); fq[2] = pk2n(qv[4] * egc, qv[5] * egc); fq[3] = pk2n(qv[6] * egc, qv[7] * egc);
            *(u32x4*)(ws + WS_CP1 + (size_t)task * CP1_STRIDE + 4096 + (size_t)(j * 64 + lane) * 16) = fq;
        }
#pragma unroll
        for (int e = 0; e < 4; ++e) { const int tp = 4 * kq + e; const float gct = __shfl(gc, tp), bt = __shfl(beta, tp);
            const float dec = __expf(fminf(gct - gc, 0.f));
            Am[tp * 16 + t] = (t < tp) ? bt * KK[e] * dec : 0.f;
            St[tp * 17 + t] = (t <= tp) ? QK[e] * dec : 0.f; }
        LDS_WAIT();
        {
            u32x2 fa; fa[0] = pk2n(St[t * 17 + 4 * kq], St[t * 17 + 4 * kq + 1]); fa[1] = pk2n(St[t * 17 + 4 * kq + 2], St[t * 17 + 4 * kq + 3]);
            *(u32x2*)(ws + WS_CP2 + (size_t)task * CP2_STRIDE + (size_t)lane * 8) = fa;
            float ds[4];
#pragma unroll
            for (int e = 0; e < 4; ++e) ds[e] = __expf(gC - __shfl(gc, 4 * kq + e));
#pragma unroll
            for (int m = 0; m < 8; ++m) { u32x2 fk;
                fk[0] = pk2n(Kf[(4 * kq + 0) * 132 + 16 * m + t] * ds[0], Kf[(4 * kq + 1) * 132 + 16 * m + t] * ds[1]);
                fk[1] = pk2n(Kf[(4 * kq + 2) * 132 + 16 * m + t] * ds[2], Kf[(4 * kq + 3) * 132 + 16 * m + t] * ds[3]);
                *(u32x2*)(ws + WS_CPK + (size_t)task * 4096 + (size_t)(m * 64 + lane) * 8) = fk; }
        }
#pragma unroll 1
        for (int pass = 0; pass < 3; ++pass) {
            if (pass < 2 || lane < 16) {
                const int col = (pass & 1) * 64 + lane;
                float x[16];
#pragma unroll
                for (int tt = 0; tt < 16; ++tt) {
                    float acc = (pass < 2) ? be[tt] * Kf[tt * 132 + col] : ((tt == lane) ? 1.f : 0.f);
#pragma unroll
                    for (int s = 0; s < tt; ++s) acc -= Am[tt * 16 + s] * x[s];
                    x[tt] = acc;
                    if (pass < 2) Wb[tt * 136 + col] = (bf16_t)(pk2n(acc, 0.f) & 0xffffu); else Tt[tt * 17 + lane] = acc; }
            }
        }
        LDS_WAIT();
        {
#pragma unroll
            for (int j = 0; j < 4; ++j) { const u32x2 lo = *(const LAS u32x2*)(Wb + t * 136 + 32 * j + 4 * kq), hi = *(const LAS u32x2*)(Wb + t * 136 + 32 * j + 16 + 4 * kq);
                *(u32x4*)(ws + WS_CP1 + (size_t)task * CP1_STRIDE + (size_t)(j * 64 + lane) * 16) = (u32x4){lo[0], lo[1], hi[0], hi[1]}; }
            u32x2 ft; ft[0] = pk2n(Tt[t * 17 + 4 * kq], Tt[t * 17 + 4 * kq + 1]); ft[1] = pk2n(Tt[t * 17 + 4 * kq + 2], Tt[t * 17 + 4 * kq + 3]);
            *(u32x2*)(ws + WS_CP2 + (size_t)task * CP2_STRIDE + 512 + (size_t)lane * 8) = ft;
            float* misc = (float*)(ws + WS_CP2 + (size_t)task * CP2_STRIDE + 1024);
            if (lane < 16) misc[lane] = beta; else if (lane == 16) misc[16] = __expf(gC);
        }
        LDS_WAIT();
    }
}

__device__ __forceinline__ void hgprep_phase(const Params& P, int l, LAS unsigned char* lds) {
    const int tid = otid(), lane = tid & 63, wave = tid >> 6, t = lane & 15, kq = lane >> 4;
    const int gw = blockIdx.x * NWAVES + wave, NGW = gridDim.x * NWAVES;
    unsigned char* ws = P.ws;
    const bf16_t* H = (const bf16_t*)(ws + WS_H);
    LAS float* Kf = (LAS float*)(lds + wave * 16384);
    LAS float* St = Kf + 16 * 132;
#pragma unroll 1
    for (int task = gw; task < NTASK; task += NGW) {
        const int c = task % NCHUNK, grp = task / NCHUNK, dir = grp & 1, h = (grp >> 1) & 7, b = grp >> 4;
        const int n0 = c * 16, plo = dir ? (n0 < 256 ? 240 - n0 : TPB + 240 - n0) : n0;
        const size_t prow = (size_t)b * TPB + (dir ? plo + 15 - t : plo + t);
        const bf16_t* hp = H + prow * NPAD + h * 128 + 4 * kq;
        const float* lbp = (const float*)(ws + WS_LB) + ((size_t)l * 2 + dir) * 1024 + h * 128 + 4 * kq;
        float L[32], kk[32], q[32];
#pragma unroll
        for (int j = 0; j < 4; ++j)
#pragma unroll
            for (int hh = 0; hh < 2; ++hh) { const int ko = 32 * j + 16 * hh;
                const u32x2 fr = *(const u32x2*)(hp + (dir ? C_HGFB : C_HGFF) + ko), qr = *(const u32x2*)(hp + C_HGQ + ko); const f32x4 lb = *(const f32x4*)(lbp + ko);
                const float fx[4] = {bflo(fr[0]), bfhi(fr[0]), bflo(fr[1]), bfhi(fr[1])}, qx[4] = {bflo(qr[0]), bfhi(qr[0]), bflo(qr[1]), bfhi(qr[1])};
#pragma unroll
                for (int e = 0; e < 4; ++e) { const int ix = 8 * j + 4 * hh + e; const float f = lb[e] + (1.f - lb[e]) * sigm(fx[e]);
                    L[ix] = __logf(fmaxf(f, 1e-30f)); kk[ix] = 1.f - f; q[ix] = silu(qx[e]); } }
        float Lt15[32];
#pragma unroll
        for (int ix = 0; ix < 32; ++ix) { float x = L[ix]; Lt15[ix] = row_sum16(x); x += dppf<0x111>(x); x += dppf<0x112>(x); x += dppf<0x114>(x); x += dppf<0x118>(x); L[ix] = x; }
        f32x4 Att = {0.f, 0.f, 0.f, 0.f};
#pragma unroll
        for (int j = 0; j < 4; ++j) {
            u32x4 fqv, qp, kp; float khat[8];
#pragma unroll
            for (int e2 = 0; e2 < 4; ++e2) {
                float qt[2], qq[2], kx[2];
#pragma unroll
                for (int z = 0; z < 2; ++z) { const int ix = 8 * j + 2 * e2 + z; const float Lt = L[ix];
                    const float L15 = Lt15[ix];
                    qt[z] = q[ix] * __expf(Lt);
                    const float d = fminf(Lt - L15, 80.f);
                    qq[z] = q[ix] * __expf(d); kx[z] = kk[ix] * __expf(-d);
                    khat[2 * e2 + z] = kx[z];
                    if (t == 15) ((float*)(ws + WS_HGA + (size_t)task * 1024 + 512))[32 * j + 16 * ((2 * e2 + z) >> 2) + 4 * kq + ((2 * e2 + z) & 3)] = __expf(Lt); }
                fqv[e2] = pk2n(qt[0], qt[1]); qp[e2] = pk2n(qq[0], qq[1]); kp[e2] = pk2n(kx[0], kx[1]); }
            *(u32x4*)(ws + WS_HGQ + (size_t)task * 4096 + (size_t)(j * 64 + lane) * 16) = fqv;
            Att = __builtin_amdgcn_mfma_f32_16x16x32_bf16(__builtin_bit_cast(bf16x8, qp), __builtin_bit_cast(bf16x8, kp), Att, 0, 0, 0);
            *(LAS f32x4*)(Kf + t * 132 + 32 * j + 4 * kq) = (f32x4){khat[0], khat[1], khat[2], khat[3]};
            *(LAS f32x4*)(Kf + t * 132 + 32 * j + 16 + 4 * kq) = (f32x4){khat[4], khat[5], khat[6], khat[7]};
        }
#pragma unroll
        for (int e = 0; e < 4; ++e) { const int tp = 4 * kq + e; St[tp * 17 + t] = (t <= tp) ? Att[e] : 0.f; }
        LDS_WAIT();
        { u32x2 fa; fa[0] = pk2n(St[t * 17 + 4 * kq], St[t * 17 + 4 * kq + 1]); fa[1] = pk2n(St[t * 17 + 4 * kq + 2], St[t * 17 + 4 * kq + 3]);
          *(u32x2*)(ws + WS_HGA + (size_t)task * 1024 + (size_t)lane * 8) = fa;
#pragma unroll
          for (int m = 0; m < 8; ++m) { u32x2 fk;
              fk[0] = pk2n(Kf[(4 * kq + 0) * 132 + 16 * m + t], Kf[(4 * kq + 1) * 132 + 16 * m + t]);
              fk[1] = pk2n(Kf[(4 * kq + 2) * 132 + 16 * m + t], Kf[(4 * kq + 3) * 132 + 16 * m + t]);
              *(u32x2*)(ws + WS_HGK + (size_t)task * 4096 + (size_t)(m * 64 + lane) * 8) = fk; } }
        LDS_WAIT();
    }
}

constexpr int T32_IN = 32 * 545, T32_BR = 16 * 64, T32_OUT = 32 * 64, T32_F1 = 32 * 256, T32_F2 = 128 * 64, T32_PER = T32_IN + 3 * T32_BR + T32_OUT + T32_F1 + T32_F2;
struct TItem { const float* W; bf16_t* WT; int K, N, k0, n0; };
__device__ __forceinline__ TItem titem_decode(const Params& P, int l, int r) {
    unsigned char* ws = P.ws; TItem t; int item;
    if (r < T32_IN) { t.W = P.in[6] + (size_t)l * D * INC; t.K = D; t.N = INC; t.WT = (bf16_t*)(ws + WS_WIN + (size_t)l * SZ_WIN); item = r; }
    else if ((r -= T32_IN) < 3 * T32_BR) { const int g = r / T32_BR; t.W = P.in[23] + (size_t)(l * 3 + g) * 1024 * D; t.K = 1024; t.N = D; t.WT = (bf16_t*)(ws + WS_WBR + (size_t)(l * 3 + g) * SZ_WBR); item = r - g * T32_BR; }
    else if ((r -= 3 * T32_BR) < T32_OUT) { t.W = P.in[24] + (size_t)l * D * D; t.K = D; t.N = D; t.WT = (bf16_t*)(ws + WS_WOUT + (size_t)l * SZ_WOUT); item = r; }
    else if ((r -= T32_OUT) < T32_F1) { t.W = P.in[27] + (size_t)l * D * DFF; t.K = D; t.N = DFF; t.WT = (bf16_t*)(ws + WS_WFF1 + (size_t)l * SZ_WFF); item = r; }
    else { r -= T32_F1; t.W = P.in[28] + (size_t)l * DFF * D; t.K = DFF; t.N = D; t.WT = (bf16_t*)(ws + WS_WFF2 + (size_t)l * SZ_WFF); item = r; }
    const int nblk = t.N / 32, kb = item / nblk, nb = item - kb * nblk; t.k0 = 64 * kb; t.n0 = 32 * nb;
    return t;
}
#define TSTAGE1(wv, ti) do { const TItem t_ = titem_decode(P, DEPTH - 1, (ti)); const float* wp_ = t_.W + (size_t)(t_.k0 + (lane >> 5)) * t_.N + t_.n0 + (lane & 31); \
    _Pragma("unroll") for (int i_ = 0; i_ < 32; ++i_) wv[i_] = __builtin_nontemporal_load(wp_ + (size_t)(2 * i_) * t_.N); } while (0)
#define TSTAGE2(wv, ti, scr) do { const TItem t_ = titem_decode(P, DEPTH - 1, (ti)); \
    _Pragma("unroll") for (int i_ = 0; i_ < 32; ++i_) (scr)[(2 * i_ + (lane >> 5)) * 33 + (lane & 31)] = wv[i_]; \
    LDS_WAIT(); \
    { const int c_ = lane & 7; _Pragma("unroll") for (int j_ = 0; j_ < 4; ++j_) { const int n_ = (lane >> 3) + 8 * j_; const LAS float* s_ = (scr) + (8 * c_) * 33 + n_; \
        u32x4 o_; o_.x = pk2(s_[0 * 33], s_[1 * 33]); o_.y = pk2(s_[2 * 33], s_[3 * 33]); o_.z = pk2(s_[4 * 33], s_[5 * 33]); o_.w = pk2(s_[6 * 33], s_[7 * 33]); \
        *(u32x4*)(t_.WT + (size_t)(t_.n0 + n_) * t_.K + t_.k0 + 8 * c_) = o_; } } \
    LDS_WAIT(); } while (0)

#define SCAN_BAR() do { asm volatile("s_waitcnt lgkmcnt(0)" ::: "memory"); __builtin_amdgcn_s_barrier(); asm volatile("" ::: "memory"); } while (0)
__device__ __forceinline__ void scan_phase(const Params& P, int l, LAS unsigned char* lds) {
    const int tid = otid(), wid = __builtin_amdgcn_readfirstlane(tid >> 6), lane = tid & 63, col = lane & 15, quad = lane >> 4;
    unsigned char* ws = P.ws;
    const bf16_t* H = (const bf16_t*)(ws + WS_H);
    const float* DNV = (const float*)(ws + WS_DN + OFF_DNV);
    constexpr int TS = 16, NT = NCHUNK;
    constexpr int SLOT = 25856, HGO = 15616;
    const f32x4 zero4 = {0.f, 0.f, 0.f, 0.f};
    for (int vb = blockIdx.x; vb < 256; vb += gridDim.x) {
        const int xcd = vb & 7, idx = vb >> 3, grp = xcd * 4 + (idx >> 3), sub = idx & 7;
        const int b = grp >> 4, h = (grp >> 1) & 7, dir = grp & 1, col0 = sub * 16;
        const size_t rowbase = (size_t)b * TPB;
        if (wid == 0) {
            bf16_t* Odn = (bf16_t*)(ws + WS_SO + (size_t)(2 + dir) * SZ_SOB);
            f32x4 St[8];
#pragma unroll
            for (int m = 0; m < 8; ++m) St[m] = zero4;
#pragma unroll 1
            for (int it = -4; it < NT; ++it) {
                if (it >= 0) {
                    const LAS unsigned char* sl = lds + (it & 1) * SLOT;
                    const int n0 = it * TS; const int plo = dir ? (n0 < 256 ? 256 - TS - n0 : TPB + 256 - TS - n0) : n0;
                    u32x4 fw[4], fq[4]; u32x2 fk[8];
#pragma unroll
                    for (int j = 0; j < 4; ++j) { fw[j] = *(const LAS u32x4*)(sl + (j * 64 + lane) * 16); fq[j] = *(const LAS u32x4*)(sl + 4096 + (j * 64 + lane) * 16); }
#pragma unroll
                    for (int m = 0; m < 8; ++m) fk[m] = *(const LAS u32x2*)(sl + 8192 + (m * 64 + lane) * 8);
                    const u32x2 fa = *(const LAS u32x2*)(sl + 12288 + lane * 8), ft = *(const LAS u32x2*)(sl + 12800 + lane * 8);
                    const f32x4 b4 = *(const LAS f32x4*)(sl + 13312 + lane * 16), v4 = *(const LAS f32x4*)(sl + 14336 + lane * 16);
                    const float egC = *(const LAS float*)(sl + 15360);
                    bf16x8 sf[4];
#pragma unroll
                    for (int j = 0; j < 4; ++j) sf[j] = __builtin_bit_cast(bf16x8, (u32x4){pk2n(St[2 * j][0], St[2 * j][1]), pk2n(St[2 * j][2], St[2 * j][3]), pk2n(St[2 * j + 1][0], St[2 * j + 1][1]), pk2n(St[2 * j + 1][2], St[2 * j + 1][3])});
                    const bf16x8 bv = __builtin_bit_cast(bf16x8, (u32x4){pk2n(b4[0] * v4[0], b4[1] * v4[1]), pk2n(b4[2] * v4[2], b4[3] * v4[3]), 0u, 0u});
                    const bf16x8 FT8 = __builtin_bit_cast(bf16x8, (u32x4){ft[0], ft[1], 0u, 0u}), FA8 = __builtin_bit_cast(bf16x8, (u32x4){fa[0], fa[1], 0u, 0u});
                    const f32x4 U = __builtin_amdgcn_mfma_f32_16x16x32_bf16(FT8, bv, zero4, 0, 0, 0);
                    f32x4 Pw = zero4, O = zero4;
#pragma unroll
                    for (int j = 0; j < 4; ++j) { Pw = __builtin_amdgcn_mfma_f32_16x16x32_bf16(__builtin_bit_cast(bf16x8, fw[j]), sf[j], Pw, 0, 0, 0);
                        O = __builtin_amdgcn_mfma_f32_16x16x32_bf16(__builtin_bit_cast(bf16x8, fq[j]), sf[j], O, 0, 0, 0); }
                    const f32x4 Vn = U - Pw;
                    const bf16x8 vn8 = __builtin_bit_cast(bf16x8, (u32x4){pk2n(Vn[0], Vn[1]), pk2n(Vn[2], Vn[3]), 0u, 0u});
                    O = __builtin_amdgcn_mfma_f32_16x16x32_bf16(FA8, vn8, O, 0, 0, 0);
#pragma unroll
                    for (int m = 0; m < 8; ++m) St[m] = __builtin_amdgcn_mfma_f32_16x16x32_bf16(__builtin_bit_cast(bf16x8, (u32x4){fk[m][0], fk[m][1], 0u, 0u}), vn8, St[m] * egC, 0, 0, 0);
#pragma unroll
                    for (int e = 0; e < 4; ++e) { const int t = 4 * quad + e; const int p = dir ? plo + TS - 1 - t : plo + t;
                        Odn[(rowbase + p) * 1024 + h * 128 + col0 + col] = (bf16_t)(pk2n(O[e], 0.f) & 0xffffu); }
                }
                SCAN_BAR();
            }
        } else if (wid == 1) {
            bf16_t* Ohg = (bf16_t*)(ws + WS_SO + (size_t)dir * SZ_SOB);
            f32x4 St[8];
#pragma unroll
            for (int m = 0; m < 8; ++m) St[m] = zero4;
#pragma unroll 1
            for (int it = -4; it < NT; ++it) {
                if (it >= 0) {
                    const LAS unsigned char* sl = lds + (it & 1) * SLOT + HGO;
                    const int n0 = it * TS; const int plo = dir ? (n0 < 256 ? 256 - TS - n0 : TPB + 256 - TS - n0) : n0;
                    u32x4 fq[4]; u32x2 fk[8]; f32x4 p15[8];
#pragma unroll
                    for (int j = 0; j < 4; ++j) fq[j] = *(const LAS u32x4*)(sl + (j * 64 + lane) * 16);
#pragma unroll
                    for (int m = 0; m < 8; ++m) { fk[m] = *(const LAS u32x2*)(sl + 4096 + (m * 64 + lane) * 8); p15[m] = *(const LAS f32x4*)(sl + 8704 + (16 * m + 4 * quad) * 4); }
                    const u32x2 fa = *(const LAS u32x2*)(sl + 8192 + lane * 8); const f32x4 v4 = *(const LAS f32x4*)(sl + 9216 + lane * 16);
                    bf16x8 sf[4];
#pragma unroll
                    for (int j = 0; j < 4; ++j) sf[j] = __builtin_bit_cast(bf16x8, (u32x4){pk2n(St[2 * j][0], St[2 * j][1]), pk2n(St[2 * j][2], St[2 * j][3]), pk2n(St[2 * j + 1][0], St[2 * j + 1][1]), pk2n(St[2 * j + 1][2], St[2 * j + 1][3])});
                    const bf16x8 bv = __builtin_bit_cast(bf16x8, (u32x4){pk2n(v4[0], v4[1]), pk2n(v4[2], v4[3]), 0u, 0u});
                    const bf16x8 FA8 = __builtin_bit_cast(bf16x8, (u32x4){fa[0], fa[1], 0u, 0u});
                    f32x4 O = __builtin_amdgcn_mfma_f32_16x16x32_bf16(FA8, bv, zero4, 0, 0, 0);
#pragma unroll
                    for (int j = 0; j < 4; ++j) O = __builtin_amdgcn_mfma_f32_16x16x32_bf16(__builtin_bit_cast(bf16x8, fq[j]), sf[j], O, 0, 0, 0);
#pragma unroll
                    for (int m = 0; m < 8; ++m) St[m] = __builtin_amdgcn_mfma_f32_16x16x32_bf16(__builtin_bit_cast(bf16x8, (u32x4){fk[m][0], fk[m][1], 0u, 0u}), bv, St[m] * p15[m], 0, 0, 0);
#pragma unroll
                    for (int e = 0; e < 4; ++e) { const int t = 4 * quad + e; const int p = dir ? plo + TS - 1 - t : plo + t;
                        Ohg[(rowbase + p) * 1024 + h * 128 + col0 + col] = (bf16_t)(pk2n(O[e], 0.f) & 0xffffu); }
                }
                SCAN_BAR();
            }
        } else if (wid < 5) {
            const int k = wid - 2;
            u32x4 fw[4], fq[4]; u32x2 fk[8], fa, ft; f32x4 b4, v4; float egC = 0.f;
#pragma unroll
            for (int j = 0; j < 4; ++j) { fw[j] = (u32x4){0u, 0u, 0u, 0u}; fq[j] = fw[j]; }
#pragma unroll
            for (int m = 0; m < 8; ++m) fk[m] = (u32x2){0u, 0u};
            fa = (u32x2){0u, 0u}; ft = fa; b4 = zero4; v4 = zero4;
            float twv[32]; int tn = 0; bool thave = false; const int tlw = blockIdx.x * 6 + (wid - 2), TNLW = gridDim.x * 6; LAS float* tscr = (LAS float*)(lds + 2 * SLOT + (wid - 2) * 8448);
#pragma unroll
            for (int i_ = 0; i_ < 32; ++i_) twv[i_] = 0.f;
#pragma unroll 1
            for (int it = -4; it < NT; ++it) {
                if ((it + 4) % 3 == k) {
                    const int jw = it + 1, jl = it + 4;
                    if (jw >= 0 && jw < NT) {
                        LAS unsigned char* sl = lds + (jw & 1) * SLOT;
#pragma unroll
                        for (int j = 0; j < 4; ++j) { *(LAS u32x4*)(sl + (j * 64 + lane) * 16) = fw[j]; *(LAS u32x4*)(sl + 4096 + (j * 64 + lane) * 16) = fq[j]; }
#pragma unroll
                        for (int m = 0; m < 8; ++m) *(LAS u32x2*)(sl + 8192 + (m * 64 + lane) * 8) = fk[m];
                        *(LAS u32x2*)(sl + 12288 + lane * 8) = fa; *(LAS u32x2*)(sl + 12800 + lane * 8) = ft;
                        *(LAS f32x4*)(sl + 13312 + lane * 16) = b4; *(LAS f32x4*)(sl + 14336 + lane * 16) = v4;
                        if (lane == 0) *(LAS float*)(sl + 15360) = egC;
                    }
                    if (jl < NT) {
                        const int n0 = jl * TS; const int plo = dir ? (n0 < 256 ? 256 - TS - n0 : TPB + 256 - TS - n0) : n0;
                        const size_t task = (size_t)grp * NCHUNK + jl;
                        const unsigned char* c1 = ws + WS_CP1 + task * CP1_STRIDE; const unsigned char* ck = ws + WS_CPK + task * 4096; const unsigned char* c2 = ws + WS_CP2 + task * CP2_STRIDE;
#pragma unroll
                        for (int j = 0; j < 4; ++j) { fw[j] = *(const u32x4*)(c1 + (size_t)(j * 64 + lane) * 16); fq[j] = *(const u32x4*)(c1 + 4096 + (size_t)(j * 64 + lane) * 16); }
#pragma unroll
                        for (int m = 0; m < 8; ++m) fk[m] = *(const u32x2*)(ck + (size_t)(m * 64 + lane) * 8);
                        fa = *(const u32x2*)(c2 + (size_t)lane * 8); ft = *(const u32x2*)(c2 + 512 + (size_t)lane * 8);
                        b4 = *(const f32x4*)(c2 + 1024 + quad * 16); egC = *(const float*)(c2 + 1024 + 64);
#pragma unroll
                        for (int e = 0; e < 4; ++e) { const int s = 4 * quad + e; const int p = dir ? plo + TS - 1 - s : plo + s;
                            v4[e] = DNV[(rowbase + p) * 1024 + h * 128 + col0 + col]; }
                    }
                }
                if (l == 0) {
                    const int ti = tlw + TNLW * tn;
                    if (ti < T32_PER) {
                        if ((it + 4) % 3 == (k + 1) % 3) { TSTAGE1(twv, ti); thave = true; }
                        else if ((it + 4) % 3 == (k + 2) % 3 && thave) { TSTAGE2(twv, ti, tscr); ++tn; thave = false; }
                    }
                }
                SCAN_BAR();
            }
        } else {
            const int k = wid - 5;
            u32x4 fq[4]; u32x2 fk[8], fa; f32x4 p15 = zero4; bf16_t vr[4] = {0, 0, 0, 0};
#pragma unroll
            for (int j = 0; j < 4; ++j) fq[j] = (u32x4){0u, 0u, 0u, 0u};
#pragma unroll
            for (int m = 0; m < 8; ++m) fk[m] = (u32x2){0u, 0u};
            fa = (u32x2){0u, 0u};
            float twv[32]; int tn = 0; bool thave = false; const int tlw = blockIdx.x * 6 + (wid - 2), TNLW = gridDim.x * 6; LAS float* tscr = (LAS float*)(lds + 2 * SLOT + (wid - 2) * 8448);
#pragma unroll
            for (int i_ = 0; i_ < 32; ++i_) twv[i_] = 0.f;
#pragma unroll 1
            for (int it = -4; it < NT; ++it) {
                if ((it + 4) % 3 == k) {
                    const int jw = it + 1, jl = it + 4;
                    if (jw >= 0 && jw < NT) {
                        LAS unsigned char* sl = lds + (jw & 1) * SLOT + HGO;
#pragma unroll
                        for (int j = 0; j < 4; ++j) *(LAS u32x4*)(sl + (j * 64 + lane) * 16) = fq[j];
#pragma unroll
                        for (int m = 0; m < 8; ++m) *(LAS u32x2*)(sl + 4096 + (m * 64 + lane) * 8) = fk[m];
                        *(LAS u32x2*)(sl + 8192 + lane * 8) = fa;
                        if (lane < 32) *(LAS f32x4*)(sl + 8704 + lane * 16) = p15;
                        *(LAS f32x4*)(sl + 9216 + lane * 16) = (f32x4){bf1(vr[0]), bf1(vr[1]), bf1(vr[2]), bf1(vr[3])};
                    }
                    if (jl < NT) {
                        const int n0 = jl * TS; const int plo = dir ? (n0 < 256 ? 256 - TS - n0 : TPB + 256 - TS - n0) : n0;
                        const size_t task = (size_t)grp * NCHUNK + jl;
                        const unsigned char* cq = ws + WS_HGQ + task * 4096; const unsigned char* ck = ws + WS_HGK + task * 4096; const unsigned char* ca = ws + WS_HGA + task * 1024;
#pragma unroll
                        for (int j = 0; j < 4; ++j) fq[j] = *(const u32x4*)(cq + (size_t)(j * 64 + lane) * 16);
#pragma unroll
                        for (int m = 0; m < 8; ++m) fk[m] = *(const u32x2*)(ck + (size_t)(m * 64 + lane) * 8);
                        fa = *(const u32x2*)(ca + (size_t)lane * 8);
                        if (lane < 32) p15 = *(const f32x4*)(ca + 512 + (size_t)lane * 16);
#pragma unroll
                        for (int e = 0; e < 4; ++e) { const int s = 4 * quad + e; const int p = dir ? plo + TS - 1 - s : plo + s;
                            vr[e] = H[(rowbase + p) * NPAD + C_HGI + h * 128 + col0 + col]; }
                    }
                }
                if (l == 0) {
                    const int ti = tlw + TNLW * tn;
                    if (ti < T32_PER) {
                        if ((it + 4) % 3 == (k + 1) % 3) { TSTAGE1(twv, ti); thave = true; }
                        else if ((it + 4) % 3 == (k + 2) % 3 && thave) { TSTAGE2(twv, ti, tscr); ++tn; thave = false; }
                    }
                }
                SCAN_BAR();
            }
        }
    }
}

__device__ __forceinline__ f32x2 cmul(f32x2 a, f32x2 b) { return (f32x2){a.x * b.x - a.y * b.y, a.x * b.y + a.y * b.x}; }
__device__ __forceinline__ f32x2 cmulc(f32x2 a, f32x2 b) { return (f32x2){a.x * b.x + a.y * b.y, a.y * b.x - a.x * b.y}; }
#define PADI(i) ((i) + (((i) >> 5) << 1))
constexpr int FFT_PADN = 8192 + 512;
template <bool INV, int ST> __device__ __forceinline__ void fft_pass16(LAS f32x2* buf, int base, int bl) {
    constexpr float C16[8] = {1.f, 0.92387953251f, 0.70710678119f, 0.38268343237f, 0.f, -0.38268343237f, -0.70710678119f, -0.92387953251f};
    constexpr float S16[8] = {0.f, 0.38268343237f, 0.70710678119f, 0.92387953251f, 1.f, 0.92387953251f, 0.70710678119f, 0.38268343237f};
    f32x2 x[16];
    constexpr int STEP = (1 << ST) + ((1 << ST) >> 4);
    LAS f32x2* pb = buf + PADI(base);
#pragma unroll
    for (int d = 0; d < 16; ++d) x[d] = pb[d * STEP];
    const float th = (float)bl * (1.f / (float)(16 << ST));
    const f32x2 W1 = {__builtin_amdgcn_cosf(th), -__builtin_amdgcn_sinf(th)};
    const f32x2 W2 = cmul(W1, W1), W4 = cmul(W2, W2), W8 = cmul(W4, W4);
    if (!INV) {
#pragma unroll
        for (int d = 0; d < 8; ++d) { const f32x2 w = cmul(W1, (f32x2){C16[d], -S16[d]}); const f32x2 a = x[d], b = x[d + 8]; x[d] = a + b; x[d + 8] = cmul(a - b, w); }
#pragma unroll
        for (int g = 0; g < 16; g += 8)
#pragma unroll
            for (int dd = 0; dd < 4; ++dd) { const int d = g + dd; const f32x2 w = cmul(W2, (f32x2){C16[2 * dd], -S16[2 * dd]}); const f32x2 a = x[d], b = x[d + 4]; x[d] = a + b; x[d + 4] = cmul(a - b, w); }
#pragma unroll
        for (int g = 0; g < 16; g += 4)
#pragma unroll
            for (int dd = 0; dd < 2; ++dd) { const int d = g + dd; const f32x2 w = dd ? (f32x2){W4.y, -W4.x} : W4; const f32x2 a = x[d], b = x[d + 2]; x[d] = a + b; x[d + 2] = cmul(a - b, w); }
#pragma unroll
        for (int g = 0; g < 16; g += 2) { const f32x2 a = x[g], b = x[g + 1]; x[g] = a + b; x[g + 1] = cmul(a - b, W8); }
    } else {
#pragma unroll
        for (int g = 0; g < 16; g += 2) { const f32x2 a = x[g], b = cmulc(x[g + 1], W8); x[g] = a + b; x[g + 1] = a - b; }
#pragma unroll
        for (int g = 0; g < 16; g += 4)
#pragma unroll
            for (int dd = 0; dd < 2; ++dd) { const int d = g + dd; const f32x2 w = dd ? (f32x2){W4.y, -W4.x} : W4; const f32x2 a = x[d], b = cmulc(x[d + 2], w); x[d] = a + b; x[d + 2] = a - b; }
#pragma unroll
        for (int g = 0; g < 16; g += 8)
#pragma unroll
            for (int dd = 0; dd < 4; ++dd) { const int d = g + dd; const f32x2 w = cmul(W2, (f32x2){C16[2 * dd], -S16[2 * dd]}); const f32x2 a = x[d], b = cmulc(x[d + 4], w); x[d] = a + b; x[d + 4] = a - b; }
#pragma unroll
        for (int d = 0; d < 8; ++d) { const f32x2 w = cmul(W1, (f32x2){C16[d], -S16[d]}); const f32x2 a = x[d], b = cmulc(x[d + 8], w); x[d] = a + b; x[d + 8] = a - b; }
    }
#pragma unroll
    for (int d = 0; d < 16; ++d) pb[d * STEP] = x[d];
}
__device__ __forceinline__ void fft_fwd_abc(LAS f32x2* buf, int tid) {
    asm volatile("" : "+v"(tid));
    fft_pass16<false, 9>(buf, tid, tid); __syncthreads();
    fft_pass16<false, 5>(buf, ((tid >> 5) << 9) + (tid & 31), tid & 31); __syncthreads();
    fft_pass16<false, 1>(buf, ((tid >> 1) << 5) + (tid & 1), tid & 1); __syncthreads();
}
__device__ __forceinline__ void fft_inv_cba(LAS f32x2* buf, int tid) {
    asm volatile("" : "+v"(tid));
    fft_pass16<true, 1>(buf, ((tid >> 1) << 5) + (tid & 1), tid & 1); __syncthreads();
    fft_pass16<true, 5>(buf, ((tid >> 5) << 9) + (tid & 31), tid & 31); __syncthreads();
    fft_pass16<true, 9>(buf, tid, tid); __syncthreads();
}
__device__ __forceinline__ float hy_delta(int c) {
    const float a = -3.0701134573253944f, bq = -15.350567286626972f;
    return fabsf(a + (float)c * ((bq - a) / 1023.f));
}
__device__ __forceinline__ void hyena_phase(const Params& P, int l, LAS unsigned char* lds) {
    const int G = gridDim.x;
    unsigned char* ws = P.ws;
    const unsigned* ZT = (const unsigned*)(ws + WS_ZT);
    const float* HID = (const float*)(ws + WS_HID + (size_t)l * SZ_HID1);
    const float* w3 = P.in[13] + (size_t)l * 64 * 4096;
    const int nitems = 1024 + (l == 0 ? 128 : 0);
#pragma unroll 1
    for (int item = blockIdx.x; item < nitems; item += G) {
        const int tid = otid();
        if (item < 1024) {
            const int c = item;
            LAS f32x2* bufA = (LAS f32x2*)lds; LAS f32x2* bufB = bufA + FFT_PADN; LAS f32x4* w3s = (LAS f32x4*)(lds + 2 * FFT_PADN * 8);
            if (tid < 256) ((LAS float*)w3s)[tid] = w3[(size_t)(tid >> 2) * 4096 + ((tid >> 1) & 1) * 2048 + (tid & 1) * 1024 + c];
            __syncthreads();
            const float dl = hy_delta(c);
            {
                f32x4 hacc[8];
#pragma unroll
                for (int e = 0; e < 8; ++e) hacc[e] = (f32x4){0.f, 0.f, 0.f, 0.f};
#pragma unroll 16
                for (int j = 0; j < 64; ++j) { const f32x4 w = w3s[j]; const f32x4 h0 = *(const f32x4*)(HID + (size_t)j * 4096 + 4 * tid), h1 = *(const f32x4*)(HID + (size_t)j * 4096 + 2048 + 4 * tid);
#pragma unroll
                    for (int e = 0; e < 4; ++e) { hacc[e] += h0[e] * w; hacc[4 + e] += h1[e] * w; } }
#pragma unroll
                for (int e = 0; e < 8; ++e) { const int t = 4 * tid + (e & 3) + (e >> 2) * 2048; const float win = __expf(-((float)t * (1.f / 4095.f)) * dl);
                    bufB[PADI(4 * tid) + (e & 3) + (e >> 2) * 2176] = (f32x2){win * hacc[e][0], win * hacc[e][2]};
                    if (t >= 1) bufB[PADI(8192 - t)] = (f32x2){win * hacc[e][1], win * hacc[e][3]}; else bufB[PADI(4096)] = (f32x2){0.f, 0.f}; }
            }
            __syncthreads();
            fft_fwd_abc(bufB, tid);
#pragma unroll
            for (int u = 0; u < 8; ++u) { LAS f32x4* pp = (LAS f32x4*)(bufB + PADI(2 * tid) + 1088 * u); const f32x4 v = *pp;
                *pp = (f32x4){v[0] + v[2], v[1] + v[3], v[0] - v[2], v[1] - v[3]}; }
            f32x2 vv[8], y1[8];
#pragma unroll
            for (int u = 0; u < 8; ++u) { const int t = tid + 512 * u; { const unsigned w_ = ZT[(size_t)c * 4096 + t]; vv[u] = (f32x2){bflo(w_), bfhi(w_)}; } bufA[PADI(tid) + 544 * u] = vv[u]; bufA[PADI(tid) + 544 * u + 4352] = (f32x2){0.f, 0.f}; }
            __syncthreads();
#pragma unroll
            for (int ord = 0; ord < 2; ++ord) {
                fft_fwd_abc(bufA, tid);
#pragma unroll 2
                for (int u = 0; u < 8; ++u) { const int i0 = 2 * (tid + 512 * u); LAS f32x4* pp = (LAS f32x4*)(bufA + PADI(2 * tid) + 1088 * u); const f32x4 v = *pp;
                    f32x2 xs[2] = {(f32x2){v[0] + v[2], v[1] + v[3]}, (f32x2){v[0] - v[2], v[1] - v[3]}};
                    const f32x4 zz = *(const LAS f32x4*)(bufB + PADI(2 * tid) + 1088 * u);
#pragma unroll
                    for (int q = 0; q < 2; ++q) { const unsigned f = __brev((unsigned)(i0 + q)) >> 19, fp = (8192u - f) & 8191u, ip = __brev(fp) >> 19;
                        const f32x2 Z = q ? (f32x2){zz[2], zz[3]} : (f32x2){zz[0], zz[1]}; const f32x2 Zp = bufB[PADI((int)ip)]; f32x2 Kf;
                        if (ord == 0) Kf = (f32x2){Z.x + Zp.x, Z.y - Zp.y}; else Kf = (f32x2){Z.y + Zp.y, Zp.x - Z.x};
                        Kf *= (0.5f / 8192.f);
                        xs[q] = cmul(xs[q], Kf); }
                    *pp = (f32x4){xs[0].x + xs[1].x, xs[0].y + xs[1].y, xs[0].x - xs[1].x, xs[0].y - xs[1].y}; }
                __syncthreads();
                fft_inv_cba(bufA, tid);
                const float skip = P.in[14][(size_t)(l * 2 + ord) * 1024 + c];
#pragma unroll
                for (int u = 0; u < 8; ++u) { const int t = tid + 512 * u; const f32x2 cv = bufA[PADI(tid) + 544 * u]; const unsigned gw_ = ZT[(size_t)((ord + 1) * 1024 + c) * 4096 + t]; const f32x2 gt = {bflo(gw_), bfhi(gw_)};
                    if (ord == 0) { y1[u] = gt * (cv + skip * vv[u]); bufA[PADI(tid) + 544 * u] = y1[u]; bufA[PADI(tid) + 544 * u + 4352] = (f32x2){0.f, 0.f}; }
                    else { const f32x2 yo = gt * (cv + skip * y1[u]); ((unsigned*)(ws + WS_ZY))[(size_t)c * 4096 + t] = pk2(yo.x, yo.y); } }
                __syncthreads();
            }
        } else {
            const int it = item - 1024, bb = it >> 6, cg = it & 63, ch = tid & 15, tg = tid >> 4, c = cg * 16 + ch;
            LAS float* filt = (LAS float*)lds;
            LAS float* vbuf = filt + 511 * 16;
            LAS float* ybuf = vbuf + 256 * 16;
            const float* ZC = (const float*)(ws + WS_ZC) + (size_t)bb * 256 * 3072;
            const float* HC = HID + 64 * 4096;
            bf16_t* HYC = (bf16_t*)(ws + WS_HYC);
            const float dl = hy_delta(c);
            for (int i = tid; i < 256 * 16; i += NTHR) vbuf[i] = ZC[(size_t)(i >> 4) * 3072 + cg * 16 + (i & 15)];
#pragma unroll 1
            for (int ord = 0; ord < 2; ++ord) {
                {
                    const float* wpf = w3 + ord * 2048 + c; const float* wpb = wpf + 1024;
                    f32x4 af0 = {0.f, 0.f, 0.f, 0.f}, af1 = af0, ab0 = af0, ab1 = af0;
#pragma unroll 4
                    for (int j = 0; j < 64; ++j) { const float wf = wpf[(size_t)j * 4096], wb = wpb[(size_t)j * 4096];
                        const f32x4 h0 = *(const f32x4*)(HC + j * 256 + tg * 8), h1 = *(const f32x4*)(HC + j * 256 + tg * 8 + 4);
                        af0 += h0 * wf; af1 += h1 * wf; ab0 += h0 * wb; ab1 += h1 * wb; }
#pragma unroll
                    for (int e = 0; e < 8; ++e) { const int tau = tg * 8 + e; const float win = __expf(-((float)tau * (1.f / 255.f)) * dl);
                        filt[(255 + tau) * 16 + ch] = win * (e < 4 ? af0[e & 3] : af1[e & 3]);
                        if (tau >= 1) filt[(255 - tau) * 16 + ch] = win * (e < 4 ? ab0[e & 3] : ab1[e & 3]); }
                }
                __syncthreads();
                const int tq = tg >> 1;
                (void)tq;
                float acc[8];
#pragma unroll
                for (int i = 0; i < 8; ++i) acc[i] = 0.f;
                const LAS float* src = ord ? ybuf : vbuf;
                for (int s = 0; s < 256; ++s) { const float vs = src[s * 16 + ch];
#pragma unroll
                    for (int i = 0; i < 8; ++i) acc[i] += filt[(tg * 8 + i - s + 255) * 16 + ch] * vs; }
                const float skip = P.in[14][(size_t)ord * 1024 + c];
                float res[8];
#pragma unroll
                for (int i = 0; i < 8; ++i) { const int t = tg * 8 + i; res[i] = ZC[(size_t)t * 3072 + (ord + 1) * 1024 + c] * (acc[i] + skip * src[t * 16 + ch]); }
                __syncthreads();
#pragma unroll
                for (int i = 0; i < 8; ++i) { const int t = tg * 8 + i;
                    if (ord == 0) ybuf[t * 16 + ch] = res[i];
                    else HYC[((size_t)bb * 256 + t) * 1024 + c] = (bf16_t)(pk2(res[i], 0.f) & 0xffffu); }
                __syncthreads();
            }
        }
    }
}

__device__ __forceinline__ void assemble_phase(const Params& P, int l, LAS unsigned char* lds) {
    const int tid = otid(), lane = tid & 63, wave = tid >> 6, G = gridDim.x;
    const int gw = blockIdx.x * NWAVES + wave, NGW = G * NWAVES;
    unsigned char* ws = P.ws;
    const bf16_t* H = (const bf16_t*)(ws + WS_H); bf16_t* BR = (bf16_t*)(ws + WS_DN);
    {
        LAS float* L = (LAS float*)lds;
        const unsigned* ZT = (const unsigned*)(ws + WS_ZY);
#define ASY_LOAD(rv_, item_) do { const int ti_ = (item_) >> 4, ct_ = (item_) & 15, tt_ = tid & 63; \
            _Pragma("unroll") for (int u = 0; u < 8; ++u) { const int cc = (tid >> 6) + 8 * u; rv_[u] = ZT[(size_t)(ct_ * 64 + cc) * 4096 + ti_ * 64 + tt_]; } } while (0)
        unsigned crv[8];
#pragma unroll
        for (int u = 0; u < 8; ++u) crv[u] = 0u;
        if ((int)blockIdx.x < 64 * 16) ASY_LOAD(crv, blockIdx.x);
#pragma unroll 1
        for (int item = blockIdx.x; item < 64 * 16; item += G) {
            const int ti = item >> 4, ct = item & 15;
            unsigned nrv[8];
#pragma unroll
            for (int u = 0; u < 8; ++u) nrv[u] = 0u;
            if (item + G < 64 * 16) ASY_LOAD(nrv, item + G);
            { const int tt = tid & 63;
#pragma unroll
              for (int u = 0; u < 8; ++u) { const int cc = (tid >> 6) + 8 * u; const unsigned v = crv[u];
                L[(0 * 64 + tt) * 65 + cc] = bflo(v); L[(1 * 64 + tt) * 65 + cc] = bfhi(v); } }
            asm volatile("s_waitcnt lgkmcnt(0)" ::: "memory"); __builtin_amdgcn_s_barrier(); asm volatile("" ::: "memory");
#pragma unroll
            for (int u = 0; u < 2; ++u) { const int task = tid + 512 * u, rowi = task >> 3, bb = rowi >> 6, tt = rowi & 63, ch8 = task & 7;
                const LAS float* lp = L + (bb * 64 + tt) * 65 + ch8 * 8;
                u32x4 o; o.x = pk2(lp[0], lp[1]); o.y = pk2(lp[2], lp[3]); o.z = pk2(lp[4], lp[5]); o.w = pk2(lp[6], lp[7]);
                *(u32x4*)(BR + ((size_t)bb * TPB + CTX + ti * 64 + tt) * 3072 + ct * 64 + ch8 * 8) = o; }
            asm volatile("s_waitcnt lgkmcnt(0)" ::: "memory"); __builtin_amdgcn_s_barrier(); asm volatile("" ::: "memory");
#pragma unroll
            for (int u = 0; u < 8; ++u) crv[u] = nrv[u];
        }
#undef ASY_LOAD
    }
    if (l == 0) {
        const u32x4* HYC = (const u32x4*)(ws + WS_HYC);
        for (int i = blockIdx.x * NTHR + tid; i < 512 * 128; i += G * NTHR) { const int r = i >> 7, c8 = i & 127;
            *(u32x4*)(BR + ((size_t)(r >> 8) * TPB + (r & 255)) * 3072 + c8 * 8) = HYC[i]; }
    }
    {
        const bf16_t* SOb = (const bf16_t*)(ws + WS_SO);
        const bool skipc = (l == DEPTH - 1);
        int r = gw;
        while (r < M && skipc && (r % TPB) < CTX) r += NGW;
        float nwr[2][8];
#pragma unroll
        for (int mix = 0; mix < 2; ++mix)
#pragma unroll
            for (int e = 0; e < 8; ++e) nwr[mix][e] = P.in[mix ? 22 : 16][l * 128 + (lane & 15) * 8 + e];
        u32x4 cs[2][2][2], cg[2][2];
#define ASM_LOAD(so, gg, row) do { _Pragma("unroll") for (int mix = 0; mix < 2; ++mix) _Pragma("unroll") for (int half = 0; half < 2; ++half) { const int ch = half * 512 + lane * 8; \
            so[mix][half][0] = *(const u32x4*)(SOb + (size_t)(mix * 2) * (SZ_SOB / 2) + (size_t)(row) * 1024 + ch); \
            so[mix][half][1] = *(const u32x4*)(SOb + (size_t)(mix * 2 + 1) * (SZ_SOB / 2) + (size_t)(row) * 1024 + ch); \
            gg[mix][half] = *(const u32x4*)(H + (size_t)(row) * NPAD + (mix ? C_DNZ : C_HGG) + ch); } } while (0)
#pragma unroll
        for (int mix = 0; mix < 2; ++mix)
#pragma unroll
            for (int half = 0; half < 2; ++half) { cs[mix][half][0] = (u32x4){0u, 0u, 0u, 0u}; cs[mix][half][1] = cs[mix][half][0]; cg[mix][half] = cs[mix][half][0]; }
        if (r < M) ASM_LOAD(cs, cg, r);
#pragma unroll 1
        while (r < M) {
            int rn = r + NGW;
            while (rn < M && skipc && (rn % TPB) < CTX) rn += NGW;
            u32x4 ns[2][2][2], ng[2][2];
#pragma unroll
            for (int mix = 0; mix < 2; ++mix)
#pragma unroll
                for (int half = 0; half < 2; ++half) { ns[mix][half][0] = (u32x4){0u, 0u, 0u, 0u}; ns[mix][half][1] = ns[mix][half][0]; ng[mix][half] = ns[mix][half][0]; }
            if (rn < M) ASM_LOAD(ns, ng, rn);
#pragma unroll
            for (int mix = 0; mix < 2; ++mix) {
#pragma unroll
                for (int half = 0; half < 2; ++half) {
                    const int ch = half * 512 + lane * 8;
                    float o[8], o2[8]; unpack8(cs[mix][half][0], o); unpack8(cs[mix][half][1], o2);
#pragma unroll
                    for (int e = 0; e < 8; ++e) o[e] += o2[e];
                    float ss = 0.f;
#pragma unroll
                    for (int e = 0; e < 8; ++e) ss += o[e] * o[e];
                    ss = row_sum16(ss);
                    const float rs = __builtin_amdgcn_rsqf(ss * (1.f / 128.f) + 1e-6f);
                    float gt[8]; unpack8(cg[mix][half], gt);
                    float res[8];
#pragma unroll
                    for (int e = 0; e < 8; ++e) res[e] = o[e] * rs * nwr[mix][e] * (mix ? silu(gt[e]) : sigm(gt[e]));
                    u32x4 ov; ov.x = pk2(res[0], res[1]); ov.y = pk2(res[2], res[3]); ov.z = pk2(res[4], res[5]); ov.w = pk2(res[6], res[7]);
                    *(u32x4*)(BR + (size_t)r * 3072 + (mix ? 2048 : 1024) + ch) = ov;
                }
            }
#pragma unroll
            for (int mix = 0; mix < 2; ++mix)
#pragma unroll
                for (int half = 0; half < 2; ++half) { cs[mix][half][0] = ns[mix][half][0]; cs[mix][half][1] = ns[mix][half][1]; cg[mix][half] = ng[mix][half]; }
            r = rn;
        }
#undef ASM_LOAD
    }
}

__device__ __forceinline__ void ctx_sb_from_sctx(const Params& P) {
    const float* SC = (const float*)(P.ws + WS_SCTX); bf16_t* SB = (bf16_t*)(P.ws + WS_U);
    for (int i = blockIdx.x * NTHR + threadIdx.x; i < 512 * D / 4; i += gridDim.x * NTHR) {
        const int r = i / (D / 4), c4 = i - r * (D / 4); f32x4 v = *(const f32x4*)(SC + (size_t)i * 4);
#pragma unroll
        for (int s = 1; s < 12; ++s) v += *(const f32x4*)(SC + (size_t)s * 512 * D + (size_t)i * 4);
        u32x2 o; o.x = pk2(v[0], v[1]); o.y = pk2(v[2], v[3]);
        *(u32x2*)(SB + ((size_t)(r >> 8) * TPB + (r & 255)) * D + c4 * 4) = o; }
}
__device__ __forceinline__ void gbar_impl(unsigned* bar, unsigned& gen, unsigned nloc, unsigned nx) {
    asm volatile("s_waitcnt vmcnt(0)" ::: "memory");
    __syncthreads();
    gen += 1u;
    if (threadIdx.x == 0) {
        __builtin_amdgcn_s_waitcnt(0);
        const unsigned x = xcc_id();
        const unsigned old = __hip_atomic_fetch_add(bar + XB_SUB(x), 1u, __ATOMIC_RELAXED, __HIP_MEMORY_SCOPE_AGENT);
        if (old + 1u == gen * nloc) {
            __builtin_amdgcn_fence(__ATOMIC_RELEASE, "agent");
            asm volatile("s_waitcnt vmcnt(0)" ::: "memory");
            const unsigned og = __hip_atomic_fetch_add(bar + XB_TOP, 1u, __ATOMIC_RELAXED, __HIP_MEMORY_SCOPE_AGENT);
            if (og + 1u == gen * nx) (void)__hip_atomic_fetch_add(bar + XB_GEN, 1u, __ATOMIC_RELAXED, __HIP_MEMORY_SCOPE_AGENT);
        }
        unsigned sp = 0u;
        while (__hip_atomic_load(bar + XB_GEN, __ATOMIC_RELAXED, __HIP_MEMORY_SCOPE_AGENT) < gen) { __builtin_amdgcn_s_sleep(1); if (++sp > (1u << 22)) break; }
        __builtin_amdgcn_fence(__ATOMIC_ACQUIRE, "agent");
        asm volatile("s_waitcnt vmcnt(0)" ::: "memory");
    }
    __syncthreads();
}
#define gbar(bar, gen, G) gbar_impl(bar, gen, bar_nloc, bar_nx)
#ifndef REPM
#define REPM 0
#endif
#define REP(bit) for (int _rp = 0; _rp < (((REPM) >> (bit)) & 1) + 1; ++_rp)
__global__ void __launch_bounds__(NTHR, 2) mega(Params P) {
    extern __shared__ __attribute__((aligned(16))) unsigned char smem[];
    LAS unsigned char* lds = (LAS unsigned char*)smem;
    cg::grid_group grid = cg::this_grid();
    unsigned char* ws = P.ws;
    const int G = gridDim.x, cidx = blockIdx.x;
    unsigned* bar = (unsigned*)(ws + WS_BAR); unsigned bgen = 0u;

    REP(0) { phase0(P, lds);
    grid.sync(); }
    unsigned bar_nloc, bar_nx;
    { unsigned nl = __hip_atomic_load(bar + XB_CNT(xcc_id()), __ATOMIC_RELAXED, __HIP_MEMORY_SCOPE_AGENT), nxx = 0u;
#pragma unroll
      for (int j = 0; j < 16; ++j) nxx += (__hip_atomic_load(bar + XB_CNT(j), __ATOMIC_RELAXED, __HIP_MEMORY_SCOPE_AGENT) != 0u) ? 1u : 0u;
      bar_nloc = (unsigned)__builtin_amdgcn_readfirstlane((int)(nl ? nl : 1u)); bar_nx = (unsigned)__builtin_amdgcn_readfirstlane((int)(nxx ? nxx : 1u)); }
    init_rows(P);
    gbar(bar, bgen, (unsigned)G);

#pragma unroll 1
    for (int l = 0; l < DEPTH; ++l) {
        const float* modl = (const float*)(ws + WS_MOD) + (size_t)l * 3 * 6 * D;
        { pg8::Order S{(const bf16_t*)(ws + WS_U), (const bf16_t*)(ws + WS_WIN + (size_t)l * SZ_WIN), D, D, l ? 32 : M / 256, NPAD / 256, G, cidx, 1, 0, 0, D, l ? 1 : 0, l ? 19 : 0, 0};
          pg8::EpiBf16<0> E{(bf16_t*)(ws + WS_H), NPAD};
          REP(1) pg8::gemm_phase(lds, D, D, S, E); }
        gbar(bar, bgen, (unsigned)G);
        REP(2) { prep_phase(P, l, lds);
        gbar(bar, bgen, (unsigned)G); }
        REP(4) { hyena_phase(P, l, lds);
        gbar(bar, bgen, (unsigned)G); }
        chunkprep_phase(P, lds);
        gbar(bar, bgen, (unsigned)G);
        hgprep_phase(P, l, lds);
        gbar(bar, bgen, (unsigned)G);
        REP(3) { scan_phase(P, l, lds);
        gbar(bar, bgen, (unsigned)G); }
        REP(5) { assemble_phase(P, l, lds);
        gbar(bar, bgen, (unsigned)G); }
        { pg8::Order S{(const bf16_t*)(ws + WS_DN), (const bf16_t*)(ws + WS_WBR + (size_t)l * 3 * SZ_WBR), 3072, 1024, 32, D / 256, G, cidx, 3, 1024, (size_t)D * 1024, 1024, 1, 0, l ? 0 : 4};
          pg8::EpiBranch E{(float*)(ws + WS_SO), (bf16_t*)(ws + WS_U), (const bf16_t*)(ws + WS_H), (float*)(ws + WS_SCTX)};
          pg8::gemm_phase(lds, 3072, 1024, S, E); }
        gbar(bar, bgen, (unsigned)G);
        if (l == 0) { ctx_sb_from_sctx(P); gbar(bar, bgen, (unsigned)G); }
        { pg8::Order S{(const bf16_t*)(ws + WS_U), (const bf16_t*)(ws + WS_WOUT + (size_t)l * SZ_WOUT), D, D, 32, D / 256, G, cidx, 1, 0, 0, D, 1, 0, l ? 0 : 8};
          pg8::EpiRes E{(bf16_t*)(ws + WS_SO + (size_t)M * D * 4), (const float*)(ws + WS_X), modl, 2, (float*)(ws + WS_SCTX)};
          pg8::gemm_phase(lds, D, D, S, E); }
        gbar(bar, bgen, (unsigned)G);
        REP(8) { ln_rows(P, P.in[25] + l * D, P.in[26] + l * D, modl, 3, true, false, l ? 0 : 8, l == DEPTH - 1);
        gbar(bar, bgen, (unsigned)G); }
        { pg8::Order S{(const bf16_t*)(ws + WS_U), (const bf16_t*)(ws + WS_WFF1 + (size_t)l * SZ_WFF), D, D, l ? 32 : M / 256, DFF / 256, G, cidx, 1, 0, 0, D, l ? 1 : 0, 0, 0};
          pg8::EpiBf16<1> E{(bf16_t*)(ws + WS_H), DFF};
          REP(9) pg8::gemm_phase(lds, D, D, S, E); }
        gbar(bar, bgen, (unsigned)G);
        { pg8::Order S{(const bf16_t*)(ws + WS_H), (const bf16_t*)(ws + WS_WFF2 + (size_t)l * SZ_WFF), DFF, DFF, 32, D / 256, G, cidx, 1, 0, 0, DFF, 1, 0, l ? 0 : 16};
          pg8::EpiRes E{(bf16_t*)(ws + WS_SO + (size_t)M * D * 4), (const float*)(ws + WS_X), modl, 5, (float*)(ws + WS_SCTX)};
          pg8::gemm_phase(lds, DFF, DFF, S, E); }
        gbar(bar, bgen, (unsigned)G);
        const bool lastl = (l == DEPTH - 1);
        ln_rows(P, P.in[29] + l * D, P.in[30] + l * D, modl + (lastl ? 0 : 3 * 6 * D), 0, !lastl, lastl, l ? 0 : 16, lastl);
        if (!lastl) gbar(bar, bgen, (unsigned)G);
    }
}

extern "C" void kernel_launch(void* const* d_in, const int* in_sizes, int n_in, void* d_out, int out_size, void* d_ws, size_t ws_size, hipStream_t stream) {
    static int grid_blocks = 0;
    if (grid_blocks == 0) {
        if (n_in != 31 || ws_size < WS_END) { fprintf(stderr, "kernel_launch: unexpected n_in %d or ws_size %zu (need %zu)\n", n_in, ws_size, (size_t)WS_END); grid_blocks = -1; return; }
        int dev = 0, cus = 0, per_cu = 0;
        hipGetDevice(&dev);
        hipDeviceGetAttribute(&cus, hipDeviceAttributeMultiprocessorCount, dev);
        if (hipFuncSetAttribute((const void*)mega, hipFuncAttributeMaxDynamicSharedMemorySize, LDS_BYTES) != hipSuccess) fprintf(stderr, "kernel_launch: hipFuncSetAttribute failed\n");
        hipOccupancyMaxActiveBlocksPerMultiprocessor(&per_cu, (const void*)mega, NTHR, LDS_BYTES);
        if (per_cu < 1) { fprintf(stderr, "kernel_launch: occupancy query says %d blocks per CU\n", per_cu); per_cu = 1; }
        (void)hipGetLastError();
        grid_blocks = cus;
    }
    if (grid_blocks < 0) return;
    Params p{};
    for (int i = 0; i < 31; ++i) p.in[i] = (const float*)d_in[i];
    p.out = (float*)d_out; p.ws = (unsigned char*)d_ws;
    (void)hipMemsetAsync((unsigned char*)d_ws + WS_BAR, 0, 16384, stream);
    void* args[] = {&p};
    hipError_t e = hipLaunchCooperativeKernel((const void*)mega, dim3(grid_blocks), dim3(NTHR), args, LDS_BYTES, stream);
    if (e != hipSuccess) fprintf(stderr, "cooperative launch failed: %s (grid %d)\n", hipGetErrorString(e), grid_blocks);
}
```

```cpp
#include <hip/hip_runtime.h>
#include <hip/hip_cooperative_groups.h>
#include <cstdio>
#include <cstdint>
namespace cg = cooperative_groups;

#define LAS __attribute__((address_space(3)))
typedef unsigned short bf16_t;
typedef short bf16x8 __attribute__((ext_vector_type(8)));
typedef float f32x4 __attribute__((ext_vector_type(4)));
typedef float f32x2 __attribute__((ext_vector_type(2)));
typedef unsigned u32x4 __attribute__((ext_vector_type(4)));
typedef unsigned u32x2 __attribute__((ext_vector_type(2)));

constexpr int D = 2048, NB = 2, SEQ = 4096, CTX = 256, TPB = SEQ + CTX, M = NB * TPB, DEPTH = 2;
constexpr int INC = 17440, NPAD = 17664, DFF = 8192;
constexpr int C_HGFF = 0, C_HGFB = 1024, C_HGI = 2048, C_DNK = 3072, C_DNV = 3584, C_DNA = 4608, C_DNB = 4624,
              C_HGQ = 4640, C_HGG = 5664, C_DNQ = 6688, C_DNZ = 7200, C_HY = 8224, C_GATE = 11296;
constexpr int NTHR = 512, NWAVES = 8;
constexpr int LDS_BYTES = 147456;
constexpr float ALPHA = 1.41421356237f;

constexpr size_t al256(size_t x) { return (x + 255) & ~(size_t)255; }
constexpr size_t SZ_WIN = (size_t)NPAD * D * 2, SZ_WBR = (size_t)D * 1024 * 2, SZ_WOUT = (size_t)D * D * 2, SZ_WFF = (size_t)DFF * D * 2;
constexpr size_t WS_WIN = 0;
constexpr size_t WS_WBR = WS_WIN + DEPTH * SZ_WIN;
constexpr size_t WS_WOUT = WS_WBR + DEPTH * 3 * SZ_WBR;
constexpr size_t WS_WFF1 = WS_WOUT + DEPTH * SZ_WOUT;
constexpr size_t WS_WFF2 = WS_WFF1 + DEPTH * SZ_WFF;
constexpr size_t WS_X = WS_WFF2 + DEPTH * SZ_WFF;
constexpr size_t WS_U = WS_X + (size_t)M * D * 4;
constexpr size_t WS_H = WS_U + (size_t)M * D * 2;
constexpr size_t WS_DN = WS_H + (size_t)M * NPAD * 2;
constexpr size_t OFF_DNK = 0, OFF_DNQ = (size_t)M * 512 * 4, OFF_DNV = 2 * OFF_DNQ, OFF_DNS = OFF_DNV + (size_t)M * 1024 * 4;
constexpr size_t SZ_DN = OFF_DNS + (size_t)M * 64 * 4;
constexpr size_t WS_SO = WS_DN + SZ_DN;
constexpr size_t SZ_SO1 = (size_t)M * 1024 * 4;
constexpr size_t SZ_SOB = (size_t)M * 1024 * 2;
constexpr size_t WS_ZT = WS_SO + 4 * SZ_SO1;
constexpr size_t WS_ZY = WS_ZT + (size_t)3072 * 4096 * 8;
constexpr size_t WS_ZC = WS_ZY + (size_t)1024 * 4096 * 8;
constexpr size_t WS_MOD = WS_ZC + (size_t)2 * 256 * 3072 * 4;
constexpr size_t WS_HID = WS_MOD + (size_t)DEPTH * 3 * 6 * D * 4;
constexpr size_t SZ_HID1 = (size_t)64 * (4096 + 256) * 4;
constexpr size_t WS_LB = WS_HID + DEPTH * SZ_HID1;
constexpr size_t WS_BAR = WS_LB + (size_t)DEPTH * 2 * 1024 * 4;
constexpr size_t WS_SCTX = WS_ZT;
constexpr int NCHUNK = TPB / 16, NTASK = NB * 8 * 2 * NCHUNK;
constexpr size_t WS_CP1 = WS_ZT;
constexpr size_t CP1_STRIDE = 8192;
constexpr size_t WS_CPK = WS_U;
constexpr size_t WS_CP2 = WS_BAR + 16384;
constexpr size_t CP2_STRIDE = 512 + 512 + 128;
static_assert((size_t)NTASK * 4096 <= (size_t)M * D * 2, "CPK alias");
constexpr size_t WS_HGQ = WS_DN + OFF_DNK;
constexpr size_t WS_HGA = WS_ZT + (size_t)NTASK * CP1_STRIDE;
constexpr size_t WS_HGK = WS_CP2 + (size_t)NTASK * CP2_STRIDE;
constexpr size_t WS_HYC = WS_HGK + (size_t)NTASK * 4096;
static_assert((size_t)NTASK * 4096 <= 2 * (size_t)M * 512 * 4 && (size_t)NTASK * (CP1_STRIDE + 1024) <= (size_t)3072 * 4096 * 8, "HG fragment aliases");
constexpr size_t WS_END = WS_HYC + (size_t)512 * 1024 * 2;
static_assert((size_t)NTASK * CP1_STRIDE <= (size_t)3072 * 4096 * 8, "CP1 alias");
static_assert((size_t)16 * 512 * D * 4 <= (size_t)3072 * 4096 * 8, "PART alias");
static_assert(WS_END < (size_t)1142900000, "workspace too large");
static_assert((size_t)M * 3072 * 2 <= SZ_DN && (size_t)M * DFF * 2 <= (size_t)M * NPAD * 2 && 2 * (size_t)M * D * 4 <= 4 * SZ_SO1, "aliases");

struct Params { const float* in[31]; float* out; unsigned char* ws; };

#define LDS_WAIT() asm volatile("s_waitcnt lgkmcnt(0)" ::: "memory")
#define XB_CNT(j) (64 * (j))
#define XB_SUB(j) (1024 + 64 * (j))
#define XB_TOP 2048
#define XB_GEN 2112
__device__ __forceinline__ unsigned xcc_id() { return (unsigned)__builtin_amdgcn_s_getreg((3 << 11) | 20) & 0xFu; }
__device__ __forceinline__ int otid() { int t = threadIdx.x; asm volatile("" : "+v"(t)); return t; }
__device__ __forceinline__ int obid() { int t = blockIdx.x; asm volatile("" : "+s"(t)); return t; }
__device__ __forceinline__ unsigned pk2(float lo, float hi) { unsigned r; asm("v_cvt_pk_bf16_f32 %0, %1, %2" : "=v"(r) : "v"(lo), "v"(hi)); return r; }
typedef __bf16 bf16v2 __attribute__((ext_vector_type(2)));
__device__ __forceinline__ unsigned pk2n(float lo, float hi) { return __builtin_bit_cast(unsigned, __builtin_convertvector((f32x2){lo, hi}, bf16v2)); }
__device__ __forceinline__ float bflo(unsigned u) { return __uint_as_float(u << 16); }
__device__ __forceinline__ float bfhi(unsigned u) { return __uint_as_float(u & 0xffff0000u); }
__device__ __forceinline__ float bf1(bf16_t u) { return __uint_as_float(((unsigned)u) << 16); }
__device__ __forceinline__ float sigm(float x) { return __builtin_amdgcn_rcpf(1.f + __expf(-x)); }
__device__ __forceinline__ float silu(float x) { return x * sigm(x); }
__device__ __forceinline__ float sin_rad(float x) { float r = x * 0.15915494309189535f; r = r - floorf(r); return __builtin_amdgcn_sinf(r); }
template <int CTRL> __device__ __forceinline__ float dppf(float x) { return __builtin_bit_cast(float, __builtin_amdgcn_update_dpp(0, __builtin_bit_cast(int, x), CTRL, 0xf, 0xf, true)); }
__device__ __forceinline__ float row_sum16(float x) {
    x += dppf<0x128>(x); x += dppf<0x124>(x); x += dppf<0x122>(x); x += dppf<0x121>(x); return x;
}
__device__ __forceinline__ float wave_sum(float v) {
    v = row_sum16(v);
    const int iv = __builtin_bit_cast(int, v);
    const float a = __builtin_bit_cast(float, __builtin_amdgcn_readlane(iv, 0)), b = __builtin_bit_cast(float, __builtin_amdgcn_readlane(iv, 16));
    const float c = __builtin_bit_cast(float, __builtin_amdgcn_readlane(iv, 32)), d = __builtin_bit_cast(float, __builtin_amdgcn_readlane(iv, 48));
    return (a + b) + (c + d);
}
__device__ __forceinline__ void unpack8(u32x4 u, float* f) {
    f[0] = bflo(u.x); f[1] = bfhi(u.x); f[2] = bflo(u.y); f[3] = bfhi(u.y); f[4] = bflo(u.z); f[5] = bfhi(u.z); f[6] = bflo(u.w); f[7] = bfhi(u.w);
}

namespace pg8 {
constexpr int BM = 256, BK = 64, HALF = 128, HTB = HALF * BK * 2, NXCD = 8, WGM = 8;
__device__ __forceinline__ int lds_byte(int r, int c) { const int st = (r >> 4) * 2 + (c >> 5), rr = r & 15, cc = c & 31, ob = rr * 64 + cc * 2; return st * 1024 + (ob ^ (((ob >> 9) & 1) << 5)); }
__device__ __forceinline__ void stage_rc(int b, int& R, int& C) { const int st = b / 1024, sb = b % 1024, swz = sb ^ (((sb >> 9) & 1) << 5); R = (st >> 1) * 16 + swz / 64; C = (st & 1) * 32 + (swz % 64) / 2; }
__device__ __forceinline__ int perm32(int rho) { const int n = rho >> 4, i = rho & 15; return 8 * (i >> 2) + 4 * n + (i & 3); }

struct Unit { int pm, pn, g, nt, split, slot; const char* A; const char* B; };

__device__ __forceinline__ void tile_of(int L, int nM, int nN, int& pm, int& pn) {
    const int nwg = nM * nN; int wgid = L;
    { const int q = nwg / NXCD, r = nwg % NXCD, xcd = wgid % NXCD, off = wgid / NXCD; wgid = (xcd < r ? xcd * (q + 1) : r * (q + 1) + (xcd - r) * q) + off; }
    const int nig = WGM * nN, gid = wgid / nig, fm = gid * WGM, gsz = (nM - fm) < WGM ? (nM - fm) : WGM;
    pm = fm + ((wgid % nig) % gsz); pn = (wgid % nig) / gsz;
}
struct Order {
    const bf16_t* A; const bf16_t* Bt; int lda, ldb, nM, nN, G, c, nsub; size_t aks, bstride;
    int K;
    int latent_only, ctx_ncols;
    int ksplit;
    __device__ __forceinline__ bool next(int i, Unit& u) const {
        const int nmain = nM * nN;
        const int rounds = (nmain > c) ? (nmain - c + G - 1) / G : 0;
        if (i < rounds * nsub) {
            const int ti = i / nsub, g = i - ti * nsub; const int L = ti * G + c;
            tile_of(L, nM, nN, u.pm, u.pn); if (latent_only) u.pm += 1 + (u.pm >= 16);
            u.g = g; u.nt = K / BK; u.split = 0;
            u.A = (const char*)(A + (size_t)u.pm * BM * lda + (size_t)g * aks);
            u.B = (const char*)(Bt + (size_t)g * bstride + (size_t)u.pn * BM * ldb);
            return true;
        }
        const int e = i - rounds * nsub; const long Lx = (long)e * G + c;
        if (ksplit > 0) {
            if (Lx >= (long)2 * nN * nsub * ksplit) return false;
            const int s = (int)Lx, per = nsub * ksplit, tile = s / per, r = s - tile * per, g = r / ksplit, ks = r - g * ksplit, Ks = K / ksplit;
            const int q = tile / nN; u.pm = q * 17; u.pn = tile - q * nN; u.g = g; u.nt = Ks / BK; u.split = 1; u.slot = r;
            u.A = (const char*)(A + (size_t)u.pm * BM * lda + (size_t)g * aks + (size_t)ks * Ks);
            u.B = (const char*)(Bt + (size_t)g * bstride + (size_t)u.pn * BM * ldb + (size_t)ks * Ks);
            return true;
        }
        if (Lx >= (long)2 * ctx_ncols) return false;
        { const int j = (int)Lx; const int q = j / ctx_ncols; u.pm = q * 17; u.pn = j - q * ctx_ncols; }
        u.g = 0; u.nt = K / BK; u.split = 0;
        u.A = (const char*)(A + (size_t)u.pm * BM * lda);
        u.B = (const char*)(Bt + (size_t)u.pn * BM * ldb);
        return true;
    }
};

template <class Epi, class Sched>
__device__ __forceinline__ void gemm_phase(LAS unsigned char* lds, const int lda, const int ldb, const Sched& S, const Epi& E) {
    const int tid = otid(), wid = __builtin_amdgcn_readfirstlane(tid >> 6), lane = tid & 63, wr = wid >> 2, wc = wid & 3, fr = lane & 15, fq = lane >> 4;
    unsigned voffA[2], voffB[2];
#pragma unroll
    for (int i = 0; i < 2; ++i) { int R, C; stage_rc(tid * 16 + i * 8192, R, C); const int Rb = Epi::PERM ? ((R & ~31) + perm32(R & 31)) : R;
        voffA[i] = (unsigned)(R * lda + C) * 2u; voffB[i] = (unsigned)(Rb * ldb + C) * 2u; }
    const size_t kstep = (size_t)(BK * 2);
    const size_t hstepA = (size_t)HALF * lda * 2, hstepB = (size_t)HALF * ldb * 2;
    const unsigned ldsw = (unsigned)wid * 1024u;
    const int aoff = lds_byte(wr * 64 + fr, fq * 8), boff = lds_byte(wc * 32 + fr, fq * 8);
#define PG8_SA(b, h) (((b) * 2 + (h)) * HTB)
#define PG8_SB(b, h) ((4 + (b) * 2 + (h)) * HTB)
#define PG8_STAGE(bufoff, gbase, voff) do { _Pragma("unroll") for (int _i = 0; _i < 2; ++_i) \
        __builtin_amdgcn_global_load_lds((const unsigned*)((const char*)(gbase) + (voff)[_i]), (LAS unsigned*)(lds + (bufoff) + ldsw + _i * 8192), 16, 0, 0); } while (0)
#define PG8_LDA(dst, b, h) do { _Pragma("unroll") for (int m = 0; m < 4; ++m) _Pragma("unroll") for (int k = 0; k < 2; ++k) dst[m][k] = *(const LAS bf16x8*)(lds + PG8_SA(b, h) + aoff + m * 2048 + k * 1024); } while (0)
#define PG8_LDB(dst, b, h) do { _Pragma("unroll") for (int n = 0; n < 2; ++n) _Pragma("unroll") for (int k = 0; k < 2; ++k) dst[n][k] = *(const LAS bf16x8*)(lds + PG8_SB(b, h) + boff + n * 2048 + k * 1024); } while (0)
#define PG8_MMA(ai, bj, At, Bt) do { __builtin_amdgcn_s_setprio(1); _Pragma("unroll") for (int m = 0; m < 4; ++m) _Pragma("unroll") for (int n = 0; n < 2; ++n) _Pragma("unroll") for (int k = 0; k < 2; ++k) \
        acc[ai][bj][m][n] = __builtin_amdgcn_mfma_f32_16x16x32_bf16(Bt[n][k], At[m][k], acc[ai][bj][m][n], 0, 0, 0); __builtin_amdgcn_s_setprio(0); } while (0)
#define PG8_WAIT_V(n) asm volatile("s_waitcnt vmcnt(" #n ")" ::: "memory")
#define PG8_WAIT_L(n) asm volatile("s_waitcnt lgkmcnt(" #n ")" ::: "memory")
#define PG8_BAR __builtin_amdgcn_s_barrier()
#define PG8_SCHED __builtin_amdgcn_sched_barrier(0)
    Unit cur, nxt; int ui = 0;
    if (!S.next(0, cur)) return;
    f32x4 acc[2][2][4][2];
#pragma unroll
    for (int a = 0; a < 2; ++a)
#pragma unroll
        for (int b = 0; b < 2; ++b)
#pragma unroll
            for (int m = 0; m < 4; ++m)
#pragma unroll
                for (int n = 0; n < 2; ++n) acc[a][b][m][n] = (f32x4){0.f, 0.f, 0.f, 0.f};
    bf16x8 At[4][2], B0[2][2], B1[2][2];
    const char* cA = cur.A; const char* cB = cur.B;
    PG8_STAGE(PG8_SB(0, 0), cB, voffB); PG8_STAGE(PG8_SA(0, 0), cA, voffA); PG8_STAGE(PG8_SB(0, 1), cB + hstepB, voffB); PG8_STAGE(PG8_SA(0, 1), cA + hstepA, voffA);
    if (wr == 1) PG8_BAR;
    PG8_WAIT_V(4); PG8_BAR;
    PG8_STAGE(PG8_SB(1, 0), cB + kstep, voffB); PG8_STAGE(PG8_SA(1, 0), cA + kstep, voffA); PG8_STAGE(PG8_SB(1, 1), cB + hstepB + kstep, voffB);
    PG8_WAIT_V(6); PG8_BAR;
    for (;;) {
        const bool has_next = S.next(ui + 1, nxt);
        const char* nA = has_next ? nxt.A : cA; const char* nB = has_next ? nxt.B : cB;
        const int nt = cur.nt;
        for (int t = 0; t < nt; t += 2) {
            const bool last = (t == nt - 2);
            const char* a1 = cA + (size_t)(t + 1) * kstep;
            const char* a2 = last ? nA : cA + (size_t)(t + 2) * kstep; const char* b2 = last ? nB : cB + (size_t)(t + 2) * kstep;
            const char* a3 = a2 + kstep; const char* b3 = b2 + kstep;
            PG8_LDB(B0, 0, 0); PG8_SCHED; PG8_LDA(At, 0, 0); PG8_STAGE(PG8_SA(1, 1), a1 + hstepA, voffA);
            PG8_WAIT_L(8); PG8_BAR; PG8_WAIT_L(0); PG8_MMA(0, 0, At, B0); PG8_BAR; PG8_SCHED;
            PG8_LDB(B1, 0, 1); PG8_STAGE(PG8_SB(0, 0), b2, voffB);
            PG8_BAR; PG8_WAIT_L(0); PG8_MMA(0, 1, At, B1); PG8_BAR;
            PG8_LDA(At, 0, 1); PG8_STAGE(PG8_SA(0, 0), a2, voffA);
            PG8_BAR; PG8_WAIT_L(0); PG8_MMA(1, 0, At, B0); PG8_BAR; PG8_SCHED;
            PG8_STAGE(PG8_SB(0, 1), b2 + hstepB, voffB);
            PG8_WAIT_V(6); PG8_BAR; PG8_MMA(1, 1, At, B1); PG8_BAR;
            PG8_LDB(B0, 1, 0); PG8_SCHED; PG8_LDA(At, 1, 0); PG8_STAGE(PG8_SA(0, 1), a2 + hstepA, voffA);
            PG8_WAIT_L(8); PG8_BAR; PG8_WAIT_L(0); PG8_MMA(0, 0, At, B0); PG8_BAR; PG8_SCHED;
            PG8_LDB(B1, 1, 1); PG8_STAGE(PG8_SB(1, 0), b3, voffB);
            PG8_BAR; PG8_WAIT_L(0); PG8_MMA(0, 1, At, B1); PG8_BAR;
            PG8_LDA(At, 1, 1); PG8_STAGE(PG8_SA(1, 0), a3, voffA);
            PG8_BAR; PG8_WAIT_L(0); PG8_MMA(1, 0, At, B0); PG8_BAR; PG8_SCHED;
            PG8_STAGE(PG8_SB(1, 1), b3 + hstepB, voffB);
            PG8_WAIT_V(6); PG8_BAR; PG8_MMA(1, 1, At, B1); PG8_BAR;
        }
        E(acc, cur, wr, wc, fr, fq);
        if (!has_next) break;
#pragma unroll
        for (int a = 0; a < 2; ++a)
#pragma unroll
            for (int b = 0; b < 2; ++b)
#pragma unroll
                for (int m = 0; m < 4; ++m)
#pragma unroll
                    for (int n = 0; n < 2; ++n) acc[a][b][m][n] = (f32x4){0.f, 0.f, 0.f, 0.f};
        cur = nxt; cA = nA; cB = nB; ++ui;
    }
    PG8_WAIT_V(0);
    if (wr == 0) PG8_BAR;
    PG8_BAR;
#undef PG8_SA
#undef PG8_SB
#undef PG8_STAGE
#undef PG8_LDA
#undef PG8_LDB
#undef PG8_MMA
#undef PG8_WAIT_V
#undef PG8_WAIT_L
#undef PG8_BAR
#undef PG8_SCHED
}

template <int ACT> struct EpiBf16 {
    static constexpr bool PERM = true;
    bf16_t* O; int ldc;
    __device__ __forceinline__ void operator()(const f32x4 (&acc)[2][2][4][2], const Unit& u, int wr, int wc, int fr, int fq) const {
        const int row0 = u.pm * BM + wr * 64 + fr, col0 = u.pn * BM + wc * 32 + 8 * fq;
#pragma unroll
        for (int ai = 0; ai < 2; ++ai)
#pragma unroll
            for (int m = 0; m < 4; ++m) { bf16_t* rowp = O + (size_t)(row0 + ai * HALF + m * 16) * ldc + col0;
#pragma unroll
                for (int bj = 0; bj < 2; ++bj) { f32x4 v0 = acc[ai][bj][m][0], v1 = acc[ai][bj][m][1];
                    if (ACT == 1) {
#pragma unroll
                        for (int e = 0; e < 4; ++e) { float a = fmaxf(v0[e], 0.f), b = fmaxf(v1[e], 0.f); v0[e] = a * a; v1[e] = b * b; } }
                    u32x4 o; o.x = pk2(v0[0], v0[1]); o.y = pk2(v0[2], v0[3]); o.z = pk2(v1[0], v1[1]); o.w = pk2(v1[2], v1[3]);
                    *(u32x4*)(rowp + bj * HALF) = o; } }
    }
};
struct EpiRes {
    static constexpr bool PERM = true;
    bf16_t* T; const float* X; const float* mod; int gidx; float* PART;
    __device__ __forceinline__ void operator()(const f32x4 (&acc)[2][2][4][2], const Unit& u, int wr, int wc, int fr, int fq) const {
        const int row0 = u.pm * BM + wr * 64 + fr, col0 = u.pn * BM + wc * 32 + 8 * fq;
        const int b = u.pm / 17, isctx = (u.pm - b * 17) == 0;
        const float* gv = mod + (size_t)(isctx ? 2 : b) * (6 * D) + (size_t)gidx * D;
#pragma unroll
        for (int bj = 0; bj < 2; ++bj) { const int col = col0 + bj * HALF; const f32x4 g0 = *(const f32x4*)(gv + col), g1 = *(const f32x4*)(gv + col + 4);
#pragma unroll
            for (int ai = 0; ai < 2; ++ai)
#pragma unroll
                for (int m = 0; m < 4; ++m) { const int row = row0 + ai * HALF + m * 16; const size_t o = (size_t)row * D + col;
                    const f32x4 t0 = g0 * acc[ai][bj][m][0], t1 = g1 * acc[ai][bj][m][1];
                    if (u.split) { float* pp = PART + ((size_t)u.slot * 512 + (row - u.pm * BM + (u.pm ? 256 : 0))) * D + col; *(f32x4*)pp = t0; *(f32x4*)(pp + 4) = t1; }
                    else { u32x4 ov; ov.x = pk2(t0[0], t0[1]); ov.y = pk2(t0[2], t0[3]); ov.z = pk2(t1[0], t1[1]); ov.w = pk2(t1[2], t1[3]); *(u32x4*)(T + o) = ov; } } }
    }
};
struct EpiBranch {
    static constexpr bool PERM = true;
    float* S; bf16_t* SB; const bf16_t* H; float* SCTX;
    __device__ __forceinline__ void operator()(const f32x4 (&acc)[2][2][4][2], const Unit& u, int wr, int wc, int fr, int fq) const {
        const int row0 = u.pm * BM + wr * 64 + fr, col0 = u.pn * BM + wc * 32 + 8 * fq; const int g = u.g;
#pragma unroll
        for (int ai = 0; ai < 2; ++ai)
#pragma unroll
            for (int m = 0; m < 4; ++m) { const int row = row0 + ai * HALF + m * 16;
#pragma unroll
                for (int bj = 0; bj < 2; ++bj) { const int col = col0 + bj * HALF;
                    float gt[8]; unpack8(*(const u32x4*)(H + (size_t)row * NPAD + C_GATE + g * D + col), gt);
                    float v[8];
#pragma unroll
                    for (int e = 0; e < 4; ++e) { v[e] = sigm(gt[e]) * acc[ai][bj][m][0][e]; v[4 + e] = sigm(gt[4 + e]) * acc[ai][bj][m][1][e]; }
                    if (u.split) { float* cp = SCTX + ((size_t)u.slot * 512 + (row - u.pm * BM + (u.pm ? 256 : 0))) * D + col;
                        *(f32x4*)cp = (f32x4){v[0], v[1], v[2], v[3]}; *(f32x4*)(cp + 4) = (f32x4){v[4], v[5], v[6], v[7]}; }
                    else {
                        bf16_t* sp = SB + (size_t)row * D + col;
                        if (g > 0) { float pv[8]; unpack8(*(const u32x4*)sp, pv);
#pragma unroll
                            for (int e = 0; e < 8; ++e) v[e] += pv[e]; }
                        u32x4 o; o.x = pk2(v[0], v[1]); o.y = pk2(v[2], v[3]); o.z = pk2(v[4], v[5]); o.w = pk2(v[6], v[7]); *(u32x4*)sp = o; } } }
    }
};
}

__device__ __forceinline__ void transpose_item(const float* __restrict__ W, int K, int N, bf16_t* __restrict__ WT, LAS float* scr, int item, int lane) {
    const int nblk = N / 32, kb = item / nblk, nb = item - kb * nblk, k0 = 64 * kb, n0 = 32 * nb;
#pragma unroll 8
    for (int i = 0; i < 32; ++i) { const int kk = 2 * i + (lane >> 5); scr[kk * 33 + (lane & 31)] = W[(size_t)(k0 + kk) * N + n0 + (lane & 31)]; }
    LDS_WAIT();
    const int c = lane & 7;
#pragma unroll
    for (int j = 0; j < 4; ++j) { const int n = (lane >> 3) + 8 * j; const LAS float* s = scr + (8 * c) * 33 + n;
        u32x4 o; o.x = pk2(s[0 * 33], s[1 * 33]); o.y = pk2(s[2 * 33], s[3 * 33]); o.z = pk2(s[4 * 33], s[5 * 33]); o.w = pk2(s[6 * 33], s[7 * 33]);
        *(u32x4*)(WT + (size_t)(n0 + n) * K + k0 + 8 * c) = o; }
    LDS_WAIT();
}

__device__ __forceinline__ void transpose_item64(const float* __restrict__ W, int K, int N, bf16_t* __restrict__ WT, LAS float* scr, int item, int lane) {
    const int nblk = (N + 63) >> 6, kb = item / nblk, nb = item - kb * nblk, k0 = 64 * kb, n0 = 64 * nb;
    const bool valid = (n0 + lane) < N;
    float wv[64];
    const float* wp = W + (size_t)k0 * N + n0 + (valid ? lane : 0);
#pragma unroll
    for (int i = 0; i < 64; ++i) wv[i] = __builtin_nontemporal_load(wp + (size_t)i * N);
#pragma unroll
    for (int i = 0; i < 64; ++i) scr[i * 65 + lane] = wv[i];
    LDS_WAIT();
#pragma unroll
    for (int j = 0; j < 8; ++j) { const int task = lane + 64 * j, n = task >> 3, c = task & 7; const LAS float* s = scr + (8 * c) * 65 + n;
        u32x4 o; o.x = pk2(s[0 * 65], s[1 * 65]); o.y = pk2(s[2 * 65], s[3 * 65]); o.z = pk2(s[4 * 65], s[5 * 65]); o.w = pk2(s[6 * 65], s[7 * 65]);
        if (n0 + n < N) *(u32x4*)(WT + (size_t)(n0 + n) * K + k0 + 8 * c) = o; }
    LDS_WAIT();
}

__device__ __forceinline__ void phase0(const Params& P, LAS unsigned char* lds) {
    const int tid = otid(), lane = tid & 63, wave = tid >> 6, G = gridDim.x;
    unsigned char* ws = P.ws;
    {
        LAS float* sil = (LAS float*)lds;
        LAS float* red = sil + 3 * 2048;
        for (int i = tid; i < 3 * 2048; i += NTHR) { const int v = i >> 11, k = i & 2047; const float x = (v < 2) ? P.in[1][v * 2048 + k] : P.in[3][k]; sil[i] = silu(x); }
        __syncthreads();
        for (int vb = blockIdx.x; vb < 256; vb += G) {
            const int colg = vb * 96, l = colg / 12288, cl = colg - l * 12288;
            if (tid < 504) {
                const int c4 = tid % 24, kg = tid / 24;
                f32x4 a0 = {0.f, 0.f, 0.f, 0.f}, a1 = a0, a2 = a0;
                const float* wp = P.in[4] + (size_t)l * 2048 * 12288 + cl + c4 * 4;
                int k = kg;
#pragma unroll 1
                for (; k + 21 * 15 < 2048; k += 21 * 16) {
                    f32x4 w[16];
#pragma unroll
                    for (int u = 0; u < 16; ++u) w[u] = __builtin_nontemporal_load((const f32x4*)(wp + (size_t)(k + 21 * u) * 12288));
#pragma unroll
                    for (int u = 0; u < 16; ++u) { a0 += sil[k + 21 * u] * w[u]; a1 += sil[2048 + k + 21 * u] * w[u]; a2 += sil[4096 + k + 21 * u] * w[u]; } }
                for (; k < 2048; k += 21) { const f32x4 w = *(const f32x4*)(wp + (size_t)k * 12288); a0 += sil[k] * w; a1 += sil[2048 + k] * w; a2 += sil[4096 + k] * w; }
                LAS float* rp = red + (kg * 24 + c4) * 12;
#pragma unroll
                for (int e = 0; e < 4; ++e) { rp[e] = a0[e]; rp[4 + e] = a1[e]; rp[8 + e] = a2[e]; }
            }
            __syncthreads();
            if (tid < 288) { const int c4 = tid / 12, ve = tid - c4 * 12, v = ve >> 2, e = ve & 3; float s = 0.f;
                for (int kg = 0; kg < 21; ++kg) s += red[(kg * 24 + c4) * 12 + ve];
                const int col = cl + c4 * 4 + e;
                ((float*)(ws + WS_MOD))[(size_t)(l * 3 + v) * 12288 + col] = s + P.in[5][l * 12288 + col]; }
            __syncthreads();
        }
    }
    {
        LAS float* feats = (LAS float*)lds;
        LAS float* hid1 = feats + 8 * 36;
        for (int item = blockIdx.x; item < 2 * 544; item += G) {
            const int l = item / 544, it = item - l * 544, lsel = it >= 512, L = lsel ? 256 : 4096, t0 = (lsel ? it - 512 : it) * 8;
            const int tt = tid >> 6, j = tid & 63, t = t0 + tt;
            if (j < 33) { float f;
                if (j == 0) f = (float)t / (float)(L - 1);
                else { const int bi = (j - 1) & 15; const float band = 1e-4f + (float)bi * ((15.f - 1e-4f) / 15.f); float rev = band * ((float)t / (float)L); rev = rev - floorf(rev);
                    f = (j <= 16) ? __builtin_amdgcn_cosf(rev) : -__builtin_amdgcn_sinf(rev); }
                feats[tt * 36 + j] = f; }
            __syncthreads();
            { const float* w1 = P.in[9] + (size_t)l * 33 * 64; float a = P.in[10][l * 64 + j];
              for (int f = 0; f < 33; ++f) a += feats[tt * 36 + f] * w1[f * 64 + j];
              hid1[tt * 64 + j] = sin_rad(a); }
            __syncthreads();
            { const float* w2 = P.in[11] + (size_t)l * 64 * 64; float a = P.in[12][l * 64 + j];
              for (int i = 0; i < 64; ++i) a += hid1[tt * 64 + i] * w2[i * 64 + j];
              float* hid = (float*)(ws + WS_HID + (size_t)l * SZ_HID1) + (lsel ? 64 * 4096 : 0);
              hid[(size_t)j * L + t] = sin_rad(a); }
            __syncthreads();
        }
    }
    if (tid == 0) (void)__hip_atomic_fetch_add((unsigned*)(ws + WS_BAR) + XB_CNT(xcc_id()), 1u, __ATOMIC_RELAXED, __HIP_MEMORY_SCOPE_AGENT);
    for (int i = blockIdx.x * NTHR + tid; i < DEPTH * 2 * 1024; i += G * NTHR) {
        const int l = i >> 11, dir = (i >> 10) & 1, ch = i & 1023;
        float x[DEPTH], mx = -1e30f;
#pragma unroll
        for (int q = 0; q < DEPTH; ++q) { x[q] = P.in[15][((size_t)dir * DEPTH + q) * 1024 + ch]; mx = fmaxf(mx, x[q]); }
        float den = 0.f, num = 0.f;
#pragma unroll
        for (int q = 0; q < DEPTH; ++q) { const float e = __expf(x[q] - mx); den += e; if (q >= 1 && q <= l) num += e; }
        ((float*)(ws + WS_LB))[i] = num / den;
    }
    for (int i = blockIdx.x * NTHR + tid; i < DEPTH * (NPAD - INC) * D / 8; i += G * NTHR) {
        const int per = (NPAD - INC) * D / 8, l = i / per, r = i - l * per;
        ((u32x4*)(ws + WS_WIN + (size_t)l * SZ_WIN + (size_t)INC * D * 2))[r] = (u32x4){0u, 0u, 0u, 0u};
    }
    {
        LAS float* scr = (LAS float*)(lds + wave * 16896);
        const int gw = blockIdx.x * NWAVES + wave, NGW = G * NWAVES;
        constexpr int I_IN = 32 * 273, I_BR = 16 * 32, I_OUT = 32 * 32, I_F1 = 32 * 128, I_F2 = 128 * 32;
        constexpr int PER = I_IN + 3 * I_BR + I_OUT + I_F1 + I_F2;
        for (int it = gw; it < (DEPTH - 1) * PER; it += NGW) {
            const int l = it / PER; int r = it - l * PER;
            if (r < I_IN) { transpose_item64(P.in[6] + (size_t)l * D * INC, D, INC, (bf16_t*)(ws + WS_WIN + (size_t)l * SZ_WIN), scr, r, lane); continue; } r -= I_IN;
            if (r < 3 * I_BR) { const int g = r / I_BR; transpose_item64(P.in[23] + (size_t)(l * 3 + g) * 1024 * D, 1024, D, (bf16_t*)(ws + WS_WBR + (size_t)(l * 3 + g) * SZ_WBR), scr, r - g * I_BR, lane); continue; } r -= 3 * I_BR;
            if (r < I_OUT) { transpose_item64(P.in[24] + (size_t)l * D * D, D, D, (bf16_t*)(ws + WS_WOUT + (size_t)l * SZ_WOUT), scr, r, lane); continue; } r -= I_OUT;
            if (r < I_F1) { transpose_item64(P.in[27] + (size_t)l * D * DFF, D, DFF, (bf16_t*)(ws + WS_WFF1 + (size_t)l * SZ_WFF), scr, r, lane); continue; } r -= I_F1;
            transpose_item64(P.in[28] + (size_t)l * DFF * D, DFF, D, (bf16_t*)(ws + WS_WFF2 + (size_t)l * SZ_WFF), scr, r, lane);
        }
    }
}

__device__ __forceinline__ void init_rows(const Params& P) {
    const int tid = otid(); const int lane = tid & 63, gw = blockIdx.x * NWAVES + (tid >> 6), NGW = gridDim.x * NWAVES;
    float* X = (float*)(P.ws + WS_X); bf16_t* U = (bf16_t*)(P.ws + WS_U); const float* mod = (const float*)(P.ws + WS_MOD);
#define INIT_SRC(r_) (((r_) % TPB) < CTX ? P.in[2] + ((size_t)((r_) / TPB) * CTX + ((r_) % TPB)) * D : P.in[0] + ((size_t)((r_) / TPB) * SEQ + (((r_) % TPB) - CTX)) * D)
    f32x4 cv[8];
#pragma unroll
    for (int j = 0; j < 8; ++j) cv[j] = (f32x4){0.f, 0.f, 0.f, 0.f};
    if (gw < M) { const float* s0 = INIT_SRC(gw);
#pragma unroll
        for (int j = 0; j < 8; ++j) cv[j] = __builtin_nontemporal_load((const f32x4*)(s0 + ((j >> 1) * 64 + lane) * 8 + (j & 1) * 4)); }
#pragma unroll 1
    for (int r = gw; r < M; r += NGW) {
        const int b = r / TPB, p = r - b * TPB; const bool isctx = p < CTX;
        f32x4 nv[8];
#pragma unroll
        for (int j = 0; j < 8; ++j) nv[j] = (f32x4){0.f, 0.f, 0.f, 0.f};
        if (r + NGW < M) { const float* s1 = INIT_SRC(r + NGW);
#pragma unroll
            for (int j = 0; j < 8; ++j) nv[j] = __builtin_nontemporal_load((const f32x4*)(s1 + ((j >> 1) * 64 + lane) * 8 + (j & 1) * 4)); }
        const float* mv = mod + (size_t)(isctx ? 2 : b) * (6 * D);
#pragma unroll
        for (int jj = 0; jj < 4; ++jj) { const int c = (jj * 64 + lane) * 8; const f32x4 v0 = cv[2 * jj], v1 = cv[2 * jj + 1];
            *(f32x4*)(X + (size_t)r * D + c) = v0; *(f32x4*)(X + (size_t)r * D + c + 4) = v1;
            const f32x4 y0 = v0 * (1.f + *(const f32x4*)(mv + D + c)) + *(const f32x4*)(mv + c), y1 = v1 * (1.f + *(const f32x4*)(mv + D + c + 4)) + *(const f32x4*)(mv + c + 4);
            u32x4 o; o.x = pk2(y0[0], y0[1]); o.y = pk2(y0[2], y0[3]); o.z = pk2(y1[0], y1[1]); o.w = pk2(y1[2], y1[3]); *(u32x4*)(U + (size_t)r * D + c) = o; }
#pragma unroll
        for (int j = 0; j < 8; ++j) cv[j] = nv[j];
    }
#undef INIT_SRC
}
__device__ __forceinline__ void ln_rows(const Params& P, const float* gam, const float* bet, const float* modU, int shidx, bool writeU, bool writeOut, int nsplit, bool skipctx) {
    const int tid = otid(); const int lane = tid & 63, gw = blockIdx.x * NWAVES + (tid >> 6), NGW = gridDim.x * NWAVES;
    float* X = (float*)(P.ws + WS_X); bf16_t* U = (bf16_t*)(P.ws + WS_U); const bf16_t* T = (const bf16_t*)(P.ws + WS_SO + (size_t)M * D * 4);
    f32x4 gv[8], bv[8];
#pragma unroll
    for (int j = 0; j < 8; ++j) { const int c = ((j >> 1) * 64 + lane) * 8 + (j & 1) * 4; gv[j] = *(const f32x4*)(gam + c); bv[j] = *(const f32x4*)(bet + c); }
    int r = gw;
    while (r < M && skipctx && (r % TPB) < CTX) r += NGW;
    f32x4 cx[8]; u32x4 ct[4]; bool pf = false;
#pragma unroll
    for (int j = 0; j < 8; ++j) cx[j] = (f32x4){0.f, 0.f, 0.f, 0.f};
#pragma unroll
    for (int j = 0; j < 4; ++j) ct[j] = (u32x4){0u, 0u, 0u, 0u};
    if (r < M && !((r % TPB) < CTX && nsplit > 0)) { pf = true;
#pragma unroll
        for (int jj = 0; jj < 4; ++jj) { const int c = (jj * 64 + lane) * 8; cx[2 * jj] = *(const f32x4*)(X + (size_t)r * D + c); cx[2 * jj + 1] = *(const f32x4*)(X + (size_t)r * D + c + 4); ct[jj] = *(const u32x4*)(T + (size_t)r * D + c); } }
#pragma unroll 1
    while (r < M) {
        int rn = r + NGW;
        while (rn < M && skipctx && (rn % TPB) < CTX) rn += NGW;
        f32x4 nx[8]; u32x4 nt[4]; bool npf = false;
#pragma unroll
        for (int j = 0; j < 8; ++j) nx[j] = (f32x4){0.f, 0.f, 0.f, 0.f};
#pragma unroll
        for (int j = 0; j < 4; ++j) nt[j] = (u32x4){0u, 0u, 0u, 0u};
        if (rn < M && !((rn % TPB) < CTX && nsplit > 0)) { npf = true;
#pragma unroll
            for (int jj = 0; jj < 4; ++jj) { const int c = (jj * 64 + lane) * 8; nx[2 * jj] = *(const f32x4*)(X + (size_t)rn * D + c); nx[2 * jj + 1] = *(const f32x4*)(X + (size_t)rn * D + c + 4); nt[jj] = *(const u32x4*)(T + (size_t)rn * D + c); } }
        const int b = r / TPB, p = r - b * TPB; const bool isctx = p < CTX;
        f32x4 v[8]; float s = 0.f;
#pragma unroll
        for (int j = 0; j < 8; ++j) { const int c = ((j >> 1) * 64 + lane) * 8 + (j & 1) * 4;
            if (!pf) {
                f32x4 a = *(const f32x4*)(X + (size_t)r * D + c) * ALPHA; const float* pp = (const float*)(P.ws + WS_SCTX) + ((size_t)b * 256 + p) * D + c;
                for (int q = 0; q < nsplit; ++q) a += *(const f32x4*)(pp + (size_t)q * 512 * D);
                v[j] = a; }
            else { const unsigned t0 = (j & 1) ? ct[j >> 1].z : ct[j >> 1].x, t1 = (j & 1) ? ct[j >> 1].w : ct[j >> 1].y;
                v[j] = cx[j] * ALPHA + (f32x4){bflo(t0), bfhi(t0), bflo(t1), bfhi(t1)}; }
            s += (v[j][0] + v[j][1]) + (v[j][2] + v[j][3]); }
        const float mean = wave_sum(s) * (1.f / D); float s2 = 0.f;
#pragma unroll
        for (int j = 0; j < 8; ++j) { v[j] = v[j] - mean; s2 += (v[j][0] * v[j][0] + v[j][1] * v[j][1]) + (v[j][2] * v[j][2] + v[j][3] * v[j][3]); }
        const float rstd = __builtin_amdgcn_rsqf(wave_sum(s2) * (1.f / D) + 1e-5f);
        const float* mv = modU + (size_t)(isctx ? 2 : b) * (6 * D) + (size_t)shidx * D;
#pragma unroll
        for (int jj = 0; jj < 4; ++jj) { const int c = (jj * 64 + lane) * 8;
            const f32x4 y0 = v[2 * jj] * rstd * gv[2 * jj] + bv[2 * jj], y1 = v[2 * jj + 1] * rstd * gv[2 * jj + 1] + bv[2 * jj + 1];
            if (!writeOut) { *(f32x4*)(X + (size_t)r * D + c) = y0; *(f32x4*)(X + (size_t)r * D + c + 4) = y1; }
            if (writeU) { const f32x4 sh0 = *(const f32x4*)(mv + c), sc0 = *(const f32x4*)(mv + D + c), sh1 = *(const f32x4*)(mv + c + 4), sc1 = *(const f32x4*)(mv + D + c + 4);
                const f32x4 z0 = y0 * (1.f + sc0) + sh0, z1 = y1 * (1.f + sc1) + sh1;
                u32x4 o; o.x = pk2(z0[0], z0[1]); o.y = pk2(z0[2], z0[3]); o.z = pk2(z1[0], z1[1]); o.w = pk2(z1[2], z1[3]); *(u32x4*)(U + (size_t)r * D + c) = o; }
            if (writeOut && !isctx) { float* op = P.out + ((size_t)b * SEQ + (p - CTX)) * D + c; *(f32x4*)op = y0; *(f32x4*)(op + 4) = y1; } }
#pragma unroll
        for (int j = 0; j < 8; ++j) cx[j] = nx[j];
#pragma unroll
        for (int j = 0; j < 4; ++j) ct[j] = nt[j];
        pf = npf; r = rn;
    }
}

__device__ __forceinline__ void prep_phase(const Params& P, int l, LAS unsigned char* lds) {
    const int tid = otid(), lane = tid & 63, wave = tid >> 6, G = gridDim.x;
    const int gw = blockIdx.x * NWAVES + wave, NGW = G * NWAVES;
    unsigned char* ws = P.ws;
    const bf16_t* H = (const bf16_t*)(ws + WS_H);
    float* DNK = (float*)(ws + WS_DN + OFF_DNK); float* DNQ = (float*)(ws + WS_DN + OFF_DNQ); float* DNV = (float*)(ws + WS_DN + OFF_DNV); float* DNS = (float*)(ws + WS_DN + OFF_DNS);
    {
        const u32x4 z4 = {0u, 0u, 0u, 0u};
#define DNP_LOAD(hu, ga, gb, row) do { const int p_ = (row) % TPB; \
            const bool hasL_ = (p_ < CTX) ? (p_ > 0) : ((p_ & 63) != 0), hasR_ = (p_ < CTX) ? (p_ < CTX - 1) : ((p_ & 63) != 63); \
            const bf16_t* h_ = H + (size_t)(row) * NPAD; \
            _Pragma("unroll") for (int w_ = 0; w_ < 4; ++w_) { const int col_ = (w_ == 0 ? C_DNK : w_ == 1 ? C_DNQ : C_DNV + (w_ - 2) * 512) + lane * 8; \
                hu[3 * w_ + 0] = hasL_ ? *(const u32x4*)(h_ - NPAD + col_) : z4; hu[3 * w_ + 1] = *(const u32x4*)(h_ + col_); hu[3 * w_ + 2] = hasR_ ? *(const u32x4*)(h_ + NPAD + col_) : z4; } \
            ga = h_[C_DNA + (lane & 15)]; gb = h_[C_DNB + (lane & 15)]; } while (0)
        float cwk[3][8], cwq[3][8], cwv[2][3][8];
#pragma unroll
        for (int j = 0; j < 3; ++j)
#pragma unroll
            for (int e = 0; e < 8; ++e) { cwk[j][e] = P.in[18][(size_t)l * 3 * 512 + j * 512 + lane * 8 + e]; cwq[j][e] = P.in[17][(size_t)l * 3 * 512 + j * 512 + lane * 8 + e];
                cwv[0][j][e] = P.in[19][(size_t)l * 3 * 1024 + j * 1024 + lane * 8 + e]; cwv[1][j][e] = P.in[19][(size_t)l * 3 * 1024 + j * 1024 + 512 + lane * 8 + e]; }
        int r = gw;
        u32x4 ch_[12]; bf16_t cga = 0, cgb = 0;
#pragma unroll
        for (int i = 0; i < 12; ++i) ch_[i] = z4;
        if (r < M) DNP_LOAD(ch_, cga, cgb, r);
#pragma unroll 1
        while (r < M) {
            const int rn_ = r + NGW;
            u32x4 nh_[12]; bf16_t nga = 0, ngb = 0;
#pragma unroll
            for (int i = 0; i < 12; ++i) nh_[i] = z4;
            if (rn_ < M) DNP_LOAD(nh_, nga, ngb, rn_);
            float kn[8], qn[8];
#pragma unroll
            for (int which = 0; which < 2; ++which) {
                float xm[8], x0[8], xp[8]; unpack8(ch_[3 * which], xm); unpack8(ch_[3 * which + 1], x0); unpack8(ch_[3 * which + 2], xp);
                float y[8], ss = 0.f;
#pragma unroll
                for (int e = 0; e < 8; ++e) { y[e] = silu(xm[e] * (which ? cwq[0][e] : cwk[0][e]) + x0[e] * (which ? cwq[1][e] : cwk[1][e]) + xp[e] * (which ? cwq[2][e] : cwk[2][e])); ss += y[e] * y[e]; }
                ss = row_sum16(ss);
                const float rn = __builtin_amdgcn_rsqf(ss + 1e-6f) * (which ? 0.08838834764831845f : 1.f);
#pragma unroll
                for (int e = 0; e < 8; ++e) { if (which) qn[e] = y[e] * rn; else kn[e] = y[e] * rn; }
            }
            float qk = 0.f;
#pragma unroll
            for (int e = 0; e < 8; ++e) qk += qn[e] * kn[e];
            qk = row_sum16(qk);
            *(f32x4*)(DNK + (size_t)r * 512 + lane * 8) = (f32x4){kn[0], kn[1], kn[2], kn[3]}; *(f32x4*)(DNK + (size_t)r * 512 + lane * 8 + 4) = (f32x4){kn[4], kn[5], kn[6], kn[7]};
            *(f32x4*)(DNQ + (size_t)r * 512 + lane * 8) = (f32x4){qn[0], qn[1], qn[2], qn[3]}; *(f32x4*)(DNQ + (size_t)r * 512 + lane * 8 + 4) = (f32x4){qn[4], qn[5], qn[6], qn[7]};
#pragma unroll
            for (int half = 0; half < 2; ++half) {
                const int cc = half * 512 + lane * 8;
                float xm[8], x0[8], xp[8]; unpack8(ch_[6 + 3 * half], xm); unpack8(ch_[6 + 3 * half + 1], x0); unpack8(ch_[6 + 3 * half + 2], xp);
                float y[8];
#pragma unroll
                for (int e = 0; e < 8; ++e) y[e] = silu(xm[e] * cwv[half][0][e] + x0[e] * cwv[half][1][e] + xp[e] * cwv[half][2][e]);
                *(f32x4*)(DNV + (size_t)r * 1024 + cc) = (f32x4){y[0], y[1], y[2], y[3]}; *(f32x4*)(DNV + (size_t)r * 1024 + cc + 4) = (f32x4){y[4], y[5], y[6], y[7]};
            }
            {
                const int hd = lane & 7, dir = (lane >> 3) & 1;
                const float qkh = __shfl(qk, 16 * (hd >> 1));
                if (lane < 16) {
                    const float araw = bf1(cga), braw = bf1(cgb);
                    const float xx = araw + P.in[21][(l * 2 + dir) * 8 + hd];
                    float sp; if (xx > 15.f) sp = xx; else { const float e = __expf(xx); sp = (e < 1e-3f) ? e * (1.f - e * (0.5f - e * (1.f / 3.f))) : __logf(1.f + e); }
                    const float gg = -__expf(P.in[20][(l * 2 + dir) * 8 + hd]) * sp;
                    *(f32x4*)(DNS + ((size_t)r * 16 + dir * 8 + hd) * 4) = (f32x4){__expf(gg), sigm(braw), qkh, gg};
                }
            }
#pragma unroll
            for (int i = 0; i < 12; ++i) ch_[i] = nh_[i];
            cga = nga; cgb = ngb; r = rn_;
        }
#undef DNP_LOAD
    }
    {
        LAS float* L = (LAS float*)lds;
        unsigned* ZT = (unsigned*)(ws + WS_ZT);
#define HYP_LOAD(hv_, item_) do { const int ti_ = (item_) / 48, ct_ = (item_) - ti_ * 48; \
            _Pragma("unroll") for (int u = 0; u < 2; ++u) { const int rowi = (tid >> 3) + 64 * u, bb = rowi >> 6, tt = rowi & 63, ch8 = tid & 7; \
                hv_[u] = *(const u32x4*)(H + ((size_t)bb * TPB + CTX + ti_ * 64 + tt) * NPAD + C_HY + ct_ * 64 + ch8 * 8); } } while (0)
        u32x4 chv[2] = {(u32x4){0u, 0u, 0u, 0u}, (u32x4){0u, 0u, 0u, 0u}};
        if ((int)blockIdx.x < 64 * 48) HYP_LOAD(chv, blockIdx.x);
#pragma unroll 1
        for (int item = blockIdx.x; item < 64 * 48; item += G) {
            const int ti = item / 48, ct = item - ti * 48;
            u32x4 nhv[2] = {(u32x4){0u, 0u, 0u, 0u}, (u32x4){0u, 0u, 0u, 0u}};
            if (item + G < 64 * 48) HYP_LOAD(nhv, item + G);
#pragma unroll
            for (int u = 0; u < 2; ++u) { const int rowi = (tid >> 3) + 64 * u, bb = rowi >> 6, tt = rowi & 63, ch8 = tid & 7;
                float f[8]; unpack8(chv[u], f);
#pragma unroll
                for (int e = 0; e < 8; ++e) L[(bb * 64 + tt) * 65 + ch8 * 8 + e] = f[e]; }
            asm volatile("s_waitcnt lgkmcnt(0)" ::: "memory"); __builtin_amdgcn_s_barrier(); asm volatile("" ::: "memory");
            { const int tt = tid & 63;
#pragma unroll
              for (int u = 0; u < 8; ++u) { const int cc = (tid >> 6) + 8 * u, ch = ct * 64 + cc;
                const float* cw = P.in[7] + (size_t)l * 3 * 3072 + ch; const float w0 = cw[0], w1 = cw[3072], w2 = cw[6144], bias = P.in[8][l * 3072 + ch];
                f32x2 o;
#pragma unroll
                for (int bb = 0; bb < 2; ++bb) { const LAS float* lp = L + (bb * 64 + tt) * 65 + cc;
                    const float xm = tt > 0 ? lp[-65] : 0.f, xp = tt < 63 ? lp[65] : 0.f; o[bb] = xm * w0 + lp[0] * w1 + xp * w2 + bias; }
                ZT[(size_t)ch * 4096 + ti * 64 + tt] = pk2(o[0], o[1]); } }
            asm volatile("s_waitcnt lgkmcnt(0)" ::: "memory"); __builtin_amdgcn_s_barrier(); asm volatile("" ::: "memory");
            chv[0] = nhv[0]; chv[1] = nhv[1];
        }
#undef HYP_LOAD
    }
    if (l == 0) {
        float* ZC = (float*)(ws + WS_ZC);
        const u32x4 z4 = {0u, 0u, 0u, 0u};
        for (int i8 = blockIdx.x * NTHR + tid; i8 < 2 * 256 * 384; i8 += G * NTHR) {
            const int ch = (i8 % 384) * 8, bt = i8 / 384, t = bt & 255, bb = bt >> 8;
            const bf16_t* hp = H + ((size_t)bb * TPB + t) * NPAD + C_HY + ch;
            float xm[8], x0[8], xp[8]; unpack8(t > 0 ? *(const u32x4*)(hp - NPAD) : z4, xm); unpack8(*(const u32x4*)hp, x0); unpack8(t < 255 ? *(const u32x4*)(hp + NPAD) : z4, xp);
            const float* cw = P.in[7] + ch; const float* cb = P.in[8] + ch;
            float y[8];
#pragma unroll
            for (int e = 0; e < 8; ++e) y[e] = xm[e] * cw[e] + x0[e] * cw[3072 + e] + xp[e] * cw[6144 + e] + cb[e];
            float* zp = ZC + (size_t)bt * 3072 + ch;
            *(f32x4*)zp = (f32x4){y[0], y[1], y[2], y[3]}; *(f32x4*)(zp + 4) = (f32x4){y[4], y[5], y[6], y[7]};
        }
    }
}

__device__ __forceinline__ void chunkprep_phase(const Params& P, LAS unsigned char* lds) {
    const int tid = otid(), lane = tid & 63, wave = tid >> 6, t = lane & 15, kq = lane >> 4;
    const int gw = blockIdx.x * NWAVES + wave, NGW = gridDim.x * NWAVES;
    unsigned char* ws = P.ws;
    const float* DNK = (const float*)(ws + WS_DN + OFF_DNK); const float* DNQ = (const float*)(ws + WS_DN + OFF_DNQ); const float* DNS = (const float*)(ws + WS_DN + OFF_DNS);
    LAS float* Kf = (LAS float*)(lds + wave * 16384);
    LAS bf16_t* Wb = (LAS bf16_t*)(Kf + 16 * 132);
    LAS float* Am = (LAS float*)(Wb + 16 * 136);
    LAS float* St = Am + 256;
    LAS float* Tt = St + 272;
    LAS float* be = Tt + 272;
#pragma unroll 1
    for (int task = gw; task < NTASK; task += NGW) {
        const int c = task % NCHUNK, grp = task / NCHUNK, dir = grp & 1, h = (grp >> 1) & 7, b = grp >> 4;
        const int n0 = c * 16, plo = dir ? (n0 < 256 ? 240 - n0 : TPB + 240 - n0) : n0;
        const size_t prow = (size_t)b * TPB + (dir ? plo + 15 - t : plo + t);
        const float* kp = DNK + prow * 512 + (h >> 1) * 128 + 4 * kq; const float* qp = DNQ + prow * 512 + (h >> 1) * 128 + 4 * kq;
        f32x4 ka[4], kb[4], qa[4], qb[4];
#pragma unroll
        for (int j = 0; j < 4; ++j) { ka[j] = *(const f32x4*)(kp + 32 * j); kb[j] = *(const f32x4*)(kp + 32 * j + 16); qa[j] = *(const f32x4*)(qp + 32 * j); qb[j] = *(const f32x4*)(qp + 32 * j + 16); }
        const f32x4 sc = *(const f32x4*)(DNS + (prow * 16 + dir * 8 + h) * 4);
        const float beta = sc[1];
        float gc = sc[3];
        gc += dppf<0x111>(gc); gc += dppf<0x112>(gc); gc += dppf<0x114>(gc); gc += dppf<0x118>(gc);
        const float gC = __shfl(gc, 15);
        const float egc = __expf(gc);
#pragma unroll
        for (int j = 0; j < 4; ++j) { *(LAS f32x4*)(Kf + t * 132 + 32 * j + 4 * kq) = ka[j]; *(LAS f32x4*)(Kf + t * 132 + 32 * j + 16 + 4 * kq) = kb[j]; }
        if (kq == 0) be[t] = beta * egc;
        f32x4 KK = {0.f, 0.f, 0.f, 0.f}, QK = KK;
#pragma unroll
        for (int j = 0; j < 4; ++j) {
            float kv[8] = {ka[j][0], ka[j][1], ka[j][2], ka[j][3], kb[j][0], kb[j][1], kb[j][2], kb[j][3]};
            float qv[8] = {qa[j][0], qa[j][1], qa[j][2], qa[j][3], qb[j][0], qb[j][1], qb[j][2], qb[j][3]};
            u32x4 kh, kl, qh, ql;
#pragma unroll
            for (int e = 0; e < 4; ++e) { const unsigned hh = pk2n(kv[2 * e], kv[2 * e + 1]); kh[e] = hh; kl[e] = pk2n(kv[2 * e] - bflo(hh), kv[2 * e + 1] - bfhi(hh));
                const unsigned gh = pk2n(qv[2 * e], qv[2 * e + 1]); qh[e] = gh; ql[e] = pk2n(qv[2 * e] - bflo(gh), qv[2 * e + 1] - bfhi(gh)); }
            const bf16x8 Kh = __builtin_bit_cast(bf16x8, kh), Kl = __builtin_bit_cast(bf16x8, kl), Qh = __builtin_bit_cast(bf16x8, qh), Ql = __builtin_bit_cast(bf16x8, ql);
            KK = __builtin_amdgcn_mfma_f32_16x16x32_bf16(Kh, Kh, KK, 0, 0, 0); KK = __builtin_amdgcn_mfma_f32_16x16x32_bf16(Kh, Kl, KK, 0, 0, 0); KK = __builtin_amdgcn_mfma_f32_16x16x32_bf16(Kl, Kh, KK, 0, 0, 0);
            QK = __builtin_amdgcn_mfma_f32_16x16x32_bf16(Qh, Kh, QK, 0, 0, 0); QK = __builtin_amdgcn_mfma_f32_16x16x32_bf16(Qh, Kl, QK, 0, 0, 0); QK = __builtin_amdgcn_mfma_f32_16x16x32_bf16(Ql, Kh, QK, 0, 0, 0);
            u32x4 fq; fq[0] = pk2n(qv[0] * egc, qv[1] * egc); fq[1] = pk2n(qv[2] * egc, qv[3] * egc); fq[2] = pk2n(qv[4] * egc, qv[5] * egc); fq[3] = pk2n(qv[6] * egc, qv[7] * egc);
            *(u32x4*)(ws + WS_CP1 + (size_t)task * CP1_STRIDE + 4096 + (size_t)(j * 64 + lane) * 16) = fq;
        }
#pragma unroll
        for (int e = 0; e < 4; ++e) { const int tp = 4 * kq + e; const float gct = __shfl(gc, tp), bt = __shfl(beta, tp);
            const float dec = __expf(fminf(gct - gc, 0.f));
            Am[tp * 16 + t] = (t < tp) ? bt * KK[e] * dec : 0.f;
            St[tp * 17 + t] = (t <= tp) ? QK[e] * dec : 0.f; }
        LDS_WAIT();
        {
            u32x2 fa; fa[0] = pk2n(St[t * 17 + 4 * kq], St[t * 17 + 4 * kq + 1]); fa[1] = pk2n(St[t * 17 + 4 * kq + 2], St[t * 17 + 4 * kq + 3]);
            *(u32x2*)(ws + WS_CP2 + (size_t)task * CP2_STRIDE + (size_t)lane * 8) = fa;
            float ds[4];
#pragma unroll
            for (int e = 0; e < 4; ++e) ds[e] = __expf(gC - __shfl(gc, 4 * kq + e));
#pragma unroll
            for (int m = 0; m < 8; ++m) { u32x2 fk;
                fk[0] = pk2n(Kf[(4 * kq + 0) * 132 + 16 * m + t] * ds[0], Kf[(4 * kq + 1) * 132 + 16 * m + t] * ds[1]);
                fk[1] = pk2n(Kf[(4 * kq + 2) * 132 + 16 * m + t] * ds[2], Kf[(4 * kq + 3) * 132 + 16 * m + t] * ds[3]);
                *(u32x2*)(ws + WS_CPK + (size_t)task * 4096 + (size_t)(m * 64 + lane) * 8) = fk; }
        }
#pragma unroll 1
        for (int pass = 0; pass < 3; ++pass) {
            if (pass < 2 || lane < 16) {
                const int col = (pass & 1) * 64 + lane;
                float x[16];
#pragma unroll
                for (int tt = 0; tt < 16; ++tt) {
                    float acc = (pass < 2) ? be[tt] * Kf[tt * 132 + col] : ((tt == lane) ? 1.f : 0.f);
#pragma unroll
                    for (int s = 0; s < tt; ++s) acc -= Am[tt * 16 + s] * x[s];
                    x[tt] = acc;
                    if (pass < 2) Wb[tt * 136 + col] = (bf16_t)(pk2n(acc, 0.f) & 0xffffu); else Tt[tt * 17 + lane] = acc; }
            }
        }
        LDS_WAIT();
        {
#pragma unroll
            for (int j = 0; j < 4; ++j) { const u32x2 lo = *(const LAS u32x2*)(Wb + t * 136 + 32 * j + 4 * kq), hi = *(const LAS u32x2*)(Wb + t * 136 + 32 * j + 16 + 4 * kq);
                *(u32x4*)(ws + WS_CP1 + (size_t)task * CP1_STRIDE + (size_t)(j * 64 + lane) * 16) = (u32x4){lo[0], lo[1], hi[0], hi[1]}; }
            u32x2 ft; ft[0] = pk2n(Tt[t * 17 + 4 * kq], Tt[t * 17 + 4 * kq + 1]); ft[1] = pk2n(Tt[t * 17 + 4 * kq + 2], Tt[t * 17 + 4 * kq + 3]);
            *(u32x2*)(ws + WS_CP2 + (size_t)task * CP2_STRIDE + 512 + (size_t)lane * 8) = ft;
            float* misc = (float*)(ws + WS_CP2 + (size_t)task * CP2_STRIDE + 1024);
            if (lane < 16) misc[lane] = beta; else if (lane == 16) misc[16] = __expf(gC);
        }
        LDS_WAIT();
    }
}

__device__ __forceinline__ void hgprep_phase(const Params& P, int l, LAS unsigned char* lds) {
    const int tid = otid(), lane = tid & 63, wave = tid >> 6, t = lane & 15, kq = lane >> 4;
    const int gw = blockIdx.x * NWAVES + wave, NGW = gridDim.x * NWAVES;
    unsigned char* ws = P.ws;
    const bf16_t* H = (const bf16_t*)(ws + WS_H);
    LAS float* Kf = (LAS float*)(lds + wave * 16384);
    LAS float* St = Kf + 16 * 132;
#pragma unroll 1
    for (int task = gw; task < NTASK; task += NGW) {
        const int c = task % NCHUNK, grp = task / NCHUNK, dir = grp & 1, h = (grp >> 1) & 7, b = grp >> 4;
        const int n0 = c * 16, plo = dir ? (n0 < 256 ? 240 - n0 : TPB + 240 - n0) : n0;
        const size_t prow = (size_t)b * TPB + (dir ? plo + 15 - t : plo + t);
        const bf16_t* hp = H + prow * NPAD + h * 128 + 4 * kq;
        const float* lbp = (const float*)(ws + WS_LB) + ((size_t)l * 2 + dir) * 1024 + h * 128 + 4 * kq;
        float L[32], kk[32], q[32];
#pragma unroll
        for (int j = 0; j < 4; ++j)
#pragma unroll
            for (int hh = 0; hh < 2; ++hh) { const int ko = 32 * j + 16 * hh;
                const u32x2 fr = *(const u32x2*)(hp + (dir ? C_HGFB : C_HGFF) + ko), qr = *(const u32x2*)(hp + C_HGQ + ko); const f32x4 lb = *(const f32x4*)(lbp + ko);
                const float fx[4] = {bflo(fr[0]), bfhi(fr[0]), bflo(fr[1]), bfhi(fr[1])}, qx[4] = {bflo(qr[0]), bfhi(qr[0]), bflo(qr[1]), bfhi(qr[1])};
#pragma unroll
                for (int e = 0; e < 4; ++e) { const int ix = 8 * j + 4 * hh + e; const float f = lb[e] + (1.f - lb[e]) * sigm(fx[e]);
                    L[ix] = __logf(fmaxf(f, 1e-30f)); kk[ix] = 1.f - f; q[ix] = silu(qx[e]); } }
        float Lt15[32];
#pragma unroll
        for (int ix = 0; ix < 32; ++ix) { float x = L[ix]; Lt15[ix] = row_sum16(x); x += dppf<0x111>(x); x += dppf<0x112>(x); x += dppf<0x114>(x); x += dppf<0x118>(x); L[ix] = x; }
        f32x4 Att = {0.f, 0.f, 0.f, 0.f};
#pragma unroll
        for (int j = 0; j < 4; ++j) {
            u32x4 fqv, qp, kp; float khat[8];
#pragma unroll
            for (int e2 = 0; e2 < 4; ++e2) {
                float qt[2], qq[2], kx[2];
#pragma unroll
                for (int z = 0; z < 2; ++z) { const int ix = 8 * j + 2 * e2 + z; const float Lt = L[ix];
                    const float L15 = Lt15[ix];
                    qt[z] = q[ix] * __expf(Lt);
                    const float d = fminf(Lt - L15, 80.f);
                    qq[z] = q[ix] * __expf(d); kx[z] = kk[ix] * __expf(-d);
                    khat[2 * e2 + z] = kx[z];
                    if (t == 15) ((float*)(ws + WS_HGA + (size_t)task * 1024 + 512))[32 * j + 16 * ((2 * e2 + z) >> 2) + 4 * kq + ((2 * e2 + z) & 3)] = __expf(Lt); }
                fqv[e2] = pk2n(qt[0], qt[1]); qp[e2] = pk2n(qq[0], qq[1]); kp[e2] = pk2n(kx[0], kx[1]); }
            *(u32x4*)(ws + WS_HGQ + (size_t)task * 4096 + (size_t)(j * 64 + lane) * 16) = fqv;
            Att = __builtin_amdgcn_mfma_f32_16x16x32_bf16(__builtin_bit_cast(bf16x8, qp), __builtin_bit_cast(bf16x8, kp), Att, 0, 0, 0);
            *(LAS f32x4*)(Kf + t * 132 + 32 * j + 4 * kq) = (f32x4){khat[0], khat[1], khat[2], khat[3]};
            *(LAS f32x4*)(Kf + t * 132 + 32 * j + 16 + 4 * kq) = (f32x4){khat[4], khat[5], khat[6], khat[7]};
        }
#pragma unroll
        for (int e = 0; e < 4; ++e) { const int tp = 4 * kq + e; St[tp * 17 + t] = (t <= tp) ? Att[e] : 0.f; }
        LDS_WAIT();
        { u32x2 fa; fa[0] = pk2n(St[t * 17 + 4 * kq], St[t * 17 + 4 * kq + 1]); fa[1] = pk2n(St[t * 17 + 4 * kq + 2], St[t * 17 + 4 * kq + 3]);
          *(u32x2*)(ws + WS_HGA + (size_t)task * 1024 + (size_t)lane * 8) = fa;
#pragma unroll
          for (int m = 0; m < 8; ++m) { u32x2 fk;
              fk[0] = pk2n(Kf[(4 * kq + 0) * 132 + 16 * m + t], Kf[(4 * kq + 1) * 132 + 16 * m + t]);
              fk[1] = pk2n(Kf[(4 * kq + 2) * 132 + 16 * m + t], Kf[(4 * kq + 3) * 132 + 16 * m + t]);
              *(u32x2*)(ws + WS_HGK + (size_t)task * 4096 + (size_t)(m * 64 + lane) * 8) = fk; } }
        LDS_WAIT();
    }
}

constexpr int T32_IN = 32 * 545, T32_BR = 16 * 64, T32_OUT = 32 * 64, T32_F1 = 32 * 256, T32_F2 = 128 * 64, T32_PER = T32_IN + 3 * T32_BR + T32_OUT + T32_F1 + T32_F2;
struct TItem { const float* W; bf16_t* WT; int K, N, k0, n0; };
__device__ __forceinline__ TItem titem_decode(const Params& P, int l, int r) {
    unsigned char* ws = P.ws; TItem t; int item;
    if (r < T32_IN) { t.W = P.in[6] + (size_t)l * D * INC; t.K = D; t.N = INC; t.WT = (bf16_t*)(ws + WS_WIN + (size_t)l * SZ_WIN); item = r; }
    else if ((r -= T32_IN) < 3 * T32_BR) { const int g = r / T32_BR; t.W = P.in[23] + (size_t)(l * 3 + g) * 1024 * D; t.K = 1024; t.N = D; t.WT = (bf16_t*)(ws + WS_WBR + (size_t)(l * 3 + g) * SZ_WBR); item = r - g * T32_BR; }
    else if ((r -= 3 * T32_BR) < T32_OUT) { t.W = P.in[24] + (size_t)l * D * D; t.K = D; t.N = D; t.WT = (bf16_t*)(ws + WS_WOUT + (size_t)l * SZ_WOUT); item = r; }
    else if ((r -= T32_OUT) < T32_F1) { t.W = P.in[27] + (size_t)l * D * DFF; t.K = D; t.N = DFF; t.WT = (bf16_t*)(ws + WS_WFF1 + (size_t)l * SZ_WFF); item = r; }
    else { r -= T32_F1; t.W = P.in[28] + (size_t)l * DFF * D; t.K = DFF; t.N = D; t.WT = (bf16_t*)(ws + WS_WFF2 + (size_t)l * SZ_WFF); item = r; }
    const int nblk = t.N / 32, kb = item / nblk, nb = item - kb * nblk; t.k0 = 64 * kb; t.n0 = 32 * nb;
    return t;
}
#define TSTAGE1(wv, ti) do { const TItem t_ = titem_decode(P, DEPTH - 1, (ti)); const float* wp_ = t_.W + (size_t)(t_.k0 + (lane >> 5)) * t_.N + t_.n0 + (lane & 31); \
    _Pragma("unroll") for (int i_ = 0; i_ < 32; ++i_) wv[i_] = __builtin_nontemporal_load(wp_ + (size_t)(2 * i_) * t_.N); } while (0)
#define TSTAGE2(wv, ti, scr) do { const TItem t_ = titem_decode(P, DEPTH - 1, (ti)); \
    _Pragma("unroll") for (int i_ = 0; i_ < 32; ++i_) (scr)[(2 * i_ + (lane >> 5)) * 33 + (lane & 31)] = wv[i_]; \
    LDS_WAIT(); \
    { const int c_ = lane & 7; _Pragma("unroll") for (int j_ = 0; j_ < 4; ++j_) { const int n_ = (lane >> 3) + 8 * j_; const LAS float* s_ = (scr) + (8 * c_) * 33 + n_; \
        u32x4 o_; o_.x = pk2(s_[0 * 33], s_[1 * 33]); o_.y = pk2(s_[2 * 33], s_[3 * 33]); o_.z = pk2(s_[4 * 33], s_[5 * 33]); o_.w = pk2(s_[6 * 33], s_[7 * 33]); \
        *(u32x4*)(t_.WT + (size_t)(t_.n0 + n_) * t_.K + t_.k0 + 8 * c_) = o_; } } \
    LDS_WAIT(); } while (0)

#define SCAN_BAR() do { asm volatile("s_waitcnt lgkmcnt(0)" ::: "memory"); __builtin_amdgcn_s_barrier(); asm volatile("" ::: "memory"); } while (0)
__device__ __forceinline__ void scan_phase(const Params& P, int l, LAS unsigned char* lds) {
    const int tid = otid(), wid = __builtin_amdgcn_readfirstlane(tid >> 6), lane = tid & 63, col = lane & 15, quad = lane >> 4;
    unsigned char* ws = P.ws;
    const bf16_t* H = (const bf16_t*)(ws + WS_H);
    const float* DNV = (const float*)(ws + WS_DN + OFF_DNV);
    constexpr int TS = 16, NT = NCHUNK;
    constexpr int SLOT = 25856, HGO = 15616;
    const f32x4 zero4 = {0.f, 0.f, 0.f, 0.f};
    for (int vb = blockIdx.x; vb < 256; vb += gridDim.x) {
        const int xcd = vb & 7, idx = vb >> 3, grp = xcd * 4 + (idx >> 3), sub = idx & 7;
        const int b = grp >> 4, h = (grp >> 1) & 7, dir = grp & 1, col0 = sub * 16;
        const size_t rowbase = (size_t)b * TPB;
        if (wid == 0) {
            bf16_t* Odn = (bf16_t*)(ws + WS_SO + (size_t)(2 + dir) * SZ_SOB);
            f32x4 St[8];
#pragma unroll
            for (int m = 0; m < 8; ++m) St[m] = zero4;
#pragma unroll 1
            for (int it = -4; it < NT; ++it) {
                if (it >= 0) {
                    const LAS unsigned char* sl = lds + (it & 1) * SLOT;
                    const int n0 = it * TS; const int plo = dir ? (n0 < 256 ? 256 - TS - n0 : TPB + 256 - TS - n0) : n0;
                    u32x4 fw[4], fq[4]; u32x2 fk[8];
#pragma unroll
                    for (int j = 0; j < 4; ++j) { fw[j] = *(const LAS u32x4*)(sl + (j * 64 + lane) * 16); fq[j] = *(const LAS u32x4*)(sl + 4096 + (j * 64 + lane) * 16); }
#pragma unroll
                    for (int m = 0; m < 8; ++m) fk[m] = *(const LAS u32x2*)(sl + 8192 + (m * 64 + lane) * 8);
                    const u32x2 fa = *(const LAS u32x2*)(sl + 12288 + lane * 8), ft = *(const LAS u32x2*)(sl + 12800 + lane * 8);
                    const f32x4 b4 = *(const LAS f32x4*)(sl + 13312 + lane * 16), v4 = *(const LAS f32x4*)(sl + 14336 + lane * 16);
                    const float egC = *(const LAS float*)(sl + 15360);
                    bf16x8 sf[4];
#pragma unroll
                    for (int j = 0; j < 4; ++j) sf[j] = __builtin_bit_cast(bf16x8, (u32x4){pk2n(St[2 * j][0], St[2 * j][1]), pk2n(St[2 * j][2], St[2 * j][3]), pk2n(St[2 * j + 1][0], St[2 * j + 1][1]), pk2n(St[2 * j + 1][2], St[2 * j + 1][3])});
                    const bf16x8 bv = __builtin_bit_cast(bf16x8, (u32x4){pk2n(b4[0] * v4[0], b4[1] * v4[1]), pk2n(b4[2] * v4[2], b4[3] * v4[3]), 0u, 0u});
                    const bf16x8 FT8 = __builtin_bit_cast(bf16x8, (u32x4){ft[0], ft[1], 0u, 0u}), FA8 = __builtin_bit_cast(bf16x8, (u32x4){fa[0], fa[1], 0u, 0u});
                    const f32x4 U = __builtin_amdgcn_mfma_f32_16x16x32_bf16(FT8, bv, zero4, 0, 0, 0);
                    f32x4 Pw = zero4, O = zero4;
#pragma unroll
                    for (int j = 0; j < 4; ++j) { Pw = __builtin_amdgcn_mfma_f32_16x16x32_bf16(__builtin_bit_cast(bf16x8, fw[j]), sf[j], Pw, 0, 0, 0);
                        O = __builtin_amdgcn_mfma_f32_16x16x32_bf16(__builtin_bit_cast(bf16x8, fq[j]), sf[j], O, 0, 0, 0); }
                    const f32x4 Vn = U - Pw;
                    const bf16x8 vn8 = __builtin_bit_cast(bf16x8, (u32x4){pk2n(Vn[0], Vn[1]), pk2n(Vn[2], Vn[3]), 0u, 0u});
                    O = __builtin_amdgcn_mfma_f32_16x16x32_bf16(FA8, vn8, O, 0, 0, 0);
#pragma unroll
                    for (int m = 0; m < 8; ++m) St[m] = __builtin_amdgcn_mfma_f32_16x16x32_bf16(__builtin_bit_cast(bf16x8, (u32x4){fk[m][0], fk[m][1], 0u, 0u}), vn8, St[m] * egC, 0, 0, 0);
#pragma unroll
                    for (int e = 0; e < 4; ++e) { const int t = 4 * quad + e; const int p = dir ? plo + TS - 1 - t : plo + t;
                        Odn[(rowbase + p) * 1024 + h * 128 + col0 + col] = (bf16_t)(pk2n(O[e], 0.f) & 0xffffu); }
                }
                SCAN_BAR();
            }
        } else if (wid == 1) {
            bf16_t* Ohg = (bf16_t*)(ws + WS_SO + (size_t)dir * SZ_SOB);
            f32x4 St[8];
#pragma unroll
            for (int m = 0; m < 8; ++m) St[m] = zero4;
#pragma unroll 1
            for (int it = -4; it < NT; ++it) {
                if (it >= 0) {
                    const LAS unsigned char* sl = lds + (it & 1) * SLOT + HGO;
                    const int n0 = it * TS; const int plo = dir ? (n0 < 256 ? 256 - TS - n0 : TPB + 256 - TS - n0) : n0;
                    u32x4 fq[4]; u32x2 fk[8]; f32x4 p15[8];
#pragma unroll
                    for (int j = 0; j < 4; ++j) fq[j] = *(const LAS u32x4*)(sl + (j * 64 + lane) * 16);
#pragma unroll
                    for (int m = 0; m < 8; ++m) { fk[m] = *(const LAS u32x2*)(sl + 4096 + (m * 64 + lane) * 8); p15[m] = *(const LAS f32x4*)(sl + 8704 + (16 * m + 4 * quad) * 4); }
                    const u32x2 fa = *(const LAS u32x2*)(sl + 8192 + lane * 8); const f32x4 v4 = *(const LAS f32x4*)(sl + 9216 + lane * 16);
                    bf16x8 sf[4];
#pragma unroll
                    for (int j = 0; j < 4; ++j) sf[j] = __builtin_bit_cast(bf16x8, (u32x4){pk2n(St[2 * j][0], St[2 * j][1]), pk2n(St[2 * j][2], St[2 * j][3]), pk2n(St[2 * j + 1][0], St[2 * j + 1][1]), pk2n(St[2 * j + 1][2], St[2 * j + 1][3])});
                    const bf16x8 bv = __builtin_bit_cast(bf16x8, (u32x4){pk2n(v4[0], v4[1]), pk2n(v4[2], v4[3]), 0u, 0u});
                    const bf16x8 FA8 = __builtin_bit_cast(bf16x8, (u32x4){fa[0], fa[1], 0u, 0u});
                    f32x4 O = __builtin_amdgcn_mfma_f32_16x16x32_bf16(FA8, bv, zero4, 0, 0, 0);
#pragma unroll
                    for (int j = 0; j < 4; ++j) O = __builtin_amdgcn_mfma_f32_16x16x32_bf16(__builtin_bit_cast(bf16x8, fq[j]), sf[j], O, 0, 0, 0);
#pragma unroll
                    for (int m = 0; m < 8; ++m) St[m] = __builtin_amdgcn_mfma_f32_16x16x32_bf16(__builtin_bit_cast(bf16x8, (u32x4){fk[m][0], fk[m][1], 0u, 0u}), bv, St[m] * p15[m], 0, 0, 0);
#pragma unroll
                    for (int e = 0; e < 4; ++e) { const int t = 4 * quad + e; const int p = dir ? plo + TS - 1 - t : plo + t;
                        Ohg[(rowbase + p) * 1024 + h * 128 + col0 + col] = (bf16_t)(pk2n(O[e], 0.f) & 0xffffu); }
                }
                SCAN_BAR();
            }
        } else if (wid < 5) {
            const int k = wid - 2;
            u32x4 fw[4], fq[4]; u32x2 fk[8], fa, ft; f32x4 b4, v4; float egC = 0.f;
#pragma unroll
            for (int j = 0; j < 4; ++j) { fw[j] = (u32x4){0u, 0u, 0u, 0u}; fq[j] = fw[j]; }
#pragma unroll
            for (int m = 0; m < 8; ++m) fk[m] = (u32x2){0u, 0u};
            fa = (u32x2){0u, 0u}; ft = fa; b4 = zero4; v4 = zero4;
            float twv[32]; int tn = 0; bool thave = false; const int tlw = blockIdx.x * 6 + (wid - 2), TNLW = gridDim.x * 6; LAS float* tscr = (LAS float*)(lds + 2 * SLOT + (wid - 2) * 8448);
#pragma unroll
            for (int i_ = 0; i_ < 32; ++i_) twv[i_] = 0.f;
#pragma unroll 1
            for (int it = -4; it < NT; ++it) {
                if ((it + 4) % 3 == k) {
                    const int jw = it + 1, jl = it + 4;
                    if (jw >= 0 && jw < NT) {
                        LAS unsigned char* sl = lds + (jw & 1) * SLOT;
#pragma unroll
                        for (int j = 0; j < 4; ++j) { *(LAS u32x4*)(sl + (j * 64 + lane) * 16) = fw[j]; *(LAS u32x4*)(sl + 4096 + (j * 64 + lane) * 16) = fq[j]; }
#pragma unroll
                        for (int m = 0; m < 8; ++m) *(LAS u32x2*)(sl + 8192 + (m * 64 + lane) * 8) = fk[m];
                        *(LAS u32x2*)(sl + 12288 + lane * 8) = fa; *(LAS u32x2*)(sl + 12800 + lane * 8) = ft;
                        *(LAS f32x4*)(sl + 13312 + lane * 16) = b4; *(LAS f32x4*)(sl + 14336 + lane * 16) = v4;
                        if (lane == 0) *(LAS float*)(sl + 15360) = egC;
                    }
                    if (jl < NT) {
                        const int n0 = jl * TS; const int plo = dir ? (n0 < 256 ? 256 - TS - n0 : TPB + 256 - TS - n0) : n0;
                        const size_t task = (size_t)grp * NCHUNK + jl;
                        const unsigned char* c1 = ws + WS_CP1 + task * CP1_STRIDE; const unsigned char* ck = ws + WS_CPK + task * 4096; const unsigned char* c2 = ws + WS_CP2 + task * CP2_STRIDE;
#pragma unroll
                        for (int j = 0; j < 4; ++j) { fw[j] = *(const u32x4*)(c1 + (size_t)(j * 64 + lane) * 16); fq[j] = *(const u32x4*)(c1 + 4096 + (size_t)(j * 64 + lane) * 16); }
#pragma unroll
                        for (int m = 0; m < 8; ++m) fk[m] = *(const u32x2*)(ck + (size_t)(m * 64 + lane) * 8);
                        fa = *(const u32x2*)(c2 + (size_t)lane * 8); ft = *(const u32x2*)(c2 + 512 + (size_t)lane * 8);
                        b4 = *(const f32x4*)(c2 + 1024 + quad * 16); egC = *(const float*)(c2 + 1024 + 64);
#pragma unroll
                        for (int e = 0; e < 4; ++e) { const int s = 4 * quad + e; const int p = dir ? plo + TS - 1 - s : plo + s;
                            v4[e] = DNV[(rowbase + p) * 1024 + h * 128 + col0 + col]; }
                    }
                }
                if (l == 0) {
                    const int ti = tlw + TNLW * tn;
                    if (ti < T32_PER) {
                        if ((it + 4) % 3 == (k + 1) % 3) { TSTAGE1(twv, ti); thave = true; }
                        else if ((it + 4) % 3 == (k + 2) % 3 && thave) { TSTAGE2(twv, ti, tscr); ++tn; thave = false; }
                    }
                }
                SCAN_BAR();
            }
        } else {
            const int k = wid - 5;
            u32x4 fq[4]; u32x2 fk[8], fa; f32x4 p15 = zero4; bf16_t vr[4] = {0, 0, 0, 0};
#pragma unroll
            for (int j = 0; j < 4; ++j) fq[j] = (u32x4){0u, 0u, 0u, 0u};
#pragma unroll
            for (int m = 0; m < 8; ++m) fk[m] = (u32x2){0u, 0u};
            fa = (u32x2){0u, 0u};
            float twv[32]; int tn = 0; bool thave = false; const int tlw = blockIdx.x * 6 + (wid - 2), TNLW = gridDim.x * 6; LAS float* tscr = (LAS float*)(lds + 2 * SLOT + (wid - 2) * 8448);
#pragma unroll
            for (int i_ = 0; i_ < 32; ++i_) twv[i_] = 0.f;
#pragma unroll 1
            for (int it = -4; it < NT; ++it) {
                if ((it + 4) % 3 == k) {
                    const int jw = it + 1, jl = it + 4;
                    if (jw >= 0 && jw < NT) {
                        LAS unsigned char* sl = lds + (jw & 1) * SLOT + HGO;
#pragma unroll
                        for (int j = 0; j < 4; ++j) *(LAS u32x4*)(sl + (j * 64 + lane) * 16) = fq[j];
#pragma unroll
                        for (int m = 0; m < 8; ++m) *(LAS u32x2*)(sl + 4096 + (m * 64 + lane) * 8) = fk[m];
                        *(LAS u32x2*)(sl + 8192 + lane * 8) = fa;
                        if (lane < 32) *(LAS f32x4*)(sl + 8704 + lane * 16) = p15;
                        *(LAS f32x4*)(sl + 9216 + lane * 16) = (f32x4){bf1(vr[0]), bf1(vr[1]), bf1(vr[2]), bf1(vr[3])};
                    }
                    if (jl < NT) {
                        const int n0 = jl * TS; const int plo = dir ? (n0 < 256 ? 256 - TS - n0 : TPB + 256 - TS - n0) : n0;
                        const size_t task = (size_t)grp * NCHUNK + jl;
                        const unsigned char* cq = ws + WS_HGQ + task * 4096; const unsigned char* ck = ws + WS_HGK + task * 4096; const unsigned char* ca = ws + WS_HGA + task * 1024;
#pragma unroll
                        for (int j = 0; j < 4; ++j) fq[j] = *(const u32x4*)(cq + (size_t)(j * 64 + lane) * 16);
#pragma unroll
                        for (int m = 0; m < 8; ++m) fk[m] = *(const u32x2*)(ck + (size_t)(m * 64 + lane) * 8);
                        fa = *(const u32x2*)(ca + (size_t)lane * 8);
                        if (lane < 32) p15 = *(const f32x4*)(ca + 512 + (size_t)lane * 16);
#pragma unroll
                        for (int e = 0; e < 4; ++e) { const int s = 4 * quad + e; const int p = dir ? plo + TS - 1 - s : plo + s;
                            vr[e] = H[(rowbase + p) * NPAD + C_HGI + h * 128 + col0 + col]; }
                    }
                }
                if (l == 0) {
                    const int ti = tlw + TNLW * tn;
                    if (ti < T32_PER) {
                        if ((it + 4) % 3 == (k + 1) % 3) { TSTAGE1(twv, ti); thave = true; }
                        else if ((it + 4) % 3 == (k + 2) % 3 && thave) { TSTAGE2(twv, ti, tscr); ++tn; thave = false; }
                    }
                }
                SCAN_BAR();
            }
        }
    }
}

__device__ __forceinline__ f32x2 cmul(f32x2 a, f32x2 b) { return (f32x2){a.x * b.x - a.y * b.y, a.x * b.y + a.y * b.x}; }
__device__ __forceinline__ f32x2 cmulc(f32x2 a, f32x2 b) { return (f32x2){a.x * b.x + a.y * b.y, a.y * b.x - a.x * b.y}; }
#define PADI(i) ((i) + (((i) >> 5) << 1))
constexpr int FFT_PADN = 8192 + 512;
template <bool INV, int ST> __device__ __forceinline__ void fft_pass16(LAS f32x2* buf, int base, int bl) {
    constexpr float C16[8] = {1.f, 0.92387953251f, 0.70710678119f, 0.38268343237f, 0.f, -0.38268343237f, -0.70710678119f, -0.92387953251f};
    constexpr float S16[8] = {0.f, 0.38268343237f, 0.70710678119f, 0.92387953251f, 1.f, 0.92387953251f, 0.70710678119f, 0.38268343237f};
    f32x2 x[16];
    constexpr int STEP = (1 << ST) + ((1 << ST) >> 4);
    LAS f32x2* pb = buf + PADI(base);
#pragma unroll
    for (int d = 0; d < 16; ++d) x[d] = pb[d * STEP];
    const float th = (float)bl * (1.f / (float)(16 << ST));
    const f32x2 W1 = {__builtin_amdgcn_cosf(th), -__builtin_amdgcn_sinf(th)};
    const f32x2 W2 = cmul(W1, W1), W4 = cmul(W2, W2), W8 = cmul(W4, W4);
    if (!INV) {
#pragma unroll
        for (int d = 0; d < 8; ++d) { const f32x2 w = cmul(W1, (f32x2){C16[d], -S16[d]}); const f32x2 a = x[d], b = x[d + 8]; x[d] = a + b; x[d + 8] = cmul(a - b, w); }
#pragma unroll
        for (int g = 0; g < 16; g += 8)
#pragma unroll
            for (int dd = 0; dd < 4; ++dd) { const int d = g + dd; const f32x2 w = cmul(W2, (f32x2){C16[2 * dd], -S16[2 * dd]}); const f32x2 a = x[d], b = x[d + 4]; x[d] = a + b; x[d + 4] = cmul(a - b, w); }
#pragma unroll
        for (int g = 0; g < 16; g += 4)
#pragma unroll
            for (int dd = 0; dd < 2; ++dd) { const int d = g + dd; const f32x2 w = dd ? (f32x2){W4.y, -W4.x} : W4; const f32x2 a = x[d], b = x[d + 2]; x[d] = a + b; x[d + 2] = cmul(a - b, w); }
#pragma unroll
        for (int g = 0; g < 16; g += 2) { const f32x2 a = x[g], b = x[g + 1]; x[g] = a + b; x[g + 1] = cmul(a - b, W8); }
    } else {
#pragma unroll
        for (int g = 0; g < 16; g += 2) { const f32x2 a = x[g], b = cmulc(x[g + 1], W8); x[g] = a + b; x[g + 1] = a - b; }
#pragma unroll
        for (int g = 0; g < 16; g += 4)
#pragma unroll
            for (int dd = 0; dd < 2; ++dd) { const int d = g + dd; const f32x2 w = dd ? (f32x2){W4.y, -W4.x} : W4; const f32x2 a = x[d], b = cmulc(x[d + 2], w); x[d] = a + b; x[d + 2] = a - b; }
#pragma unroll
        for (int g = 0; g < 16; g += 8)
#pragma unroll
            for (int dd = 0; dd < 4; ++dd) { const int d = g + dd; const f32x2 w = cmul(W2, (f32x2){C16[2 * dd], -S16[2 * dd]}); const f32x2 a = x[d], b = cmulc(x[d + 4], w); x[d] = a + b; x[d + 4] = a - b; }
#pragma unroll
        for (int d = 0; d < 8; ++d) { const f32x2 w = cmul(W1, (f32x2){C16[d], -S16[d]}); const f32x2 a = x[d], b = cmulc(x[d + 8], w); x[d] = a + b; x[d + 8] = a - b; }
    }
#pragma unroll
    for (int d = 0; d < 16; ++d) pb[d * STEP] = x[d];
}
__device__ __forceinline__ void fft_fwd_abc(LAS f32x2* buf, int tid) {
    asm volatile("" : "+v"(tid));
    fft_pass16<false, 9>(buf, tid, tid); __syncthreads();
    fft_pass16<false, 5>(buf, ((tid >> 5) << 9) + (tid & 31), tid & 31); __syncthreads();
    fft_pass16<false, 1>(buf, ((tid >> 1) << 5) + (tid & 1), tid & 1); __syncthreads();
}
__device__ __forceinline__ void fft_inv_cba(LAS f32x2* buf, int tid) {
    asm volatile("" : "+v"(tid));
    fft_pass16<true, 1>(buf, ((tid >> 1) << 5) + (tid & 1), tid & 1); __syncthreads();
    fft_pass16<true, 5>(buf, ((tid >> 5) << 9) + (tid & 31), tid & 31); __syncthreads();
    fft_pass16<true, 9>(buf, tid, tid); __syncthreads();
}
__device__ __forceinline__ float hy_delta(int c) {
    const float a = -3.0701134573253944f, bq = -15.350567286626972f;
    return fabsf(a + (float)c * ((bq - a) / 1023.f));
}
__device__ __forceinline__ void hyena_phase(const Params& P, int l, LAS unsigned char* lds) {
    const int G = gridDim.x;
    unsigned char* ws = P.ws;
    const unsigned* ZT = (const unsigned*)(ws + WS_ZT);
    const float* HID = (const float*)(ws + WS_HID + (size_t)l * SZ_HID1);
    const float* w3 = P.in[13] + (size_t)l * 64 * 4096;
    const int nitems = 1024 + (l == 0 ? 128 : 0);
#pragma unroll 1
    for (int item = blockIdx.x; item < nitems; item += G) {
        const int tid = otid();
        if (item < 1024) {
            const int c = item;
            LAS f32x2* bufA = (LAS f32x2*)lds; LAS f32x2* bufB = bufA + FFT_PADN; LAS f32x4* w3s = (LAS f32x4*)(lds + 2 * FFT_PADN * 8);
            if (tid < 256) ((LAS float*)w3s)[tid] = w3[(size_t)(tid >> 2) * 4096 + ((tid >> 1) & 1) * 2048 + (tid & 1) * 1024 + c];
            __syncthreads();
            const float dl = hy_delta(c);
            {
                f32x4 hacc[8];
#pragma unroll
                for (int e = 0; e < 8; ++e) hacc[e] = (f32x4){0.f, 0.f, 0.f, 0.f};
#pragma unroll 16
                for (int j = 0; j < 64; ++j) { const f32x4 w = w3s[j]; const f32x4 h0 = *(const f32x4*)(HID + (size_t)j * 4096 + 4 * tid), h1 = *(const f32x4*)(HID + (size_t)j * 4096 + 2048 + 4 * tid);
#pragma unroll
                    for (int e = 0; e < 4; ++e) { hacc[e] += h0[e] * w; hacc[4 + e] += h1[e] * w; } }
#pragma unroll
                for (int e = 0; e < 8; ++e) { const int t = 4 * tid + (e & 3) + (e >> 2) * 2048; const float win = __expf(-((float)t * (1.f / 4095.f)) * dl);
                    bufB[PADI(4 * tid) + (e & 3) + (e >> 2) * 2176] = (f32x2){win * hacc[e][0], win * hacc[e][2]};
                    if (t >= 1) bufB[PADI(8192 - t)] = (f32x2){win * hacc[e][1], win * hacc[e][3]}; else bufB[PADI(4096)] = (f32x2){0.f, 0.f}; }
            }
            __syncthreads();
            fft_fwd_abc(bufB, tid);
#pragma unroll
            for (int u = 0; u < 8; ++u) { LAS f32x4* pp = (LAS f32x4*)(bufB + PADI(2 * tid) + 1088 * u); const f32x4 v = *pp;
                *pp = (f32x4){v[0] + v[2], v[1] + v[3], v[0] - v[2], v[1] - v[3]}; }
            f32x2 vv[8], y1[8];
#pragma unroll
            for (int u = 0; u < 8; ++u) { const int t = tid + 512 * u; { const unsigned w_ = ZT[(size_t)c * 4096 + t]; vv[u] = (f32x2){bflo(w_), bfhi(w_)}; } bufA[PADI(tid) + 544 * u] = vv[u]; bufA[PADI(tid) + 544 * u + 4352] = (f32x2){0.f, 0.f}; }
            __syncthreads();
#pragma unroll
            for (int ord = 0; ord < 2; ++ord) {
                fft_fwd_abc(bufA, tid);
#pragma unroll 2
                for (int u = 0; u < 8; ++u) { const int i0 = 2 * (tid + 512 * u); LAS f32x4* pp = (LAS f32x4*)(bufA + PADI(2 * tid) + 1088 * u); const f32x4 v = *pp;
                    f32x2 xs[2] = {(f32x2){v[0] + v[2], v[1] + v[3]}, (f32x2){v[0] - v[2], v[1] - v[3]}};
                    const f32x4 zz = *(const LAS f32x4*)(bufB + PADI(2 * tid) + 1088 * u);
#pragma unroll
                    for (int q = 0; q < 2; ++q) { const unsigned f = __brev((unsigned)(i0 + q)) >> 19, fp = (8192u - f) & 8191u, ip = __brev(fp) >> 19;
                        const f32x2 Z = q ? (f32x2){zz[2], zz[3]} : (f32x2){zz[0], zz[1]}; const f32x2 Zp = bufB[PADI((int)ip)]; f32x2 Kf;
                        if (ord == 0) Kf = (f32x2){Z.x + Zp.x, Z.y - Zp.y}; else Kf = (f32x2){Z.y + Zp.y, Zp.x - Z.x};
                        Kf *= (0.5f / 8192.f);
                        xs[q] = cmul(xs[q], Kf); }
                    *pp = (f32x4){xs[0].x + xs[1].x, xs[0].y + xs[1].y, xs[0].x - xs[1].x, xs[0].y - xs[1].y}; }
                __syncthreads();
                fft_inv_cba(bufA, tid);
                const float skip = P.in[14][(size_t)(l * 2 + ord) * 1024 + c];
#pragma unroll
                for (int u = 0; u < 8; ++u) { const int t = tid + 512 * u; const f32x2 cv = bufA[PADI(tid) + 544 * u]; const unsigned gw_ = ZT[(size_t)((ord + 1) * 1024 + c) * 4096 + t]; const f32x2 gt = {bflo(gw_), bfhi(gw_)};
                    if (ord == 0) { y1[u] = gt * (cv + skip * vv[u]); bufA[PADI(tid) + 544 * u] = y1[u]; bufA[PADI(tid) + 544 * u + 4352] = (f32x2){0.f, 0.f}; }
                    else { const f32x2 yo = gt * (cv + skip * y1[u]); ((unsigned*)(ws + WS_ZY))[(size_t)c * 4096 + t] = pk2(yo.x, yo.y); } }
                __syncthreads();
            }
        } else {
            const int it = item - 1024, bb = it >> 6, cg = it & 63, ch = tid & 15, tg = tid >> 4, c = cg * 16 + ch;
            LAS float* filt = (LAS float*)lds;
            LAS float* vbuf = filt + 511 * 16;
            LAS float* ybuf = vbuf + 256 * 16;
            const float* ZC = (const float*)(ws + WS_ZC) + (size_t)bb * 256 * 3072;
            const float* HC = HID + 64 * 4096;
            bf16_t* HYC = (bf16_t*)(ws + WS_HYC);
            const float dl = hy_delta(c);
            for (int i = tid; i < 256 * 16; i += NTHR) vbuf[i] = ZC[(size_t)(i >> 4) * 3072 + cg * 16 + (i & 15)];
#pragma unroll 1
            for (int ord = 0; ord < 2; ++ord) {
                {
                    const float* wpf = w3 + ord * 2048 + c; const float* wpb = wpf + 1024;
                    f32x4 af0 = {0.f, 0.f, 0.f, 0.f}, af1 = af0, ab0 = af0, ab1 = af0;
#pragma unroll 4
                    for (int j = 0; j < 64; ++j) { const float wf = wpf[(size_t)j * 4096], wb = wpb[(size_t)j * 4096];
                        const f32x4 h0 = *(const f32x4*)(HC + j * 256 + tg * 8), h1 = *(const f32x4*)(HC + j * 256 + tg * 8 + 4);
                        af0 += h0 * wf; af1 += h1 * wf; ab0 += h0 * wb; ab1 += h1 * wb; }
#pragma unroll
                    for (int e = 0; e < 8; ++e) { const int tau = tg * 8 + e; const float win = __expf(-((float)tau * (1.f / 255.f)) * dl);
                        filt[(255 + tau) * 16 + ch] = win * (e < 4 ? af0[e & 3] : af1[e & 3]);
                        if (tau >= 1) filt[(255 - tau) * 16 + ch] = win * (e < 4 ? ab0[e & 3] : ab1[e & 3]); }
                }
                __syncthreads();
                const int tq = tg >> 1;
                (void)tq;
                float acc[8];
#pragma unroll
                for (int i = 0; i < 8; ++i) acc[i] = 0.f;
                const LAS float* src = ord ? ybuf : vbuf;
                for (int s = 0; s < 256; ++s) { const float vs = src[s * 16 + ch];
#pragma unroll
                    for (int i = 0; i < 8; ++i) acc[i] += filt[(tg * 8 + i - s + 255) * 16 + ch] * vs; }
                const float skip = P.in[14][(size_t)ord * 1024 + c];
                float res[8];
#pragma unroll
                for (int i = 0; i < 8; ++i) { const int t = tg * 8 + i; res[i] = ZC[(size_t)t * 3072 + (ord + 1) * 1024 + c] * (acc[i] + skip * src[t * 16 + ch]); }
                __syncthreads();
#pragma unroll
                for (int i = 0; i < 8; ++i) { const int t = tg * 8 + i;
                    if (ord == 0) ybuf[t * 16 + ch] = res[i];
                    else HYC[((size_t)bb * 256 + t) * 1024 + c] = (bf16_t)(pk2(res[i], 0.f) & 0xffffu); }
                __syncthreads();
            }
        }
    }
}

__device__ __forceinline__ void assemble_phase(const Params& P, int l, LAS unsigned char* lds) {
    const int tid = otid(), lane = tid & 63, wave = tid >> 6, G = gridDim.x;
    const int gw = blockIdx.x * NWAVES + wave, NGW = G * NWAVES;
    unsigned char* ws = P.ws;
    const bf16_t* H = (const bf16_t*)(ws + WS_H); bf16_t* BR = (bf16_t*)(ws + WS_DN);
    {
        LAS float* L = (LAS float*)lds;
        const unsigned* ZT = (const unsigned*)(ws + WS_ZY);
#define ASY_LOAD(rv_, item_) do { const int ti_ = (item_) >> 4, ct_ = (item_) & 15, tt_ = tid & 63; \
            _Pragma("unroll") for (int u = 0; u < 8; ++u) { const int cc = (tid >> 6) + 8 * u; rv_[u] = ZT[(size_t)(ct_ * 64 + cc) * 4096 + ti_ * 64 + tt_]; } } while (0)
        unsigned crv[8];
#pragma unroll
        for (int u = 0; u < 8; ++u) crv[u] = 0u;
        if ((int)blockIdx.x < 64 * 16) ASY_LOAD(crv, blockIdx.x);
#pragma unroll 1
        for (int item = blockIdx.x; item < 64 * 16; item += G) {
            const int ti = item >> 4, ct = item & 15;
            unsigned nrv[8];
#pragma unroll
            for (int u = 0; u < 8; ++u) nrv[u] = 0u;
            if (item + G < 64 * 16) ASY_LOAD(nrv, item + G);
            { const int tt = tid & 63;
#pragma unroll
              for (int u = 0; u < 8; ++u) { const int cc = (tid >> 6) + 8 * u; const unsigned v = crv[u];
                L[(0 * 64 + tt) * 65 + cc] = bflo(v); L[(1 * 64 + tt) * 65 + cc] = bfhi(v); } }
            asm volatile("s_waitcnt lgkmcnt(0)" ::: "memory"); __builtin_amdgcn_s_barrier(); asm volatile("" ::: "memory");
#pragma unroll
            for (int u = 0; u < 2; ++u) { const int task = tid + 512 * u, rowi = task >> 3, bb = rowi >> 6, tt = rowi & 63, ch8 = task & 7;
                const LAS float* lp = L + (bb * 64 + tt) * 65 + ch8 * 8;
                u32x4 o; o.x = pk2(lp[0], lp[1]); o.y = pk2(lp[2], lp[3]); o.z = pk2(lp[4], lp[5]); o.w = pk2(lp[6], lp[7]);
                *(u32x4*)(BR + ((size_t)bb * TPB + CTX + ti * 64 + tt) * 3072 + ct * 64 + ch8 * 8) = o; }
            asm volatile("s_waitcnt lgkmcnt(0)" ::: "memory"); __builtin_amdgcn_s_barrier(); asm volatile("" ::: "memory");
#pragma unroll
            for (int u = 0; u < 8; ++u) crv[u] = nrv[u];
        }
#undef ASY_LOAD
    }
    if (l == 0) {
        const u32x4* HYC = (const u32x4*)(ws + WS_HYC);
        for (int i = blockIdx.x * NTHR + tid; i < 512 * 128; i += G * NTHR) { const int r = i >> 7, c8 = i & 127;
            *(u32x4*)(BR + ((size_t)(r >> 8) * TPB + (r & 255)) * 3072 + c8 * 8) = HYC[i]; }
    }
    {
        const bf16_t* SOb = (const bf16_t*)(ws + WS_SO);
        const bool skipc = (l == DEPTH - 1);
        int r = gw;
        while (r < M && skipc && (r % TPB) < CTX) r += NGW;
        float nwr[2][8];
#pragma unroll
        for (int mix = 0; mix < 2; ++mix)
#pragma unroll
            for (int e = 0; e < 8; ++e) nwr[mix][e] = P.in[mix ? 22 : 16][l * 128 + (lane & 15) * 8 + e];
        u32x4 cs[2][2][2], cg[2][2];
#define ASM_LOAD(so, gg, row) do { _Pragma("unroll") for (int mix = 0; mix < 2; ++mix) _Pragma("unroll") for (int half = 0; half < 2; ++half) { const int ch = half * 512 + lane * 8; \
            so[mix][half][0] = *(const u32x4*)(SOb + (size_t)(mix * 2) * (SZ_SOB / 2) + (size_t)(row) * 1024 + ch); \
            so[mix][half][1] = *(const u32x4*)(SOb + (size_t)(mix * 2 + 1) * (SZ_SOB / 2) + (size_t)(row) * 1024 + ch); \
            gg[mix][half] = *(const u32x4*)(H + (size_t)(row) * NPAD + (mix ? C_DNZ : C_HGG) + ch); } } while (0)
#pragma unroll
        for (int mix = 0; mix < 2; ++mix)
#pragma unroll
            for (int half = 0; half < 2; ++half) { cs[mix][half][0] = (u32x4){0u, 0u, 0u, 0u}; cs[mix][half][1] = cs[mix][half][0]; cg[mix][half] = cs[mix][half][0]; }
        if (r < M) ASM_LOAD(cs, cg, r);
#pragma unroll 1
        while (r < M) {
            int rn = r + NGW;
            while (rn < M && skipc && (rn % TPB) < CTX) rn += NGW;
            u32x4 ns[2][2][2], ng[2][2];
#pragma unroll
            for (int mix = 0; mix < 2; ++mix)
#pragma unroll
                for (int half = 0; half < 2; ++half) { ns[mix][half][0] = (u32x4){0u, 0u, 0u, 0u}; ns[mix][half][1] = ns[mix][half][0]; ng[mix][half] = ns[mix][half][0]; }
            if (rn < M) ASM_LOAD(ns, ng, rn);
#pragma unroll
            for (int mix = 0; mix < 2; ++mix) {
#pragma unroll
                for (int half = 0; half < 2; ++half) {
                    const int ch = half * 512 + lane * 8;
                    float o[8], o2[8]; unpack8(cs[mix][half][0], o); unpack8(cs[mix][half][1], o2);
#pragma unroll
                    for (int e = 0; e < 8; ++e) o[e] += o2[e];
                    float ss = 0.f;
#pragma unroll
                    for (int e = 0; e < 8; ++e) ss += o[e] * o[e];
                    ss = row_sum16(ss);
                    const float rs = __builtin_amdgcn_rsqf(ss * (1.f / 128.f) + 1e-6f);
                    float gt[8]; unpack8(cg[mix][half], gt);
                    float res[8];
#pragma unroll
                    for (int e = 0; e < 8; ++e) res[e] = o[e] * rs * nwr[mix][e] * (mix ? silu(gt[e]) : sigm(gt[e]));
                    u32x4 ov; ov.x = pk2(res[0], res[1]); ov.y = pk2(res[2], res[3]); ov.z = pk2(res[4], res[5]); ov.w = pk2(res[6], res[7]);
                    *(u32x4*)(BR + (size_t)r * 3072 + (mix ? 2048 : 1024) + ch) = ov;
                }
            }
#pragma unroll
            for (int mix = 0; mix < 2; ++mix)
#pragma unroll
                for (int half = 0; half < 2; ++half) { cs[mix][half][0] = ns[mix][half][0]; cs[mix][half][1] = ns[mix][half][1]; cg[mix][half] = ng[mix][half]; }
            r = rn;
        }
#undef ASM_LOAD
    }
}

__device__ __forceinline__ void ctx_sb_from_sctx(const Params& P) {
    const float* SC = (const float*)(P.ws + WS_SCTX); bf16_t* SB = (bf16_t*)(P.ws + WS_U);
    for (int i = blockIdx.x * NTHR + threadIdx.x; i < 512 * D / 4; i += gridDim.x * NTHR) {
        const int r = i / (D / 4), c4 = i - r * (D / 4); f32x4 v = *(const f32x4*)(SC + (size_t)i * 4);
#pragma unroll
        for (int s = 1; s < 12; ++s) v += *(const f32x4*)(SC + (size_t)s * 512 * D + (size_t)i * 4);
        u32x2 o; o.x = pk2(v[0], v[1]); o.y = pk2(v[2], v[3]);
        *(u32x2*)(SB + ((size_t)(r >> 8) * TPB + (r & 255)) * D + c4 * 4) = o; }
}
__device__ __forceinline__ void gbar_impl(unsigned* bar, unsigned& gen, unsigned nloc, unsigned nx) {
    asm volatile("s_waitcnt vmcnt(0)" ::: "memory");
    __syncthreads();
    gen += 1u;
    if (threadIdx.x == 0) {
        __builtin_amdgcn_s_waitcnt(0);
        const unsigned x = xcc_id();
        const unsigned old = __hip_atomic_fetch_add(bar + XB_SUB(x), 1u, __ATOMIC_RELAXED, __HIP_MEMORY_SCOPE_AGENT);
        if (old + 1u == gen * nloc) {
            __builtin_amdgcn_fence(__ATOMIC_RELEASE, "agent");
            asm volatile("s_waitcnt vmcnt(0)" ::: "memory");
            const unsigned og = __hip_atomic_fetch_add(bar + XB_TOP, 1u, __ATOMIC_RELAXED, __HIP_MEMORY_SCOPE_AGENT);
            if (og + 1u == gen * nx) (void)__hip_atomic_fetch_add(bar + XB_GEN, 1u, __ATOMIC_RELAXED, __HIP_MEMORY_SCOPE_AGENT);
        }
        unsigned sp = 0u;
        while (__hip_atomic_load(bar + XB_GEN, __ATOMIC_RELAXED, __HIP_MEMORY_SCOPE_AGENT) < gen) { __builtin_amdgcn_s_sleep(1); if (++sp > (1u << 22)) break; }
        __builtin_amdgcn_fence(__ATOMIC_ACQUIRE, "agent");
        asm volatile("s_waitcnt vmcnt(0)" ::: "memory");
    }
    __syncthreads();
}
#define gbar(bar, gen, G) gbar_impl(bar, gen, bar_nloc, bar_nx)
#ifndef REPM
#define REPM 0
#endif
#define REP(bit) for (int _rp = 0; _rp < (((REPM) >> (bit)) & 1) + 1; ++_rp)
__global__ void __launch_bounds__(NTHR, 2) mega(Params P) {
    extern __shared__ __attribute__((aligned(16))) unsigned char smem[];
    LAS unsigned char* lds = (LAS unsigned char*)smem;
    cg::grid_group grid = cg::this_grid();
    unsigned char* ws = P.ws;
    const int G = gridDim.x, cidx = blockIdx.x;
    unsigned* bar = (unsigned*)(ws + WS_BAR); unsigned bgen = 0u;

    REP(0) { phase0(P, lds);
    grid.sync(); }
    unsigned bar_nloc, bar_nx;
    { unsigned nl = __hip_atomic_load(bar + XB_CNT(xcc_id()), __ATOMIC_RELAXED, __HIP_MEMORY_SCOPE_AGENT), nxx = 0u;
#pragma unroll
      for (int j = 0; j < 16; ++j) nxx += (__hip_atomic_load(bar + XB_CNT(j), __ATOMIC_RELAXED, __HIP_MEMORY_SCOPE_AGENT) != 0u) ? 1u : 0u;
      bar_nloc = (unsigned)__builtin_amdgcn_readfirstlane((int)(nl ? nl : 1u)); bar_nx = (unsigned)__builtin_amdgcn_readfirstlane((int)(nxx ? nxx : 1u)); }
    init_rows(P);
    gbar(bar, bgen, (unsigned)G);

#pragma unroll 1
    for (int l = 0; l < DEPTH; ++l) {
        const float* modl = (const float*)(ws + WS_MOD) + (size_t)l * 3 * 6 * D;
        { pg8::Order S{(const bf16_t*)(ws + WS_U), (const bf16_t*)(ws + WS_WIN + (size_t)l * SZ_WIN), D, D, l ? 32 : M / 256, NPAD / 256, G, cidx, 1, 0, 0, D, l ? 1 : 0, l ? 19 : 0, 0};
          pg8::EpiBf16<0> E{(bf16_t*)(ws + WS_H), NPAD};
          REP(1) pg8::gemm_phase(lds, D, D, S, E); }
        gbar(bar, bgen, (unsigned)G);
        REP(2) { prep_phase(P, l, lds);
        gbar(bar, bgen, (unsigned)G); }
        REP(4) { hyena_phase(P, l, lds);
        gbar(bar, bgen, (unsigned)G); }
        chunkprep_phase(P, lds);
        gbar(bar, bgen, (unsigned)G);
        hgprep_phase(P, l, lds);
        gbar(bar, bgen, (unsigned)G);
        REP(3) { scan_phase(P, l, lds);
        gbar(bar, bgen, (unsigned)G); }
        REP(5) { assemble_phase(P, l, lds);
        gbar(bar, bgen, (unsigned)G); }
        { pg8::Order S{(const bf16_t*)(ws + WS_DN), (const bf16_t*)(ws + WS_WBR + (size_t)l * 3 * SZ_WBR), 3072, 1024, 32, D / 256, G, cidx, 3, 1024, (size_t)D * 1024, 1024, 1, 0, l ? 0 : 4};
          pg8::EpiBranch E{(float*)(ws + WS_SO), (bf16_t*)(ws + WS_U), (const bf16_t*)(ws + WS_H), (float*)(ws + WS_SCTX)};
          pg8::gemm_phase(lds, 3072, 1024, S, E); }
        gbar(bar, bgen, (unsigned)G);
        if (l == 0) { ctx_sb_from_sctx(P); gbar(bar, bgen, (unsigned)G); }
        { pg8::Order S{(const bf16_t*)(ws + WS_U), (const bf16_t*)(ws + WS_WOUT + (size_t)l * SZ_WOUT), D, D, 32, D / 256, G, cidx, 1, 0, 0, D, 1, 0, l ? 0 : 8};
          pg8::EpiRes E{(bf16_t*)(ws + WS_SO + (size_t)M * D * 4), (const float*)(ws + WS_X), modl, 2, (float*)(ws + WS_SCTX)};
          pg8::gemm_phase(lds, D, D, S, E); }
        gbar(bar, bgen, (unsigned)G);
        REP(8) { ln_rows(P, P.in[25] + l * D, P.in[26] + l * D, modl, 3, true, false, l ? 0 : 8, l == DEPTH - 1);
        gbar(bar, bgen, (unsigned)G); }
        { pg8::Order S{(const bf16_t*)(ws + WS_U), (const bf16_t*)(ws + WS_WFF1 + (size_t)l * SZ_WFF), D, D, l ? 32 : M / 256, DFF / 256, G, cidx, 1, 0, 0, D, l ? 1 : 0, 0, 0};
          pg8::EpiBf16<1> E{(bf16_t*)(ws + WS_H), DFF};
          REP(9) pg8::gemm_phase(lds, D, D, S, E); }
        gbar(bar, bgen, (unsigned)G);
        { pg8::Order S{(const bf16_t*)(ws + WS_H), (const bf16_t*)(ws + WS_WFF2 + (size_t)l * SZ_WFF), DFF, DFF, 32, D / 256, G, cidx, 1, 0, 0, DFF, 1, 0, l ? 0 : 16};
          pg8::EpiRes E{(bf16_t*)(ws + WS_SO + (size_t)M * D * 4), (const float*)(ws + WS_X), modl, 5, (float*)(ws + WS_SCTX)};
          pg8::gemm_phase(lds, DFF, DFF, S, E); }
        gbar(bar, bgen, (unsigned)G);
        const bool lastl = (l == DEPTH - 1);
        ln_rows(P, P.in[29] + l * D, P.in[30] + l * D, modl + (lastl ? 0 : 3 * 6 * D), 0, !lastl, lastl, l ? 0 : 16, lastl);
        if (!lastl) gbar(bar, bgen, (unsigned)G);
    }
}

extern "C" void kernel_launch(void* const* d_in, const int* in_sizes, int n_in, void* d_out, int out_size, void* d_ws, size_t ws_size, hipStream_t stream) {
    static int grid_blocks = 0;
    if (grid_blocks == 0) {
        if (n_in != 31 || ws_size < WS_END) { fprintf(stderr, "kernel_launch: unexpected n_in %d or ws_size %zu (need %zu)\n", n_in, ws_size, (size_t)WS_END); grid_blocks = -1; return; }
        int dev = 0, cus = 0, per_cu = 0;
        hipGetDevice(&dev);
        hipDeviceGetAttribute(&cus, hipDeviceAttributeMultiprocessorCount, dev);
        if (hipFuncSetAttribute((const void*)mega, hipFuncAttributeMaxDynamicSharedMemorySize, LDS_BYTES) != hipSuccess) fprintf(stderr, "kernel_launch: hipFuncSetAttribute failed\n");
        hipOccupancyMaxActiveBlocksPerMultiprocessor(&per_cu, (const void*)mega, NTHR, LDS_BYTES);
        if (per_cu < 1) { fprintf(stderr, "kernel_launch: occupancy query says %d blocks per CU\n", per_cu); per_cu = 1; }
        (void)hipGetLastError();
        grid_blocks = cus;
    }
    if (grid_blocks < 0) return;
    Params p{};
    for (int i = 0; i < 31; ++i) p.in[i] = (const float*)d_in[i];
    p.out = (float*)d_out; p.ws = (unsigned char*)d_ws;
    (void)hipMemsetAsync((unsigned char*)d_ws + WS_BAR, 0, 16384, stream);
    void* args[] = {&p};
    hipError_t e = hipLaunchCooperativeKernel((const void*)mega, dim3(grid_blocks), dim3(NTHR), args, LDS_BYTES, stream);
    if (e != hipSuccess) fprintf(stderr, "cooperative launch failed: %s (grid %d)\n", hipGetErrorString(e), grid_blocks);
}
```
